# Optimizing an MI355X kernel written in HIP

```python
import math
import jax, jax.numpy as jnp
from jax import lax
import numpy as np

D_MODEL = 1024
BATCH = 8
SEQ = 8192
DEPTH = 1

CHUNK = 64
D_MIX = D_MODEL
S5_WIDTH = 512
S5_GROUP = 16
S5_GROUPS = S5_WIDTH // S5_GROUP
S5_STATE = 64
S5_DT_MIN = 1e-3
S5_DT_MAX = 1e-1
MLA_WIDTH = D_MIX - S5_WIDTH
MLA_HEADS = 8
MLA_NOPE = 64
MLA_ROPE = 32
MLA_V = MLA_WIDTH // MLA_HEADS
Q_LORA = 384
KV_LORA = 256
ROPE_THETA = 10000.0
Q_BLOCK = 128
D_IN = S5_WIDTH + Q_LORA + KV_LORA + MLA_ROPE
PEER_HEADS = 8
PEER_NKEYS = 128
PEER_EXPERTS = PEER_NKEYS * PEER_NKEYS
PEER_QDIM = 256
PEER_HALF = PEER_QDIM // 2
PEER_TOPK = 16
PEER_BLOCK = 128
DEEPNORM_ALPHA = (2.0 * DEPTH) ** 0.25
DEEPNORM_BETA = (8.0 * DEPTH) ** -0.25
NORM_EPS = 1e-6
MASK_VALUE = -1e30

kernel_name = "hybrid_s5_mla_peer_block"


def _layernorm(x, g, b):
    xf = x.astype(jnp.float32)
    mu = jnp.mean(xf, axis=-1, keepdims=True)
    var = jnp.mean(jnp.square(xf - mu), axis=-1, keepdims=True)
    y = (xf - mu) * lax.rsqrt(var + NORM_EPS) * g.astype(jnp.float32) + b.astype(jnp.float32)
    return y.astype(x.dtype)


def _rmsnorm(x, g):
    xf = x.astype(jnp.float32)
    y = xf * lax.rsqrt(jnp.mean(xf * xf, axis=-1, keepdims=True) + NORM_EPS) * g.astype(jnp.float32)
    return y.astype(x.dtype)


def _rope_angles(positions):
    inv_freq = ROPE_THETA ** (-jnp.arange(0, MLA_ROPE, 2, dtype=jnp.float32) / MLA_ROPE)
    ang = positions.astype(jnp.float32)[..., None] * inv_freq
    return jnp.cos(ang), jnp.sin(ang)


def _apply_rope(x, cos, sin):
    x1, x2 = jnp.split(x, 2, axis=-1)
    cos = cos.astype(x.dtype)
    sin = sin.astype(x.dtype)
    return jnp.concatenate([x1 * cos - x2 * sin, x2 * cos + x1 * sin], axis=-1)


def _complex_affine_combine(left, right):
    a1r, a1i, b1r, b1i = left
    a2r, a2i, b2r, b2i = right
    ar = a2r * a1r - a2i * a1i
    ai = a2r * a1i + a2i * a1r
    br = a2r * b1r - a2i * b1i + b2r
    bi = a2r * b1i + a2i * b1r + b2i
    return (ar, ai, br, bi)


def _s5_mixer(u, lam_re, lam_im, log_dt, b_re, b_im, c_re, c_im, d, w_glu, b_glu):
    bsz, L, _ = u.shape
    ug = u.reshape(bsz, L, S5_GROUPS, S5_GROUP)
    dt = jnp.exp(log_dt)[:, None]
    mag = jnp.exp(lam_re * dt)
    ab_re = mag * jnp.cos(lam_im * dt)
    ab_im = mag * jnp.sin(lam_im * dt)
    den = lam_re * lam_re + lam_im * lam_im
    nr = ab_re - 1.0
    coef_re = (nr * lam_re + ab_im * lam_im) / den
    coef_im = (ab_im * lam_re - nr * lam_im) / den
    bb_re = coef_re[..., None] * b_re - coef_im[..., None] * b_im
    bb_im = coef_re[..., None] * b_im + coef_im[..., None] * b_re
    bu_re = jnp.einsum('blgh,gph->blgp', ug, bb_re)
    bu_im = jnp.einsum('blgh,gph->blgp', ug, bb_im)
    a_re = jnp.broadcast_to(ab_re, (1, L) + ab_re.shape)
    a_im = jnp.broadcast_to(ab_im, (1, L) + ab_im.shape)
    _, _, s_re, s_im = lax.associative_scan(_complex_affine_combine, (a_re, a_im, bu_re, bu_im), axis=1)
    y = jnp.einsum('blgp,ghp->blgh', s_re, c_re) - jnp.einsum('blgp,ghp->blgh', s_im, c_im)
    y = y.reshape(bsz, L, S5_WIDTH) + d * u
    y = jax.nn.gelu(y)
    return y * jax.nn.sigmoid(y @ w_glu + b_glu)


def _mla_mixer(cq, ckv, kr, cos, sin, q_norm, w_uq, kv_norm, w_ukv):
    bsz, L, _ = cq.shape
    q = (_rmsnorm(cq, q_norm) @ w_uq).reshape(bsz, L, MLA_HEADS, MLA_NOPE + MLA_ROPE)
    q_nope = q[..., :MLA_NOPE]
    q_pe = _apply_rope(q[..., MLA_NOPE:], cos[:, :, None, :], sin[:, :, None, :])
    kv = (_rmsnorm(ckv, kv_norm) @ w_ukv).reshape(bsz, L, MLA_HEADS, MLA_NOPE + MLA_V)
    k_nope = kv[..., :MLA_NOPE]
    v = kv[..., MLA_NOPE:]
    k_pe = _apply_rope(kr, cos, sin)
    scale = (MLA_NOPE + MLA_ROPE) ** -0.5
    n_blk = L // Q_BLOCK
    k_chunk = jnp.arange(L) // CHUNK

    def q_block(args):
        qn, qp, blk = args
        s = jnp.einsum('bqhd,bkhd->bhqk', qn, k_nope) + jnp.einsum('bqhr,bkr->bhqk', qp, k_pe)
        s = s.astype(jnp.float32) * scale
        q_chunk = (blk * Q_BLOCK + jnp.arange(Q_BLOCK)) // CHUNK
        mask = k_chunk[None, :] <= q_chunk[:, None]
        s = jnp.where(mask[None, None], s, MASK_VALUE)
        p = jax.nn.softmax(s, axis=-1).astype(v.dtype)
        return jnp.einsum('bhqk,bkhd->bqhd', p, v)

    qn_b = q_nope.reshape(bsz, n_blk, Q_BLOCK, MLA_HEADS, MLA_NOPE).transpose(1, 0, 2, 3, 4)
    qp_b = q_pe.reshape(bsz, n_blk, Q_BLOCK, MLA_HEADS, MLA_ROPE).transpose(1, 0, 2, 3, 4)
    out = lax.map(q_block, (qn_b, qp_b, jnp.arange(n_blk)))
    return out.transpose(1, 0, 2, 3, 4).reshape(bsz, L, MLA_WIDTH)


def _peer(h, w_query, keys1, keys2, u_tab, v_tab):
    bsz, L, dm = h.shape
    hb = h.reshape((bsz * L) // PEER_BLOCK, PEER_BLOCK, dm)

    def token_block(ht):
        q = (ht @ w_query).reshape(PEER_BLOCK, PEER_HEADS, PEER_QDIM)
        s1 = jnp.einsum('thd,hkd->thk', q[..., :PEER_HALF], keys1)
        s2 = jnp.einsum('thd,hkd->thk', q[..., PEER_HALF:], keys2)
        v1, i1 = lax.top_k(s1, PEER_TOPK)
        v2, i2 = lax.top_k(s2, PEER_TOPK)
        cand = (v1[..., :, None] + v2[..., None, :]).reshape(PEER_BLOCK, PEER_HEADS, PEER_TOPK * PEER_TOPK)
        top_s, top_c = lax.top_k(cand, PEER_TOPK)
        e1 = jnp.take_along_axis(i1, top_c // PEER_TOPK, axis=-1)
        e2 = jnp.take_along_axis(i2, top_c % PEER_TOPK, axis=-1)
        expert = e1 * PEER_NKEYS + e2
        g = jax.nn.softmax(top_s.astype(jnp.float32), axis=-1).astype(ht.dtype)
        act = jax.nn.gelu(jnp.einsum('thkd,td->thk', u_tab[expert], ht))
        return jnp.einsum('thk,thkd->td', g * act, v_tab[expert])

    return lax.map(token_block, hb).reshape(bsz, L, dm)


def setup_inputs(seed: int = 0) -> dict:
    key = jax.random.key(seed)
    ks = jax.random.split(key, 40)
    nrm = jax.random.normal
    f32 = jnp.float32
    x = nrm(ks[0], (BATCH, SEQ, D_MODEL), f32)
    c = nrm(ks[1], (BATCH, D_MODEL), f32)
    offset = jax.random.randint(ks[2], (BATCH, 1), 0, 4096, dtype=jnp.int32)
    positions = (offset + jnp.arange(SEQ, dtype=jnp.int32)[None, :]).astype(jnp.int32)
    w_ada = nrm(ks[3], (DEPTH, D_MODEL, 6 * D_MODEL), f32) * (0.5 * D_MODEL ** -0.5)
    b_ada = 0.02 * nrm(ks[4], (DEPTH, 6 * D_MODEL), f32)
    w_in = nrm(ks[5], (DEPTH, D_MODEL, D_IN), f32) * D_MODEL ** -0.5
    s5_lambda_re = -0.5 + 0.01 * nrm(ks[6], (DEPTH, S5_GROUPS, S5_STATE), f32)
    s5_lambda_im = jnp.broadcast_to(math.pi * jnp.arange(S5_STATE, dtype=f32), (DEPTH, S5_GROUPS, S5_STATE)) + 0.0
    s5_log_dt = jax.random.uniform(ks[7], (DEPTH, S5_GROUPS), f32, math.log(S5_DT_MIN), math.log(S5_DT_MAX))
    s5_b_re = nrm(ks[8], (DEPTH, S5_GROUPS, S5_STATE, S5_GROUP), f32) * (2.0 * S5_GROUP) ** -0.5
    s5_b_im = nrm(ks[9], (DEPTH, S5_GROUPS, S5_STATE, S5_GROUP), f32) * (2.0 * S5_GROUP) ** -0.5
    s5_c_re = nrm(ks[10], (DEPTH, S5_GROUPS, S5_GROUP, S5_STATE), f32) * (2.0 * S5_STATE) ** -0.5
    s5_c_im = nrm(ks[11], (DEPTH, S5_GROUPS, S5_GROUP, S5_STATE), f32) * (2.0 * S5_STATE) ** -0.5
    s5_d = nrm(ks[12], (DEPTH, S5_WIDTH), f32)
    s5_w_glu = nrm(ks[13], (DEPTH, S5_WIDTH, S5_WIDTH), f32) * S5_WIDTH ** -0.5
    s5_b_glu = 0.02 * nrm(ks[14], (DEPTH, S5_WIDTH), f32)
    mla_q_norm = 1.0 + 0.02 * nrm(ks[15], (DEPTH, Q_LORA), f32)
    mla_w_uq = nrm(ks[16], (DEPTH, Q_LORA, MLA_HEADS * (MLA_NOPE + MLA_ROPE)), f32) * Q_LORA ** -0.5
    mla_kv_norm = 1.0 + 0.02 * nrm(ks[17], (DEPTH, KV_LORA), f32)
    mla_w_ukv = nrm(ks[18], (DEPTH, KV_LORA, MLA_HEADS * (MLA_NOPE + MLA_V)), f32) * KV_LORA ** -0.5
    gn_s5 = 1.0 + 0.02 * nrm(ks[19], (DEPTH, S5_WIDTH), f32)
    gn_mla = 1.0 + 0.02 * nrm(ks[20], (DEPTH, MLA_WIDTH), f32)
    w_out = nrm(ks[21], (DEPTH, D_MIX, D_MODEL), f32) * (D_MIX ** -0.5 * DEEPNORM_BETA)
    ln1_g = 1.0 + 0.02 * nrm(ks[22], (DEPTH, D_MODEL), f32)
    ln1_b = 0.02 * nrm(ks[23], (DEPTH, D_MODEL), f32)
    peer_w_query = nrm(ks[24], (DEPTH, D_MODEL, PEER_HEADS * PEER_QDIM), f32) * D_MODEL ** -0.5
    peer_keys1 = nrm(ks[25], (DEPTH, PEER_HEADS, PEER_NKEYS, PEER_HALF), f32) * PEER_HALF ** -0.5
    peer_keys2 = nrm(ks[26], (DEPTH, PEER_HEADS, PEER_NKEYS, PEER_HALF), f32) * PEER_HALF ** -0.5
    peer_u = nrm(ks[27], (DEPTH, PEER_EXPERTS, D_MODEL), f32) * D_MODEL ** -0.5
    peer_v = nrm(ks[28], (DEPTH, PEER_EXPERTS, D_MODEL), f32) * DEEPNORM_BETA
    ln2_g = 1.0 + 0.02 * nrm(ks[29], (DEPTH, D_MODEL), f32)
    ln2_b = 0.02 * nrm(ks[30], (DEPTH, D_MODEL), f32)
    return {"x": x, "c": c, "positions": positions, "w_ada": w_ada, "b_ada": b_ada, "w_in": w_in,
            "s5_lambda_re": s5_lambda_re, "s5_lambda_im": s5_lambda_im, "s5_log_dt": s5_log_dt,
            "s5_b_re": s5_b_re, "s5_b_im": s5_b_im, "s5_c_re": s5_c_re, "s5_c_im": s5_c_im,
            "s5_d": s5_d, "s5_w_glu": s5_w_glu, "s5_b_glu": s5_b_glu,
            "mla_q_norm": mla_q_norm, "mla_w_uq": mla_w_uq, "mla_kv_norm": mla_kv_norm, "mla_w_ukv": mla_w_ukv,
            "gn_s5": gn_s5, "gn_mla": gn_mla, "w_out": w_out, "ln1_g": ln1_g, "ln1_b": ln1_b,
            "peer_w_query": peer_w_query, "peer_keys1": peer_keys1, "peer_keys2": peer_keys2,
            "peer_u": peer_u, "peer_v": peer_v, "ln2_g": ln2_g, "ln2_b": ln2_b}


def reference(x, c, positions, w_ada, b_ada, w_in,
              s5_lambda_re, s5_lambda_im, s5_log_dt, s5_b_re, s5_b_im, s5_c_re, s5_c_im,
              s5_d, s5_w_glu, s5_b_glu,
              mla_q_norm, mla_w_uq, mla_kv_norm, mla_w_ukv,
              gn_s5, gn_mla, w_out, ln1_g, ln1_b,
              peer_w_query, peer_keys1, peer_keys2, peer_u, peer_v, ln2_g, ln2_b):
    cos, sin = _rope_angles(positions)
    c_act = jax.nn.silu(c)
    splits = [S5_WIDTH, S5_WIDTH + Q_LORA, S5_WIDTH + Q_LORA + KV_LORA]
    for l in range(DEPTH):
        mod = c_act @ w_ada[l] + b_ada[l]
        sh1, sc1, g1, sh2, sc2, g2 = jnp.split(mod[:, None, :], 6, axis=-1)
        h = x * (1.0 + sc1) + sh1
        proj = h @ w_in[l]
        u, cq, ckv, kr = jnp.split(proj, splits, axis=-1)
        y_s5 = _s5_mixer(u, s5_lambda_re[l], s5_lambda_im[l], s5_log_dt[l], s5_b_re[l], s5_b_im[l],
                         s5_c_re[l], s5_c_im[l], s5_d[l], s5_w_glu[l], s5_b_glu[l])
        y_mla = _mla_mixer(cq, ckv, kr, cos, sin, mla_q_norm[l], mla_w_uq[l], mla_kv_norm[l], mla_w_ukv[l])
        y_mix = jnp.concatenate([_rmsnorm(y_s5, gn_s5[l]), _rmsnorm(y_mla, gn_mla[l])], axis=-1) @ w_out[l]
        x = _layernorm(DEEPNORM_ALPHA * x + (1.0 + g1) * y_mix, ln1_g[l], ln1_b[l])
        h = x * (1.0 + sc2) + sh2
        y_ff = _peer(h, peer_w_query[l], peer_keys1[l], peer_keys2[l], peer_u[l], peer_v[l])
        x = _layernorm(DEEPNORM_ALPHA * x + (1.0 + g2) * y_ff, ln2_g[l], ln2_b[l])
    return x
```

```cpp
#include <hip/hip_runtime.h>
#include <hip/hip_bf16.h>
#include <stdint.h>

namespace nv {
constexpr int DM = 1024, SEQ = 8192, NB = 8, DIN = 1184;
constexpr float EPS = 1e-6f;

__device__ __forceinline__ float gelu_tanh(float x) {
    return 0.5f * x * (1.0f + tanhf(0.7978845608028654f * (x + 0.044715f * x * x * x)));
}

__global__ void k_mod(const float* __restrict__ c, const float* __restrict__ w_ada, const float* __restrict__ b_ada, float* __restrict__ mod) {
    const int n = blockIdx.x * 256 + threadIdx.x, b = blockIdx.y;
    float acc = b_ada[n];
    for (int k = 0; k < DM; ++k) { const float cv = c[b * DM + k]; const float s = cv / (1.0f + expf(-cv)); acc += s * w_ada[(size_t)k * 6144 + n]; }
    mod[b * 6144 + n] = acc;
}
__global__ void k_modulate(const float* __restrict__ x, const float* __restrict__ sh, const float* __restrict__ sc, float* __restrict__ h, int n) {
    const size_t i = (size_t)blockIdx.x * 256 + threadIdx.x;
    if (i < (size_t)n * DM) { const int d = (int)(i & (DM - 1)); h[i] = x[i] * (1.0f + sc[d]) + sh[d]; }
}
__global__ __launch_bounds__(256) void k_gemm(const float* __restrict__ A, int lda, const float* __restrict__ B, int sbk, int sbn, const float* __restrict__ bias,
                                               float* __restrict__ C, int ldc, int M, int N, int K) {
    __shared__ float As[16][68], Bs[16][68];
    const int tid = threadIdx.x, tx = tid & 15, ty = tid >> 4, m0 = blockIdx.y * 64, n0 = blockIdx.x * 64;
    float acc[4][4];
#pragma unroll
    for (int i = 0; i < 4; ++i)
#pragma unroll
        for (int j = 0; j < 4; ++j) acc[i][j] = 0.f;
    for (int k0 = 0; k0 < K; k0 += 16) {
#pragma unroll
        for (int i = 0; i < 4; ++i) { const int idx = tid + i * 256, r = idx >> 4, kk = idx & 15; As[kk][r] = A[(size_t)(m0 + r) * lda + k0 + kk]; }
#pragma unroll
        for (int i = 0; i < 4; ++i) { const int idx = tid + i * 256, kk = idx >> 6, nn = idx & 63; Bs[kk][nn] = (n0 + nn < N) ? B[(size_t)(k0 + kk) * sbk + (size_t)(n0 + nn) * sbn] : 0.f; }
        __syncthreads();
#pragma unroll
        for (int kk = 0; kk < 16; ++kk) {
            float a[4], b[4];
#pragma unroll
            for (int i = 0; i < 4; ++i) { a[i] = As[kk][ty * 4 + i]; b[i] = Bs[kk][tx * 4 + i]; }
#pragma unroll
            for (int i = 0; i < 4; ++i)
#pragma unroll
                for (int j = 0; j < 4; ++j) acc[i][j] += a[i] * b[j];
        }
        __syncthreads();
    }
#pragma unroll
    for (int i = 0; i < 4; ++i)
#pragma unroll
        for (int j = 0; j < 4; ++j) { const int n = n0 + tx * 4 + j; if (n < N) C[(size_t)(m0 + ty * 4 + i) * ldc + n] = acc[i][j] + (bias ? bias[n] : 0.f); }
}
__global__ __launch_bounds__(64) void k_s5(const float* __restrict__ proj, const float* __restrict__ lam_re, const float* __restrict__ lam_im, const float* __restrict__ log_dt,
                                            const float* __restrict__ b_re, const float* __restrict__ b_im, const float* __restrict__ c_re, const float* __restrict__ c_im,
                                            const float* __restrict__ dd, float* __restrict__ y, int n) {
    __shared__ float Sre[64][65], Sim[64][65], Cre[64][16], Cim[64][16], U[64][16];
    const int g = blockIdx.x, p = threadIdx.x;
    const float dt = expf(log_dt[g]), lr = lam_re[g * 64 + p], li = lam_im[g * 64 + p];
    const float mag = expf(lr * dt), abr = mag * cosf(li * dt), abi = mag * sinf(li * dt);
    const float den = lr * lr + li * li, nr = abr - 1.0f, cr = (nr * lr + abi * li) / den, ci = (abi * lr - nr * li) / den;
    float bbr[16], bbi[16];
#pragma unroll
    for (int h = 0; h < 16; ++h) { const float br = b_re[(g * 64 + p) * 16 + h], bi = b_im[(g * 64 + p) * 16 + h]; bbr[h] = cr * br - ci * bi; bbi[h] = cr * bi + ci * br; }
#pragma unroll
    for (int h = 0; h < 16; ++h) { Cre[p][h] = c_re[(g * 16 + h) * 64 + p]; Cim[p][h] = c_im[(g * 16 + h) * 64 + p]; }
    float sr = 0.f, si = 0.f;
    for (int t0 = 0; t0 < n; t0 += 64) {
        __syncthreads();
#pragma unroll
        for (int i = 0; i < 16; ++i) { const int idx = p + i * 64, tt = idx >> 4, h = idx & 15; U[tt][h] = proj[(size_t)(t0 + tt) * DIN + g * 16 + h]; }
        __syncthreads();
        for (int tt = 0; tt < 64; ++tt) {
            float bur = 0.f, bui = 0.f;
#pragma unroll
            for (int h = 0; h < 16; ++h) { const float uv = U[tt][h]; bur += bbr[h] * uv; bui += bbi[h] * uv; }
            const float nsr = abr * sr - abi * si + bur, nsi = abr * si + abi * sr + bui; sr = nsr; si = nsi;
            Sre[tt][p] = sr; Sim[tt][p] = si;
        }
        __syncthreads();
        float yv[16];
#pragma unroll
        for (int h = 0; h < 16; ++h) yv[h] = 0.f;
        for (int q = 0; q < 64; ++q) { const float a = Sre[p][q], b = Sim[p][q];
#pragma unroll
            for (int h = 0; h < 16; ++h) yv[h] += Cre[q][h] * a - Cim[q][h] * b; }
#pragma unroll
        for (int h = 0; h < 16; ++h) y[(size_t)(t0 + p) * 512 + g * 16 + h] = yv[h] + dd[g * 16 + h] * U[p][h];
    }
}
__global__ void k_gelu(float* __restrict__ y, size_t cnt) { const size_t i = (size_t)blockIdx.x * 256 + threadIdx.x; if (i < cnt) y[i] = gelu_tanh(y[i]); }
__global__ void k_glu(float* __restrict__ y, const float* __restrict__ z, size_t cnt) { const size_t i = (size_t)blockIdx.x * 256 + threadIdx.x; if (i < cnt) y[i] = y[i] / (1.0f + expf(-z[i])); }
__global__ __launch_bounds__(256) void k_rmsnorm(const float* __restrict__ in, int ldi, const float* __restrict__ g, float* __restrict__ out, int ldo, int ncols, int nrows) {
    const int row = blockIdx.x * 4 + (threadIdx.x >> 6), lane = threadIdx.x & 63;
    if (row >= nrows) return;
    float s = 0.f;
    for (int c = lane; c < ncols; c += 64) { const float v = in[(size_t)row * ldi + c]; s += v * v; }
#pragma unroll
    for (int o = 32; o > 0; o >>= 1) s += __shfl_xor(s, o);
    const float r = 1.0f / sqrtf(s / (float)ncols + EPS);
    for (int c = lane; c < ncols; c += 64) out[(size_t)row * ldo + c] = in[(size_t)row * ldi + c] * r * g[c];
}
__global__ void k_rope_tab(const int* __restrict__ pos, float* __restrict__ cs, int n) {
    const int idx = blockIdx.x * 256 + threadIdx.x; if (idx >= n * 16) return;
    const int t = idx >> 4, i = idx & 15;
    const double ang = (double)pos[t] * exp(-log(10000.0) * (double)i / 16.0);
    cs[idx * 2] = (float)cos(ang); cs[idx * 2 + 1] = (float)sin(ang);
}
__global__ void k_rope(float* __restrict__ buf, int ld, int off, int hs, int nh, const float* __restrict__ cs, int n) {
    const int idx = blockIdx.x * 256 + threadIdx.x; if (idx >= n * nh * 16) return;
    const int i = idx & 15, h = (idx >> 4) % nh, t = (idx >> 4) / nh;
    float* p = buf + (size_t)t * ld + off + h * hs;
    const float c = cs[(t * 16 + i) * 2], s = cs[(t * 16 + i) * 2 + 1], x1 = p[i], x2 = p[16 + i];
    p[i] = x1 * c - x2 * s; p[16 + i] = x2 * c + x1 * s;
}
__global__ void k_copy_cols(const float* __restrict__ src, int lds_, float* __restrict__ dst, int ldd, int ncols, int nrows) {
    const int idx = blockIdx.x * 256 + threadIdx.x; if (idx >= nrows * ncols) return;
    const int r = idx / ncols, c = idx % ncols; dst[(size_t)r * ldd + c] = src[(size_t)r * lds_ + c];
}
__global__ __launch_bounds__(256) void k_attn(const float* __restrict__ q, const float* __restrict__ kv, const float* __restrict__ kpe, float* __restrict__ out) {
    __shared__ float Qs[64][97], Ks[64][97], Vs[64][65], Ss[64][65];
    const int qc = blockIdx.x, h = blockIdx.y, tid = threadIdx.x, qi = tid >> 2, part = tid & 3;
    for (int idx = tid; idx < 64 * 96; idx += 256) { const int r = idx / 96, c = idx % 96; Qs[r][c] = q[(size_t)(qc * 64 + r) * 768 + h * 96 + c]; }
    float m = -INFINITY, l = 0.f, o[16];
#pragma unroll
    for (int d = 0; d < 16; ++d) o[d] = 0.f;
    const float scale = 0.10206207261596577f;
    for (int kc = 0; kc <= qc; ++kc) {
        __syncthreads();
        for (int idx = tid; idx < 64 * 96; idx += 256) { const int r = idx / 96, c = idx % 96;
            Ks[r][c] = (c < 64) ? kv[(size_t)(kc * 64 + r) * 1024 + h * 128 + c] : kpe[(size_t)(kc * 64 + r) * 32 + (c - 64)]; }
        for (int idx = tid; idx < 64 * 64; idx += 256) { const int r = idx >> 6, c = idx & 63; Vs[r][c] = kv[(size_t)(kc * 64 + r) * 1024 + h * 128 + 64 + c]; }
        __syncthreads();
        for (int jj = 0; jj < 16; ++jj) { const int j = jj * 4 + part; float s = 0.f;
            for (int c = 0; c < 96; ++c) s += Qs[qi][c] * Ks[j][c];
            Ss[qi][j] = s * scale; }
        __syncthreads();
        float mt = -INFINITY;
        for (int j = 0; j < 64; ++j) mt = fmaxf(mt, Ss[qi][j]);
        const float mnew = fmaxf(m, mt), alpha = expf(m - mnew);
        float psum = 0.f;
#pragma unroll
        for (int d = 0; d < 16; ++d) o[d] *= alpha;
        for (int j = 0; j < 64; ++j) { const float pj = expf(Ss[qi][j] - mnew); psum += pj;
#pragma unroll
            for (int d = 0; d < 16; ++d) o[d] += pj * Vs[j][part * 16 + d]; }
        l = l * alpha + psum; m = mnew;
    }
#pragma unroll
    for (int d = 0; d < 16; ++d) out[(size_t)(qc * 64 + qi) * 512 + h * 64 + part * 16 + d] = o[d] / l;
}
__global__ __launch_bounds__(256) void k_ln(const float* __restrict__ x, const float* __restrict__ y, const float* __restrict__ gate, const float* __restrict__ gam, const float* __restrict__ bet,
                                             float* __restrict__ out, float alpha) {
    __shared__ float red[8];
    const int r = blockIdx.x, tid = threadIdx.x;
    float v[4], s = 0.f;
#pragma unroll
    for (int i = 0; i < 4; ++i) { const int c = tid + i * 256; v[i] = alpha * x[(size_t)r * DM + c] + (1.0f + gate[c]) * y[(size_t)r * DM + c]; s += v[i]; }
#pragma unroll
    for (int o = 32; o > 0; o >>= 1) s += __shfl_xor(s, o);
    if ((tid & 63) == 0) red[tid >> 6] = s;
    __syncthreads();
    const float mu = (red[0] + red[1] + red[2] + red[3]) * (1.0f / DM);
    float q = 0.f;
#pragma unroll
    for (int i = 0; i < 4; ++i) { const float d = v[i] - mu; q += d * d; }
#pragma unroll
    for (int o = 32; o > 0; o >>= 1) q += __shfl_xor(q, o);
    if ((tid & 63) == 0) red[4 + (tid >> 6)] = q;
    __syncthreads();
    const float rstd = 1.0f / sqrtf((red[4] + red[5] + red[6] + red[7]) * (1.0f / DM) + EPS);
#pragma unroll
    for (int i = 0; i < 4; ++i) { const int c = tid + i * 256; out[(size_t)r * DM + c] = (v[i] - mu) * rstd * gam[c] + bet[c]; }
}
#define NV_INSERT(xv, xi)                                                                             \
    {                                                                                                \
        _Pragma("unroll") for (int j = 15; j >= 1; --j) {                                             \
            const bool take = (xv) > L[j - 1], sel = (xv) > L[j];                                     \
            const float nl = take ? L[j - 1] : (sel ? (xv) : L[j]);                                   \
            const int ni = take ? I[j - 1] : (sel ? (xi) : I[j]);                                     \
            L[j] = nl; I[j] = ni;                                                                     \
        }                                                                                            \
        if ((xv) > L[0]) { L[0] = (xv); I[0] = (xi); }                                                \
    }
__global__ void k_topk1(const float* __restrict__ s, float* __restrict__ vals, int* __restrict__ idxs, int cnt) {
    const int id = blockIdx.x * 256 + threadIdx.x; if (id >= cnt) return;
    float L[16]; int I[16];
#pragma unroll
    for (int j = 0; j < 16; ++j) { L[j] = -INFINITY; I[j] = 0; }
    const float* sp = s + (size_t)id * 128;
    for (int k = 0; k < 128; ++k) { const float xv = sp[k]; NV_INSERT(xv, k) }
#pragma unroll
    for (int j = 0; j < 16; ++j) { vals[(size_t)id * 16 + j] = L[j]; idxs[(size_t)id * 16 + j] = I[j]; }
}
__global__ void k_topk2(const float* __restrict__ v1, const int* __restrict__ i1, const float* __restrict__ v2, const int* __restrict__ i2,
                        int* __restrict__ ids, float* __restrict__ gates, int cnt) {
    const int id = blockIdx.x * 256 + threadIdx.x; if (id >= cnt) return;
    float L[16]; int I[16];
#pragma unroll
    for (int j = 0; j < 16; ++j) { L[j] = -INFINITY; I[j] = 0; }
    for (int c = 0; c < 256; ++c) { const float xv = v1[(size_t)id * 16 + (c >> 4)] + v2[(size_t)id * 16 + (c & 15)]; NV_INSERT(xv, c) }
    float den = 0.f, e[16];
#pragma unroll
    for (int j = 0; j < 16; ++j) { e[j] = expf(L[j] - L[0]); den += e[j]; }
#pragma unroll
    for (int j = 0; j < 16; ++j) {
        ids[(size_t)id * 16 + j] = i1[(size_t)id * 16 + (I[j] >> 4)] * 128 + i2[(size_t)id * 16 + (I[j] & 15)];
        gates[(size_t)id * 16 + j] = e[j] / den;
    }
}
__global__ __launch_bounds__(256) void k_peer(const float* __restrict__ h, const int* __restrict__ ids, const float* __restrict__ gates, const float* __restrict__ ut, const float* __restrict__ vt,
                                               float* __restrict__ yff, int n) {
    const int t = blockIdx.x * 4 + (threadIdx.x >> 6), lane = threadIdx.x & 63;
    if (t >= n) return;
    float4 hr[4], acc[4];
#pragma unroll
    for (int i = 0; i < 4; ++i) { hr[i] = *(const float4*)(h + (size_t)t * DM + i * 256 + lane * 4); acc[i] = make_float4(0.f, 0.f, 0.f, 0.f); }
    for (int e = 0; e < 128; ++e) {
        const int id = ids[(size_t)t * 128 + e]; const float g = gates[(size_t)t * 128 + e];
        const float* ur = ut + (size_t)id * DM; const float* vr = vt + (size_t)id * DM;
        float d = 0.f;
#pragma unroll
        for (int i = 0; i < 4; ++i) { const float4 u4 = *(const float4*)(ur + i * 256 + lane * 4); d += u4.x * hr[i].x + u4.y * hr[i].y + u4.z * hr[i].z + u4.w * hr[i].w; }
#pragma unroll
        for (int o = 32; o > 0; o >>= 1) d += __shfl_xor(d, o);
        const float w = g * gelu_tanh(d);
#pragma unroll
        for (int i = 0; i < 4; ++i) { const float4 v4 = *(const float4*)(vr + i * 256 + lane * 4); acc[i].x += w * v4.x; acc[i].y += w * v4.y; acc[i].z += w * v4.z; acc[i].w += w * v4.w; }
    }
#pragma unroll
    for (int i = 0; i < 4; ++i) *(float4*)(yff + (size_t)t * DM + i * 256 + lane * 4) = acc[i];
}

struct In {
    const float *x, *c; const int* pos; const float *w_ada, *b_ada, *w_in, *lam_re, *lam_im, *log_dt, *b_re, *b_im, *c_re, *c_im, *s5_d, *w_glu, *b_glu, *q_norm, *w_uq, *kv_norm, *w_ukv,
        *gn_s5, *gn_mla, *w_out, *ln1_g, *ln1_b, *w_query, *keys1, *keys2, *pu, *pv, *ln2_g, *ln2_b;
};
static inline dim3 g1(size_t cnt) { return dim3((unsigned)((cnt + 255) / 256)); }
static void gemm(hipStream_t st, const float* A, int lda, const float* B, int sbk, int sbn, const float* bias, float* C, int ldc, int M, int N, int K) {
    k_gemm<<<dim3((N + 63) / 64, M / 64), 256, 0, st>>>(A, lda, B, sbk, sbn, bias, C, ldc, M, N, K);
}
static void forward_batch(const In& I, int b, float* mod, float* ws, float* out, hipStream_t st) {
    const int n = SEQ; const size_t N1 = (size_t)n;
    float* p = ws;
    auto take = [&](size_t cnt) { float* r = p; p += (cnt + 63) / 64 * 64; return r; };
    float* hbuf = take(N1 * 1024); float* proj = take(N1 * DIN); float* ys5 = take(N1 * 512); float* z = take(N1 * 512);
    float* cqn = take(N1 * 384); float* ckvn = take(N1 * 256); float* q = take(N1 * 768); float* kv = take(N1 * 1024); float* cs = take(N1 * 32);
    float* ymla = take(N1 * 512); float* ycat = take(N1 * 1024); float* ymix = take(N1 * 1024); float* x1 = take(N1 * 1024);
    float* qp = take(N1 * 2048); float* s1 = take(N1 * 1024); float* s2 = take(N1 * 1024);
    float* v1 = take(N1 * 128); float* v2 = take(N1 * 128); int* i1 = (int*)take(N1 * 128); int* i2 = (int*)take(N1 * 128); int* ids = (int*)take(N1 * 128); float* gates = take(N1 * 128);
    float* yff = ycat;
    const float* xb = I.x + (size_t)b * n * DM; const float* mb = mod + b * 6144; const int* posb = I.pos + (size_t)b * n;
    const float *sh1 = mb, *sc1 = mb + 1024, *gt1 = mb + 2048, *sh2 = mb + 3072, *sc2 = mb + 4096, *gt2 = mb + 5120;
    k_modulate<<<g1(N1 * DM), 256, 0, st>>>(xb, sh1, sc1, hbuf, n);
    gemm(st, hbuf, DM, I.w_in, DIN, 1, nullptr, proj, DIN, n, DIN, DM);
    k_s5<<<32, 64, 0, st>>>(proj, I.lam_re, I.lam_im, I.log_dt, I.b_re, I.b_im, I.c_re, I.c_im, I.s5_d, ys5, n);
    k_gelu<<<g1(N1 * 512), 256, 0, st>>>(ys5, N1 * 512);
    gemm(st, ys5, 512, I.w_glu, 512, 1, I.b_glu, z, 512, n, 512, 512);
    k_glu<<<g1(N1 * 512), 256, 0, st>>>(ys5, z, N1 * 512);
    k_rmsnorm<<<n / 4, 256, 0, st>>>(ys5, 512, I.gn_s5, ycat, 1024, 512, n);
    k_rmsnorm<<<n / 4, 256, 0, st>>>(proj + 512, DIN, I.q_norm, cqn, 384, 384, n);
    k_rmsnorm<<<n / 4, 256, 0, st>>>(proj + 896, DIN, I.kv_norm, ckvn, 256, 256, n);
    gemm(st, cqn, 384, I.w_uq, 768, 1, nullptr, q, 768, n, 768, 384);
    gemm(st, ckvn, 256, I.w_ukv, 1024, 1, nullptr, kv, 1024, n, 1024, 256);
    k_rope_tab<<<g1(N1 * 16), 256, 0, st>>>(posb, cs, n);
    k_rope<<<g1(N1 * 8 * 16), 256, 0, st>>>(q, 768, 64, 96, 8, cs, n);
    k_rope<<<g1(N1 * 16), 256, 0, st>>>(proj, DIN, 1152, 0, 1, cs, n);
    float* kpe = z;
    k_copy_cols<<<g1(N1 * 32), 256, 0, st>>>(proj + 1152, DIN, kpe, 32, 32, n);
    k_attn<<<dim3(n / 64, 8), 256, 0, st>>>(q, kv, kpe, ymla);
    k_rmsnorm<<<n / 4, 256, 0, st>>>(ymla, 512, I.gn_mla, ycat + 512, 1024, 512, n);
    gemm(st, ycat, 1024, I.w_out, 1024, 1, nullptr, ymix, 1024, n, 1024, 1024);
    k_ln<<<n, 256, 0, st>>>(xb, ymix, gt1, I.ln1_g, I.ln1_b, x1, 1.189207115002721f);
    k_modulate<<<g1(N1 * DM), 256, 0, st>>>(x1, sh2, sc2, hbuf, n);
    gemm(st, hbuf, DM, I.w_query, 2048, 1, nullptr, qp, 2048, n, 2048, DM);
    for (int h = 0; h < 8; ++h) {
        gemm(st, qp + h * 256, 2048, I.keys1 + (size_t)h * 128 * 128, 1, 128, nullptr, s1 + h * 128, 1024, n, 128, 128);
        gemm(st, qp + h * 256 + 128, 2048, I.keys2 + (size_t)h * 128 * 128, 1, 128, nullptr, s2 + h * 128, 1024, n, 128, 128);
    }
    k_topk1<<<g1(N1 * 8), 256, 0, st>>>(s1, v1, i1, n * 8);
    k_topk1<<<g1(N1 * 8), 256, 0, st>>>(s2, v2, i2, n * 8);
    k_topk2<<<g1(N1 * 8), 256, 0, st>>>(v1, i1, v2, i2, ids, gates, n * 8);
    k_peer<<<n / 4, 256, 0, st>>>(hbuf, ids, gates, I.pu, I.pv, yff, n);
    k_ln<<<n, 256, 0, st>>>(x1, yff, gt2, I.ln2_g, I.ln2_b, out + (size_t)b * n * DM, 1.189207115002721f);
}
}

extern "C" void kernel_launch(void* const* d_in, const int* in_sizes, int n_in, void* d_out, int out_size, void* d_ws, size_t ws_size, hipStream_t stream) {
    nv::In I;
    I.x = (const float*)d_in[0]; I.c = (const float*)d_in[1]; I.pos = (const int*)d_in[2]; I.w_ada = (const float*)d_in[3]; I.b_ada = (const float*)d_in[4]; I.w_in = (const float*)d_in[5];
    I.lam_re = (const float*)d_in[6]; I.lam_im = (const float*)d_in[7]; I.log_dt = (const float*)d_in[8]; I.b_re = (const float*)d_in[9]; I.b_im = (const float*)d_in[10];
    I.c_re = (const float*)d_in[11]; I.c_im = (const float*)d_in[12]; I.s5_d = (const float*)d_in[13]; I.w_glu = (const float*)d_in[14]; I.b_glu = (const float*)d_in[15];
    I.q_norm = (const float*)d_in[16]; I.w_uq = (const float*)d_in[17]; I.kv_norm = (const float*)d_in[18]; I.w_ukv = (const float*)d_in[19]; I.gn_s5 = (const float*)d_in[20];
    I.gn_mla = (const float*)d_in[21]; I.w_out = (const float*)d_in[22]; I.ln1_g = (const float*)d_in[23]; I.ln1_b = (const float*)d_in[24]; I.w_query = (const float*)d_in[25];
    I.keys1 = (const float*)d_in[26]; I.keys2 = (const float*)d_in[27]; I.pu = (const float*)d_in[28]; I.pv = (const float*)d_in[29]; I.ln2_g = (const float*)d_in[30]; I.ln2_b = (const float*)d_in[31];
    float* ws = (float*)d_ws;
    float* mod = ws;
    float* arena = ws + 8 * 6144;
    nv::k_mod<<<dim3(24, 8), 256, 0, stream>>>(I.c, I.w_ada, I.b_ada, mod);
    for (int b = 0; b < nv::NB; ++b) nv::forward_batch(I, b, mod, arena, (float*)d_out, stream);
}
```

```cpp
#include <hip/hip_runtime.h>
#include <hip/hip_bf16.h>
#include <stdint.h>
#include <stdio.h>

#define XB_TMO      128
#define XB_XCNT(j)  (256  + 64 * (j))
#define XB_XSUB(j)  (1280 + 64 * (j))
#define XB_XGEN(j)  (2304 + 64 * (j))
#define XB_TOP      3328
#define XB_TOPGEN   3392
#define XCD_BAR_WORDS 3456
#define XB_SPIN_CAP (1u << 22)
#define LAS __attribute__((address_space(3)))

__device__ __forceinline__ unsigned xb_ld(unsigned* p)              { return __hip_atomic_load(p, __ATOMIC_RELAXED, __HIP_MEMORY_SCOPE_AGENT); }
__device__ __forceinline__ unsigned xb_add(unsigned* p, unsigned v) { return __hip_atomic_fetch_add(p, v, __ATOMIC_RELAXED, __HIP_MEMORY_SCOPE_AGENT); }
__device__ __forceinline__ unsigned xb_xcc_id() { return (unsigned)__builtin_amdgcn_s_getreg((3 << 11) | 20) & 0xFu; }
#define XB_SPIN(cond, bar) do { unsigned _sp = 0; while (cond) { __builtin_amdgcn_s_sleep(1); \
    if ((++_sp & 255u) == 0u) { if (xb_ld(&(bar)[XB_TMO])) break; if (_sp > XB_SPIN_CAP) { atomicAdd(&(bar)[XB_TMO], 1u); break; } } } } while (0)

struct XcdBarrier {
    unsigned* bar; unsigned x;
    volatile LAS unsigned* st;
};

__device__ __forceinline__ XcdBarrier xcd_barrier_post(unsigned* bar, volatile LAS unsigned* st) {
    XcdBarrier b; b.bar = bar; b.x = xb_xcc_id(); b.st = st;
    if (threadIdx.x == 0) (void)xb_add(&bar[XB_XCNT(b.x)], 1u);
    return b;
}
__device__ __forceinline__ void xcd_barrier_complete(unsigned* bar, unsigned x, unsigned& nloc, unsigned& nx) {
    const unsigned G = gridDim.x * gridDim.y * gridDim.z;
    unsigned sum, cnt, mine, sp = 0u;
    for (;;) {
        sum = 0u; cnt = 0u; mine = 0u;
#pragma unroll
        for (unsigned j = 0; j < 16; ++j) { const unsigned c = xb_ld(&bar[XB_XCNT(j)]); sum += c; cnt += (c > 0u) ? 1u : 0u; mine = (j == x) ? c : mine; }
        if (sum == G) break;
        __builtin_amdgcn_s_sleep(1);
        if ((++sp & 255u) == 0u) { if (xb_ld(&bar[XB_TMO])) break; if (sp > XB_SPIN_CAP) { atomicAdd(&bar[XB_TMO], 1u); break; } }
    }
    nloc = mine > 0u ? mine : 1u; nx = cnt > 0u ? cnt : 1u;
}

__device__ __forceinline__ void xcd_barrier(const XcdBarrier& b) {
    asm volatile("s_waitcnt vmcnt(0)" ::: "memory");
    __syncthreads();
    if (threadIdx.x == 0) {
        unsigned* bar = b.bar;
        __builtin_amdgcn_s_waitcnt(0);
        unsigned nloc = b.st[0], nx = b.st[1];
        if (nloc == 0u) { xcd_barrier_complete(bar, b.x, nloc, nx); b.st[0] = nloc; b.st[1] = nx; }
        const unsigned old = xb_add(&bar[XB_XSUB(b.x)], 1u);
        const unsigned gen = old / nloc;
        if (old + 1u == (gen + 1u) * nloc) {
            __builtin_amdgcn_fence(__ATOMIC_RELEASE, "agent");
            asm volatile("s_waitcnt vmcnt(0)" ::: "memory");
            const unsigned og = xb_add(&bar[XB_TOP], 1u);
            const unsigned tg = og / nx;
            if (og + 1u == (tg + 1u) * nx) xb_add(&bar[XB_TOPGEN], 1u);
            else XB_SPIN(xb_ld(&bar[XB_TOPGEN]) == tg, bar);
            __builtin_amdgcn_fence(__ATOMIC_ACQUIRE, "agent");
            xb_add(&bar[XB_XGEN(b.x)], 1u);
            asm volatile("s_waitcnt vmcnt(0)" ::: "memory");
        } else {
            XB_SPIN(xb_ld(&bar[XB_XGEN(b.x)]) == gen, bar);
            __builtin_amdgcn_fence(__ATOMIC_ACQUIRE, "agent");
            asm volatile("s_waitcnt vmcnt(0)" ::: "memory");
        }
    }
    __syncthreads();
}


namespace nv {
constexpr int DM = 1024, SEQ = 8192, NB = 8, DIN = 1184;
constexpr float EPS = 1e-6f;

__device__ __forceinline__ float gelu_tanh(float x) {
    return 0.5f * x * (1.0f + tanhf(0.7978845608028654f * (x + 0.044715f * x * x * x)));
}

__device__ __forceinline__ void d_mod(const float* __restrict__ c, const float* __restrict__ w_ada, const float* __restrict__ b_ada, float* __restrict__ mod, int bx, int by, char* smem) {
    const int n = bx * 256 + threadIdx.x, b = by;
    float acc = b_ada[n];
    for (int k = 0; k < DM; ++k) { const float cv = c[b * DM + k]; const float s = cv / (1.0f + expf(-cv)); acc += s * w_ada[(size_t)k * 6144 + n]; }
    mod[b * 6144 + n] = acc;
}
__device__ __forceinline__ void d_modulate(const float* __restrict__ x, const float* __restrict__ sh, const float* __restrict__ sc, float* __restrict__ h, int n, int bx, int by, char* smem) {
    const size_t i = (size_t)bx * 256 + threadIdx.x;
    if (i < (size_t)n * DM) { const int d = (int)(i & (DM - 1)); h[i] = x[i] * (1.0f + sc[d]) + sh[d]; }
}
__device__ __forceinline__ void d_gemm(const float* __restrict__ A, int lda, const float* __restrict__ B, int sbk, int sbn, const float* __restrict__ bias,
                                               float* __restrict__ C, int ldc, int M, int N, int K, int bx, int by, char* smem) {
    float (*As)[68] = (float (*)[68])smem; float (*Bs)[68] = (float (*)[68])(smem + 16 * 68 * 4);
    __syncthreads();
    const int tid = threadIdx.x, tx = tid & 15, ty = tid >> 4, m0 = by * 64, n0 = bx * 64;
    float acc[4][4];
#pragma unroll
    for (int i = 0; i < 4; ++i)
#pragma unroll
        for (int j = 0; j < 4; ++j) acc[i][j] = 0.f;
    for (int k0 = 0; k0 < K; k0 += 16) {
#pragma unroll
        for (int i = 0; i < 4; ++i) { const int idx = tid + i * 256, r = idx >> 4, kk = idx & 15; As[kk][r] = A[(size_t)(m0 + r) * lda + k0 + kk]; }
#pragma unroll
        for (int i = 0; i < 4; ++i) { const int idx = tid + i * 256, kk = idx >> 6, nn = idx & 63; Bs[kk][nn] = (n0 + nn < N) ? B[(size_t)(k0 + kk) * sbk + (size_t)(n0 + nn) * sbn] : 0.f; }
        __syncthreads();
#pragma unroll
        for (int kk = 0; kk < 16; ++kk) {
            float a[4], b[4];
#pragma unroll
            for (int i = 0; i < 4; ++i) { a[i] = As[kk][ty * 4 + i]; b[i] = Bs[kk][tx * 4 + i]; }
#pragma unroll
            for (int i = 0; i < 4; ++i)
#pragma unroll
                for (int j = 0; j < 4; ++j) acc[i][j] += a[i] * b[j];
        }
        __syncthreads();
    }
#pragma unroll
    for (int i = 0; i < 4; ++i)
#pragma unroll
        for (int j = 0; j < 4; ++j) { const int n = n0 + tx * 4 + j; if (n < N) C[(size_t)(m0 + ty * 4 + i) * ldc + n] = acc[i][j] + (bias ? bias[n] : 0.f); }
}
__device__ __forceinline__ void d_s5(const float* __restrict__ proj, const float* __restrict__ lam_re, const float* __restrict__ lam_im, const float* __restrict__ log_dt,
                                            const float* __restrict__ b_re, const float* __restrict__ b_im, const float* __restrict__ c_re, const float* __restrict__ c_im,
                                            const float* __restrict__ dd, float* __restrict__ y, int n, int bx, int by, char* smem) {
    float (*Sre)[65] = (float (*)[65])smem; float (*Sim)[65] = (float (*)[65])(smem + 64 * 65 * 4); float (*Cre)[16] = (float (*)[16])(smem + 2 * 64 * 65 * 4);
    float (*Cim)[16] = (float (*)[16])(smem + 2 * 64 * 65 * 4 + 64 * 16 * 4); float (*U)[16] = (float (*)[16])(smem + 2 * 64 * 65 * 4 + 2 * 64 * 16 * 4);
    __syncthreads();
    const int g = bx, p = threadIdx.x & 63;
    const float dt = expf(log_dt[g]), lr = lam_re[g * 64 + p], li = lam_im[g * 64 + p];
    const float mag = expf(lr * dt), abr = mag * cosf(li * dt), abi = mag * sinf(li * dt);
    const float den = lr * lr + li * li, nr = abr - 1.0f, cr = (nr * lr + abi * li) / den, ci = (abi * lr - nr * li) / den;
    float bbr[16], bbi[16];
#pragma unroll
    for (int h = 0; h < 16; ++h) { const float br = b_re[(g * 64 + p) * 16 + h], bi = b_im[(g * 64 + p) * 16 + h]; bbr[h] = cr * br - ci * bi; bbi[h] = cr * bi + ci * br; }
#pragma unroll
    for (int h = 0; h < 16; ++h) { Cre[p][h] = c_re[(g * 16 + h) * 64 + p]; Cim[p][h] = c_im[(g * 16 + h) * 64 + p]; }
    float sr = 0.f, si = 0.f;
    for (int t0 = 0; t0 < n; t0 += 64) {
        __syncthreads();
#pragma unroll
        for (int i = 0; i < 16; ++i) { const int idx = p + i * 64, tt = idx >> 4, h = idx & 15; U[tt][h] = proj[(size_t)(t0 + tt) * DIN + g * 16 + h]; }
        __syncthreads();
        for (int tt = 0; tt < 64; ++tt) {
            float bur = 0.f, bui = 0.f;
#pragma unroll
            for (int h = 0; h < 16; ++h) { const float uv = U[tt][h]; bur += bbr[h] * uv; bui += bbi[h] * uv; }
            const float nsr = abr * sr - abi * si + bur, nsi = abr * si + abi * sr + bui; sr = nsr; si = nsi;
            Sre[tt][p] = sr; Sim[tt][p] = si;
        }
        __syncthreads();
        float yv[16];
#pragma unroll
        for (int h = 0; h < 16; ++h) yv[h] = 0.f;
        for (int q = 0; q < 64; ++q) { const float a = Sre[p][q], b = Sim[p][q];
#pragma unroll
            for (int h = 0; h < 16; ++h) yv[h] += Cre[q][h] * a - Cim[q][h] * b; }
#pragma unroll
        for (int h = 0; h < 16; ++h) y[(size_t)(t0 + p) * 512 + g * 16 + h] = yv[h] + dd[g * 16 + h] * U[p][h];
    }
}
__device__ __forceinline__ void d_gelu(float* __restrict__ y, size_t cnt, int bx, int by, char* smem) { const size_t i = (size_t)bx * 256 + threadIdx.x; if (i < cnt) y[i] = gelu_tanh(y[i]); }
__device__ __forceinline__ void d_glu(float* __restrict__ y, const float* __restrict__ z, size_t cnt, int bx, int by, char* smem) { const size_t i = (size_t)bx * 256 + threadIdx.x; if (i < cnt) y[i] = y[i] / (1.0f + expf(-z[i])); }
__device__ __forceinline__ void d_rmsnorm(const float* __restrict__ in, int ldi, const float* __restrict__ g, float* __restrict__ out, int ldo, int ncols, int nrows, int bx, int by, char* smem) {
    const int row = bx * 4 + (threadIdx.x >> 6), lane = threadIdx.x & 63;
    if (row >= nrows) return;
    float s = 0.f;
    for (int c = lane; c < ncols; c += 64) { const float v = in[(size_t)row * ldi + c]; s += v * v; }
#pragma unroll
    for (int o = 32; o > 0; o >>= 1) s += __shfl_xor(s, o);
    const float r = 1.0f / sqrtf(s / (float)ncols + EPS);
    for (int c = lane; c < ncols; c += 64) out[(size_t)row * ldo + c] = in[(size_t)row * ldi + c] * r * g[c];
}
__device__ __forceinline__ void d_rope_tab(const int* __restrict__ pos, float* __restrict__ cs, int n, int bx, int by, char* smem) {
    const int idx = bx * 256 + threadIdx.x; if (idx >= n * 16) return;
    const int t = idx >> 4, i = idx & 15;
    const double ang = (double)pos[t] * exp(-log(10000.0) * (double)i / 16.0);
    cs[idx * 2] = (float)cos(ang); cs[idx * 2 + 1] = (float)sin(ang);
}
__device__ __forceinline__ void d_rope(float* __restrict__ buf, int ld, int off, int hs, int nh, const float* __restrict__ cs, int n, int bx, int by, char* smem) {
    const int idx = bx * 256 + threadIdx.x; if (idx >= n * nh * 16) return;
    const int i = idx & 15, h = (idx >> 4) % nh, t = (idx >> 4) / nh;
    float* p = buf + (size_t)t * ld + off + h * hs;
    const float c = cs[(t * 16 + i) * 2], s = cs[(t * 16 + i) * 2 + 1], x1 = p[i], x2 = p[16 + i];
    p[i] = x1 * c - x2 * s; p[16 + i] = x2 * c + x1 * s;
}
__device__ __forceinline__ void d_copy_cols(const float* __restrict__ src, int lds_, float* __restrict__ dst, int ldd, int ncols, int nrows, int bx, int by, char* smem) {
    const int idx = bx * 256 + threadIdx.x; if (idx >= nrows * ncols) return;
    const int r = idx / ncols, c = idx % ncols; dst[(size_t)r * ldd + c] = src[(size_t)r * lds_ + c];
}
__device__ __forceinline__ void d_attn(const float* __restrict__ q, const float* __restrict__ kv, const float* __restrict__ kpe, float* __restrict__ out, int bx, int by, char* smem) {
    float (*Qs)[97] = (float (*)[97])smem; float (*Ks)[97] = (float (*)[97])(smem + 64 * 97 * 4); float (*Vs)[65] = (float (*)[65])(smem + 2 * 64 * 97 * 4);
    float (*Ss)[65] = (float (*)[65])(smem + 2 * 64 * 97 * 4 + 64 * 65 * 4);
    __syncthreads();
    const int qc = bx, h = by, tid = threadIdx.x, qi = tid >> 2, part = tid & 3;
    for (int idx = tid; idx < 64 * 96; idx += 256) { const int r = idx / 96, c = idx % 96; Qs[r][c] = q[(size_t)(qc * 64 + r) * 768 + h * 96 + c]; }
    float m = -INFINITY, l = 0.f, o[16];
#pragma unroll
    for (int d = 0; d < 16; ++d) o[d] = 0.f;
    const float scale = 0.10206207261596577f;
    for (int kc = 0; kc <= qc; ++kc) {
        __syncthreads();
        for (int idx = tid; idx < 64 * 96; idx += 256) { const int r = idx / 96, c = idx % 96;
            Ks[r][c] = (c < 64) ? kv[(size_t)(kc * 64 + r) * 1024 + h * 128 + c] : kpe[(size_t)(kc * 64 + r) * 32 + (c - 64)]; }
        for (int idx = tid; idx < 64 * 64; idx += 256) { const int r = idx >> 6, c = idx & 63; Vs[r][c] = kv[(size_t)(kc * 64 + r) * 1024 + h * 128 + 64 + c]; }
        __syncthreads();
#pragma nounroll
        for (int jj = 0; jj < 16; ++jj) { const int j = jj * 4 + part; float s = 0.f;
#pragma unroll 8
            for (int c = 0; c < 96; ++c) s += Qs[qi][c] * Ks[j][c];
            Ss[qi][j] = s * scale; }
        __syncthreads();
        float mt = -INFINITY;
#pragma unroll 8
        for (int j = 0; j < 64; ++j) mt = fmaxf(mt, Ss[qi][j]);
        const float mnew = fmaxf(m, mt), alpha = expf(m - mnew);
        float psum = 0.f;
#pragma unroll
        for (int d = 0; d < 16; ++d) o[d] *= alpha;
#pragma unroll 2
        for (int j = 0; j < 64; ++j) { const float pj = expf(Ss[qi][j] - mnew); psum += pj;
#pragma unroll
            for (int d = 0; d < 16; ++d) o[d] += pj * Vs[j][part * 16 + d]; }
        l = l * alpha + psum; m = mnew;
    }
#pragma unroll
    for (int d = 0; d < 16; ++d) out[(size_t)(qc * 64 + qi) * 512 + h * 64 + part * 16 + d] = o[d] / l;
}
__device__ __forceinline__ void d_ln(const float* __restrict__ x, const float* __restrict__ y, const float* __restrict__ gate, const float* __restrict__ gam, const float* __restrict__ bet,
                                             float* __restrict__ out, float alpha, int bx, int by, char* smem) {
    float* red = (float*)smem;
    __syncthreads();
    const int r = bx, tid = threadIdx.x;
    float v[4], s = 0.f;
#pragma unroll
    for (int i = 0; i < 4; ++i) { const int c = tid + i * 256; v[i] = alpha * x[(size_t)r * DM + c] + (1.0f + gate[c]) * y[(size_t)r * DM + c]; s += v[i]; }
#pragma unroll
    for (int o = 32; o > 0; o >>= 1) s += __shfl_xor(s, o);
    if ((tid & 63) == 0) red[tid >> 6] = s;
    __syncthreads();
    const float mu = (red[0] + red[1] + red[2] + red[3]) * (1.0f / DM);
    float q = 0.f;
#pragma unroll
    for (int i = 0; i < 4; ++i) { const float d = v[i] - mu; q += d * d; }
#pragma unroll
    for (int o = 32; o > 0; o >>= 1) q += __shfl_xor(q, o);
    if ((tid & 63) == 0) red[4 + (tid >> 6)] = q;
    __syncthreads();
    const float rstd = 1.0f / sqrtf((red[4] + red[5] + red[6] + red[7]) * (1.0f / DM) + EPS);
#pragma unroll
    for (int i = 0; i < 4; ++i) { const int c = tid + i * 256; out[(size_t)r * DM + c] = (v[i] - mu) * rstd * gam[c] + bet[c]; }
}
#define NV_INSERT(xv, xi)                                                                             \
    {                                                                                                \
        _Pragma("unroll") for (int j = 15; j >= 1; --j) {                                             \
            const bool take = (xv) > L[j - 1], sel = (xv) > L[j];                                     \
            const float nl = take ? L[j - 1] : (sel ? (xv) : L[j]);                                   \
            const int ni = take ? I[j - 1] : (sel ? (xi) : I[j]);                                     \
            L[j] = nl; I[j] = ni;                                                                     \
        }                                                                                            \
        if ((xv) > L[0]) { L[0] = (xv); I[0] = (xi); }                                                \
    }
__device__ __forceinline__ void d_topk1(const float* __restrict__ s, float* __restrict__ vals, int* __restrict__ idxs, int cnt, int bx, int by, char* smem) {
    const int id = bx * 256 + threadIdx.x; if (id >= cnt) return;
    float L[16]; int I[16];
#pragma unroll
    for (int j = 0; j < 16; ++j) { L[j] = -INFINITY; I[j] = 0; }
    const float* sp = s + (size_t)id * 128;
    for (int k = 0; k < 128; ++k) { const float xv = sp[k]; NV_INSERT(xv, k) }
#pragma unroll
    for (int j = 0; j < 16; ++j) { vals[(size_t)id * 16 + j] = L[j]; idxs[(size_t)id * 16 + j] = I[j]; }
}
__device__ __forceinline__ void d_topk2(const float* __restrict__ v1, const int* __restrict__ i1, const float* __restrict__ v2, const int* __restrict__ i2,
                        int* __restrict__ ids, float* __restrict__ gates, int cnt, int bx, int by, char* smem) {
    const int id = bx * 256 + threadIdx.x; if (id >= cnt) return;
    float L[16]; int I[16];
#pragma unroll
    for (int j = 0; j < 16; ++j) { L[j] = -INFINITY; I[j] = 0; }
    for (int c = 0; c < 256; ++c) { const float xv = v1[(size_t)id * 16 + (c >> 4)] + v2[(size_t)id * 16 + (c & 15)]; NV_INSERT(xv, c) }
    float den = 0.f, e[16];
#pragma unroll
    for (int j = 0; j < 16; ++j) { e[j] = expf(L[j] - L[0]); den += e[j]; }
#pragma unroll
    for (int j = 0; j < 16; ++j) {
        ids[(size_t)id * 16 + j] = i1[(size_t)id * 16 + (I[j] >> 4)] * 128 + i2[(size_t)id * 16 + (I[j] & 15)];
        gates[(size_t)id * 16 + j] = e[j] / den;
    }
}
__device__ __forceinline__ void d_peer(const float* __restrict__ h, const int* __restrict__ ids, const float* __restrict__ gates, const float* __restrict__ ut, const float* __restrict__ vt,
                                               float* __restrict__ yff, int n, int bx, int by, char* smem) {
    const int t = bx * 4 + (threadIdx.x >> 6), lane = threadIdx.x & 63;
    if (t >= n) return;
    float4 hr[4], acc[4];
#pragma unroll
    for (int i = 0; i < 4; ++i) { hr[i] = *(const float4*)(h + (size_t)t * DM + i * 256 + lane * 4); acc[i] = make_float4(0.f, 0.f, 0.f, 0.f); }
    for (int e = 0; e < 128; ++e) {
        const int id = ids[(size_t)t * 128 + e]; const float g = gates[(size_t)t * 128 + e];
        const float* ur = ut + (size_t)id * DM; const float* vr = vt + (size_t)id * DM;
        float d = 0.f;
#pragma unroll
        for (int i = 0; i < 4; ++i) { const float4 u4 = *(const float4*)(ur + i * 256 + lane * 4); d += u4.x * hr[i].x + u4.y * hr[i].y + u4.z * hr[i].z + u4.w * hr[i].w; }
#pragma unroll
        for (int o = 32; o > 0; o >>= 1) d += __shfl_xor(d, o);
        const float w = g * gelu_tanh(d);
#pragma unroll
        for (int i = 0; i < 4; ++i) { const float4 v4 = *(const float4*)(vr + i * 256 + lane * 4); acc[i].x += w * v4.x; acc[i].y += w * v4.y; acc[i].z += w * v4.z; acc[i].w += w * v4.w; }
    }
#pragma unroll
    for (int i = 0; i < 4; ++i) *(float4*)(yff + (size_t)t * DM + i * 256 + lane * 4) = acc[i];
}


struct In {
    const float *x, *c; const int* pos; const float *w_ada, *b_ada, *w_in, *lam_re, *lam_im, *log_dt, *b_re, *b_im, *c_re, *c_im, *s5_d, *w_glu, *b_glu, *q_norm, *w_uq, *kv_norm, *w_ukv,
        *gn_s5, *gn_mla, *w_out, *ln1_g, *ln1_b, *w_query, *keys1, *keys2, *pu, *pv, *ln2_g, *ln2_b;
    float* ws; float* out; unsigned* bar; unsigned* pad_;
};
constexpr int MK_LDS = 2 * 64 * 97 * 4 + 2 * 64 * 65 * 4;
#define PH1(nvb, call) { for (int vb = blockIdx.x; vb < (int)(nvb); vb += gridDim.x) { const int bx = vb, by = 0; (void)by; call; } xcd_barrier(bar); }
#define PH2(nx, ny, call) { for (int vb = blockIdx.x; vb < (int)(nx) * (int)(ny); vb += gridDim.x) { const int bx = vb % (int)(nx), by = vb / (int)(nx); call; } xcd_barrier(bar); }
#define NBLK(cnt) (((cnt) + 255) / 256)
__global__ void __launch_bounds__(256, 1) mk_naive(In I) {
    extern __shared__ __attribute__((aligned(16))) char smem_all[];
    char* smem = smem_all + 16;
    if (threadIdx.x == 0) *(uint4*)smem_all = make_uint4(0u, 0u, 0u, 0u);
    __syncthreads();
    XcdBarrier bar = xcd_barrier_post(I.bar, (volatile LAS unsigned*)smem_all);
    float* mod = I.ws;
    float* p = I.ws + 8 * 6144;
    const int n = SEQ; const size_t N1 = (size_t)n;
#define TAKE(name, cnt) float* name = p; p += ((cnt) + 63) / 64 * 64;
    TAKE(hbuf, N1 * 1024) TAKE(proj, N1 * DIN) TAKE(ys5, N1 * 512) TAKE(z, N1 * 512) TAKE(cqn, N1 * 384) TAKE(ckvn, N1 * 256) TAKE(q, N1 * 768) TAKE(kv, N1 * 1024) TAKE(cs, N1 * 32)
    TAKE(ymla, N1 * 512) TAKE(ycat, N1 * 1024) TAKE(ymix, N1 * 1024) TAKE(x1, N1 * 1024) TAKE(qp, N1 * 2048) TAKE(s1, N1 * 1024) TAKE(s2, N1 * 1024)
    TAKE(v1, N1 * 128) TAKE(v2, N1 * 128) TAKE(i1f, N1 * 128) TAKE(i2f, N1 * 128) TAKE(idsf, N1 * 128) TAKE(gates, N1 * 128)
    int* i1 = (int*)i1f; int* i2 = (int*)i2f; int* ids = (int*)idsf;
    float* yff = ycat; float* kpe = z;
    PH2(24, 8, d_mod(I.c, I.w_ada, I.b_ada, mod, bx, by, smem))
    for (int b = 0; b < NB; ++b) {
        const float* xb = I.x + (size_t)b * n * DM; const float* mb = mod + b * 6144; const int* posb = I.pos + (size_t)b * n;
        const float *sh1 = mb, *sc1 = mb + 1024, *gt1 = mb + 2048, *sh2 = mb + 3072, *sc2 = mb + 4096, *gt2 = mb + 5120;
        PH1(NBLK(N1 * DM), d_modulate(xb, sh1, sc1, hbuf, n, bx, by, smem))
        PH2((DIN + 63) / 64, n / 64, d_gemm(hbuf, DM, I.w_in, DIN, 1, nullptr, proj, DIN, n, DIN, DM, bx, by, smem))
        PH1(32, d_s5(proj, I.lam_re, I.lam_im, I.log_dt, I.b_re, I.b_im, I.c_re, I.c_im, I.s5_d, ys5, n, bx, by, smem))
        PH1(NBLK(N1 * 512), d_gelu(ys5, N1 * 512, bx, by, smem))
        PH2(512 / 64, n / 64, d_gemm(ys5, 512, I.w_glu, 512, 1, I.b_glu, z, 512, n, 512, 512, bx, by, smem))
        PH1(NBLK(N1 * 512), d_glu(ys5, z, N1 * 512, bx, by, smem))
        PH1(n / 4, d_rmsnorm(ys5, 512, I.gn_s5, ycat, 1024, 512, n, bx, by, smem))
        PH1(n / 4, d_rmsnorm(proj + 512, DIN, I.q_norm, cqn, 384, 384, n, bx, by, smem))
        PH1(n / 4, d_rmsnorm(proj + 896, DIN, I.kv_norm, ckvn, 256, 256, n, bx, by, smem))
        PH2(768 / 64, n / 64, d_gemm(cqn, 384, I.w_uq, 768, 1, nullptr, q, 768, n, 768, 384, bx, by, smem))
        PH2(1024 / 64, n / 64, d_gemm(ckvn, 256, I.w_ukv, 1024, 1, nullptr, kv, 1024, n, 1024, 256, bx, by, smem))
        PH1(NBLK(N1 * 16), d_rope_tab(posb, cs, n, bx, by, smem))
        PH1(NBLK(N1 * 8 * 16), d_rope(q, 768, 64, 96, 8, cs, n, bx, by, smem))
        PH1(NBLK(N1 * 16), d_rope(proj, DIN, 1152, 0, 1, cs, n, bx, by, smem))
        PH1(NBLK(N1 * 32), d_copy_cols(proj + 1152, DIN, kpe, 32, 32, n, bx, by, smem))
        PH2(n / 64, 8, d_attn(q, kv, kpe, ymla, bx, by, smem))
        PH1(n / 4, d_rmsnorm(ymla, 512, I.gn_mla, ycat + 512, 1024, 512, n, bx, by, smem))
        PH2(1024 / 64, n / 64, d_gemm(ycat, 1024, I.w_out, 1024, 1, nullptr, ymix, 1024, n, 1024, 1024, bx, by, smem))
        PH1(n, d_ln(xb, ymix, gt1, I.ln1_g, I.ln1_b, x1, 1.189207115002721f, bx, by, smem))
        PH1(NBLK(N1 * DM), d_modulate(x1, sh2, sc2, hbuf, n, bx, by, smem))
        PH2(2048 / 64, n / 64, d_gemm(hbuf, DM, I.w_query, 2048, 1, nullptr, qp, 2048, n, 2048, DM, bx, by, smem))
        for (int h = 0; h < 8; ++h) {
            PH2(2, n / 64, d_gemm(qp + h * 256, 2048, I.keys1 + (size_t)h * 128 * 128, 1, 128, nullptr, s1 + h * 128, 1024, n, 128, 128, bx, by, smem))
            PH2(2, n / 64, d_gemm(qp + h * 256 + 128, 2048, I.keys2 + (size_t)h * 128 * 128, 1, 128, nullptr, s2 + h * 128, 1024, n, 128, 128, bx, by, smem))
        }
        PH1(NBLK(N1 * 8), d_topk1(s1, v1, i1, n * 8, bx, by, smem))
        PH1(NBLK(N1 * 8), d_topk1(s2, v2, i2, n * 8, bx, by, smem))
        PH1(NBLK(N1 * 8), d_topk2(v1, i1, v2, i2, ids, gates, n * 8, bx, by, smem))
        PH1(n / 4, d_peer(hbuf, ids, gates, I.pu, I.pv, yff, n, bx, by, smem))
        PH1(n, d_ln(x1, yff, gt2, I.ln2_g, I.ln2_b, I.out + (size_t)b * n * DM, 1.189207115002721f, bx, by, smem))
    }
}
}

extern "C" void kernel_launch(void* const* d_in, const int* in_sizes, int n_in, void* d_out, int out_size, void* d_ws, size_t ws_size, hipStream_t stream) {
    nv::In I{};
    I.x = (const float*)d_in[0]; I.c = (const float*)d_in[1]; I.pos = (const int*)d_in[2]; I.w_ada = (const float*)d_in[3]; I.b_ada = (const float*)d_in[4]; I.w_in = (const float*)d_in[5];
    I.lam_re = (const float*)d_in[6]; I.lam_im = (const float*)d_in[7]; I.log_dt = (const float*)d_in[8]; I.b_re = (const float*)d_in[9]; I.b_im = (const float*)d_in[10];
    I.c_re = (const float*)d_in[11]; I.c_im = (const float*)d_in[12]; I.s5_d = (const float*)d_in[13]; I.w_glu = (const float*)d_in[14]; I.b_glu = (const float*)d_in[15];
    I.q_norm = (const float*)d_in[16]; I.w_uq = (const float*)d_in[17]; I.kv_norm = (const float*)d_in[18]; I.w_ukv = (const float*)d_in[19]; I.gn_s5 = (const float*)d_in[20];
    I.gn_mla = (const float*)d_in[21]; I.w_out = (const float*)d_in[22]; I.ln1_g = (const float*)d_in[23]; I.ln1_b = (const float*)d_in[24]; I.w_query = (const float*)d_in[25];
    I.keys1 = (const float*)d_in[26]; I.keys2 = (const float*)d_in[27]; I.pu = (const float*)d_in[28]; I.pv = (const float*)d_in[29]; I.ln2_g = (const float*)d_in[30]; I.ln2_b = (const float*)d_in[31];
    I.bar = (unsigned*)d_ws;
    I.ws = (float*)((char*)d_ws + 16384);
    I.out = (float*)d_out; I.pad_ = nullptr;
    constexpr size_t kDynLds = nv::MK_LDS + 16;
    static int grid = 0;
    if (!grid) {
        int dev = 0, cus = 0, per_cu = 0;
        hipGetDevice(&dev);
        hipDeviceGetAttribute(&cus, hipDeviceAttributeMultiprocessorCount, dev);
        hipFuncSetAttribute((const void*)nv::mk_naive, hipFuncAttributeMaxDynamicSharedMemorySize, (int)kDynLds);
        hipOccupancyMaxActiveBlocksPerMultiprocessor(&per_cu, nv::mk_naive, 256, kDynLds);
        grid = cus * (per_cu < 1 ? per_cu : 1);
        if (grid <= 0) grid = cus;
    }
    hipMemsetAsync(d_ws, 0, 16384, stream);
    hipLaunchKernelGGL(nv::mk_naive, dim3(grid), dim3(256), kDynLds, stream, I);
}
```

```cpp
#include <hip/hip_runtime.h>
#include <hip/hip_bf16.h>
#include <stdint.h>
#include <stdio.h>
#define XB_TMO      128
#define XB_XCNT(j)  (256  + 64 * (j))
#define XB_XSUB(j)  (1280 + 64 * (j))
#define XB_XGEN(j)  (2304 + 64 * (j))
#define XB_TOP      3328
#define XB_TOPGEN   3392
#define XCD_BAR_WORDS 3456
#define XB_SPIN_CAP (1u << 22)
#define LAS __attribute__((address_space(3)))

__device__ __forceinline__ unsigned xb_ld(unsigned* p)              { return __hip_atomic_load(p, __ATOMIC_RELAXED, __HIP_MEMORY_SCOPE_AGENT); }
__device__ __forceinline__ unsigned xb_add(unsigned* p, unsigned v) { return __hip_atomic_fetch_add(p, v, __ATOMIC_RELAXED, __HIP_MEMORY_SCOPE_AGENT); }
#define WGT_LDS_OFF (131072 + 256)
__device__ __forceinline__ unsigned wgt_hw_slot() { return (unsigned)__builtin_amdgcn_s_getreg((5 << 11) | 4) & 63u; }
__device__ __forceinline__ void wgt_file(int wave_index) { ((volatile LAS int*)(unsigned)WGT_LDS_OFF)[wgt_hw_slot()] = wave_index; }
__device__ __forceinline__ int wgt_tid() {
    const int wv = __builtin_amdgcn_readfirstlane(((volatile LAS int*)(unsigned)WGT_LDS_OFF)[wgt_hw_slot()]);
    unsigned z = 0u; asm volatile("" : "+v"(z));
    return wv * 64 + (int)__builtin_amdgcn_mbcnt_hi(~0u, __builtin_amdgcn_mbcnt_lo(~0u, z));
}
__device__ __forceinline__ unsigned xb_xcc_id() { return (unsigned)__builtin_amdgcn_s_getreg((3 << 11) | 20) & 0xFu; }
#define XB_SPIN(cond, bar) do { unsigned _sp = 0; while (cond) { __builtin_amdgcn_s_sleep(1); \
    if ((++_sp & 255u) == 0u) { if (xb_ld(&(bar)[XB_TMO])) break; if (_sp > XB_SPIN_CAP) { atomicAdd(&(bar)[XB_TMO], 1u); break; } } } } while (0)

struct XcdBarrier {
    unsigned* bar; unsigned x;
    volatile LAS unsigned* st;
};

__device__ __forceinline__ XcdBarrier xcd_barrier_post(unsigned* bar, volatile LAS unsigned* st) {
    XcdBarrier b; b.bar = bar; b.x = xb_xcc_id(); b.st = st;
    if (wgt_tid() == 0) (void)xb_add(&bar[XB_XCNT(b.x)], 1u);
    return b;
}
__device__ __forceinline__ void xcd_barrier_complete(unsigned* bar, unsigned x, unsigned& nloc, unsigned& nx) {
    const unsigned G = gridDim.x * gridDim.y * gridDim.z;
    unsigned sum, cnt, mine, sp = 0u;
    for (;;) {
        sum = 0u; cnt = 0u; mine = 0u;
#pragma unroll
        for (unsigned j = 0; j < 16; ++j) { const unsigned c = xb_ld(&bar[XB_XCNT(j)]); sum += c; cnt += (c > 0u) ? 1u : 0u; mine = (j == x) ? c : mine; }
        if (sum == G) break;
        __builtin_amdgcn_s_sleep(1);
        if ((++sp & 255u) == 0u) { if (xb_ld(&bar[XB_TMO])) break; if (sp > XB_SPIN_CAP) { atomicAdd(&bar[XB_TMO], 1u); break; } }
    }
    nloc = mine > 0u ? mine : 1u; nx = cnt > 0u ? cnt : 1u;
}

__device__ __forceinline__ void xcd_barrier(const XcdBarrier& b) {
    asm volatile("s_waitcnt vmcnt(0)" ::: "memory");
    __syncthreads();
    if (wgt_tid() == 0) {
        unsigned* bar = b.bar;
        __builtin_amdgcn_s_waitcnt(0);
        unsigned nloc = b.st[0], nx = b.st[1];
        if (nloc == 0u) { xcd_barrier_complete(bar, b.x, nloc, nx); b.st[0] = nloc; b.st[1] = nx; }
        const unsigned old = xb_add(&bar[XB_XSUB(b.x)], 1u);
        const unsigned gen = old / nloc;
        if (old + 1u == (gen + 1u) * nloc) {
            __builtin_amdgcn_fence(__ATOMIC_RELEASE, "agent");
            asm volatile("s_waitcnt vmcnt(0)" ::: "memory");
            const unsigned og = xb_add(&bar[XB_TOP], 1u);
            const unsigned tg = og / nx;
            if (og + 1u == (tg + 1u) * nx) xb_add(&bar[XB_TOPGEN], 1u);
            else XB_SPIN(xb_ld(&bar[XB_TOPGEN]) == tg, bar);
            __builtin_amdgcn_fence(__ATOMIC_ACQUIRE, "agent");
            xb_add(&bar[XB_XGEN(b.x)], 1u);
            asm volatile("s_waitcnt vmcnt(0)" ::: "memory");
        } else {
            XB_SPIN(xb_ld(&bar[XB_XGEN(b.x)]) == gen, bar);
            __builtin_amdgcn_fence(__ATOMIC_ACQUIRE, "agent");
            asm volatile("s_waitcnt vmcnt(0)" ::: "memory");
        }
    }
    __syncthreads();
}


namespace pg8 {
#define PG8_LAS __attribute__((address_space(3)))
typedef unsigned short bf16_t;
typedef short bf16x8 __attribute__((ext_vector_type(8)));
typedef float f32x4 __attribute__((ext_vector_type(4)));
typedef unsigned u32x4 __attribute__((ext_vector_type(4)));
constexpr int BM = 256, BK = 64, HALF = 128, HTB = HALF * BK * 2  , STAGE_BYTES = 8 * HTB, NXCD = 8, WGM = 8;

__host__ __device__ __forceinline__ int lds_byte(int r, int c) { const int st = (r >> 4) * 2 + (c >> 5), rr = r & 15, cc = c & 31, ob = rr * 64 + cc * 2; return st * 1024 + (ob ^ (((ob >> 9) & 1) << 5)); }
__host__ __device__ __forceinline__ void stage_rc(int b, int& R, int& C) { const int st = b / 1024, sb = b % 1024, swz = sb ^ (((sb >> 9) & 1) << 5); R = (st >> 1) * 16 + swz / 64; C = (st & 1) * 32 + (swz % 64) / 2; }
__host__ __device__ __forceinline__ int perm32(int rho) { const int n = rho >> 4, i = rho & 15; return 8 * (i >> 2) + 4 * n + (i & 3); }

struct Unit { int pm, pn, pz; const char* a; const char* b; int nt; };
struct Gemm { int K, lda, ldb; };

struct StaticOrder {
    int nM, nN, nwg, G, c;
    __host__ __device__ void init(int M, int N, int G_, int c_) { nM = M / BM; nN = N / BM; nwg = nM * nN; G = G_; c = c_; }
    __host__ __device__ bool next(int i, Unit& u) const {
        const long L = (long)i * G + c; if (L >= nwg) return false;
        int wgid = (int)L; { const int q = nwg / NXCD, r = nwg % NXCD, xcd = wgid % NXCD, off = wgid / NXCD; wgid = (xcd < r ? xcd * (q + 1) : r * (q + 1) + (xcd - r) * q) + off; }
        const int nig = WGM * nN, gid = wgid / nig, fm = gid * WGM, gsz = (nM - fm) < WGM ? (nM - fm) : WGM;
        u.pm = fm + ((wgid % nig) % gsz); u.pn = (wgid % nig) / gsz; return true;
    }
    __device__ __forceinline__ void a_ready(const Unit&) const {}
    __device__ __forceinline__ void done(const Unit&) const {}
};
__device__ __forceinline__ unsigned cvt_pk_bf16(float lo, float hi) { unsigned r; asm volatile("v_cvt_pk_bf16_f32 %0, %1, %2" : "=v"(r) : "v"(lo), "v"(hi)); return r; }
typedef float f32x2 __attribute__((ext_vector_type(2)));
__device__ __forceinline__ f32x2 gelu_pk(f32x2 v) {
    const f32x2 av = __builtin_elementwise_abs(v), d = av * 0.2316418882f + 1.0f;
    f32x2 t; t.x = __builtin_amdgcn_rcpf(d.x); t.y = __builtin_amdgcn_rcpf(d.y);
    f32x2 q = t * 0.5307027145f + (-0.7265760135f); q = q * t + 0.7107068705f; q = q * t + (-0.142248368f); q = q * t + 0.127414796f; q = q * t;
    const f32x2 s = (v * v) * (-0.72134752044f);
    f32x2 e; e.x = __builtin_amdgcn_exp2f(s.x); e.y = __builtin_amdgcn_exp2f(s.y);
    const f32x2 m = v * (q * e), r = v - m;
    f32x2 o; o.x = v.x < 0.f ? m.x : r.x; o.y = v.y < 0.f ? m.y : r.y; return o;
}

struct EpiF32 {
    static constexpr bool PERM = false, AFTER_DRAIN = false;
    float* C; int ldc; const float* bias;
    __device__ __forceinline__ void operator()(const f32x4 (&acc)[2][2][4][2], const Unit& u, int wr, int wc, int fr, int fq) const {
        const int row0 = u.pm * BM + wr * 64 + fr, col0 = u.pn * BM + wc * 32 + 4 * fq;
        f32x4 bv[2][2];
#pragma unroll
        for (int bj = 0; bj < 2; ++bj)
#pragma unroll
            for (int n = 0; n < 2; ++n) bv[bj][n] = bias ? *(const f32x4*)(bias + col0 + bj * HALF + n * 16) : (f32x4){0.f, 0.f, 0.f, 0.f};
#pragma unroll
        for (int ai = 0; ai < 2; ++ai)
#pragma unroll
            for (int m = 0; m < 4; ++m) { float* rowp = C + (size_t)(row0 + ai * HALF + m * 16) * ldc + col0;
#pragma unroll
                for (int bj = 0; bj < 2; ++bj)
#pragma unroll
                    for (int n = 0; n < 2; ++n) *(f32x4*)(rowp + bj * HALF + n * 16) = acc[ai][bj][m][n] + bv[bj][n]; }
    }
};
template <int ACT  > struct EpiBf16 {
    static constexpr bool PERM = true, AFTER_DRAIN = false;
    bf16_t* O; int ldc; const float* bias; int split_cols; size_t split_stride;
    __device__ __forceinline__ void operator()(const f32x4 (&acc)[2][2][4][2], const Unit& u, int wr, int wc, int fr, int fq) const {
        const int row0 = u.pm * BM + wr * 64 + fr; int colt = u.pn * BM; bf16_t* base = O;
        if (split_cols) { const int t = colt / split_cols; base += (size_t)t * split_stride; colt -= t * split_cols; }
        const int col0 = colt + wc * 32 + 8 * fq, bcol0 = u.pn * BM + wc * 32 + 8 * fq;
        f32x4 bv[2][2];
#pragma unroll
        for (int bj = 0; bj < 2; ++bj)
#pragma unroll
            for (int n = 0; n < 2; ++n) bv[bj][n] = bias ? *(const f32x4*)(bias + bcol0 + bj * HALF + 4 * n) : (f32x4){0.f, 0.f, 0.f, 0.f};
#pragma unroll
        for (int ai = 0; ai < 2; ++ai)
#pragma unroll
            for (int m = 0; m < 4; ++m) { bf16_t* rowp = base + (size_t)(row0 + ai * HALF + m * 16) * ldc + col0;
#pragma unroll
                for (int bj = 0; bj < 2; ++bj) { f32x4 v0 = acc[ai][bj][m][0] + bv[bj][0], v1 = acc[ai][bj][m][1] + bv[bj][1];
                    if (ACT == 1) { f32x2 a = gelu_pk((f32x2){v0[0], v0[1]}), b = gelu_pk((f32x2){v0[2], v0[3]}), c = gelu_pk((f32x2){v1[0], v1[1]}), d = gelu_pk((f32x2){v1[2], v1[3]});
                        v0 = (f32x4){a.x, a.y, b.x, b.y}; v1 = (f32x4){c.x, c.y, d.x, d.y}; }
                    if (ACT == 2) {
#pragma unroll
                        for (int j = 0; j < 4; ++j) { v0[j] = 0.5f * v0[j] * (1.0f + erff(v0[j] * 0.70710678f)); v1[j] = 0.5f * v1[j] * (1.0f + erff(v1[j] * 0.70710678f)); } }
                    u32x4 w; w.x = cvt_pk_bf16(v0[0], v0[1]); w.y = cvt_pk_bf16(v0[2], v0[3]); w.z = cvt_pk_bf16(v1[0], v1[1]); w.w = cvt_pk_bf16(v1[2], v1[3]);
                    *(u32x4*)(rowp + bj * HALF) = w; } }
    }
};

template <class Epi, class Sched, bool STAMP = false>
__device__ __forceinline__ void gemm_phase(PG8_LAS unsigned char* lds, const Gemm g, const Sched& S, const Epi& E, unsigned long long* stamps) {
    int tid_op = wgt_tid(); asm volatile("" : "+v"(tid_op));
    const int tid = tid_op, wid = __builtin_amdgcn_readfirstlane(tid >> 6), lane = tid & 63, wr = wid >> 2, wc = wid & 3, fr = lane & 15, fq = lane >> 4;
    int Kop = g.K; asm volatile("" : "+s"(Kop));
    const int K = Kop, nt = K / BK;
    int ts_lo = 0, ts_hi = 0, nts = 0; const unsigned long long rt_entry = STAMP ? (unsigned long long)wall_clock64() : 0ull;
#define PG8_STAMP() do { if (STAMP && wid == 0 && nts < 64) { const unsigned long long _c = (unsigned long long)clock64(); \
        ts_lo = (lane == nts) ? (int)(unsigned)_c : ts_lo; ts_hi = (lane == nts) ? (int)(unsigned)(_c >> 32) : ts_hi; ++nts; } } while (0)
    PG8_STAMP();
    unsigned voffA[2], voffB[2];
#pragma unroll
    for (int i = 0; i < 2; ++i) { int R, C; stage_rc(tid * 16 + i * 8192, R, C); const int Rb = Epi::PERM ? ((R & ~31) + perm32(R & 31)) : R;
        voffA[i] = (unsigned)(R * g.lda + C) * 2u; voffB[i] = (unsigned)(Rb * g.ldb + C) * 2u; }
    const size_t kstep = (size_t)(BK * 2);
    const size_t hstepA = (size_t)HALF * g.lda * 2, hstepB = (size_t)HALF * g.ldb * 2;
    const unsigned ldsw = (unsigned)wid * 1024u;
    const int aoff = lds_byte(wr * 64 + fr, fq * 8), boff = lds_byte(wc * 32 + fr, fq * 8);
#define PG8_SA(b, h) (((b) * 2 + (h)) * HTB)
#define PG8_SB(b, h) ((4 + (b) * 2 + (h)) * HTB)
#define PG8_STAGE(bufoff, gbase, voff) do { _Pragma("unroll") for (int _i = 0; _i < 2; ++_i) \
        __builtin_amdgcn_global_load_lds((const unsigned*)((const char*)(gbase) + (voff)[_i]), (PG8_LAS unsigned*)(lds + (bufoff) + ldsw + _i * 8192), 16, 0, 0); } while (0)
#define PG8_LDA(dst, b, h) do { _Pragma("unroll") for (int m = 0; m < 4; ++m) _Pragma("unroll") for (int k = 0; k < 2; ++k) dst[m][k] = *(const PG8_LAS bf16x8*)(lds + PG8_SA(b, h) + aoff + m * 2048 + k * 1024); } while (0)
#define PG8_LDB(dst, b, h) do { _Pragma("unroll") for (int n = 0; n < 2; ++n) _Pragma("unroll") for (int k = 0; k < 2; ++k) dst[n][k] = *(const PG8_LAS bf16x8*)(lds + PG8_SB(b, h) + boff + n * 2048 + k * 1024); } while (0)
#define PG8_MMA(ai, bj, At, Bt) do { __builtin_amdgcn_s_setprio(1); _Pragma("unroll") for (int m = 0; m < 4; ++m) _Pragma("unroll") for (int n = 0; n < 2; ++n) _Pragma("unroll") for (int k = 0; k < 2; ++k) \
        acc[ai][bj][m][n] = __builtin_amdgcn_mfma_f32_16x16x32_bf16(Bt[n][k], At[m][k], acc[ai][bj][m][n], 0, 0, 0); __builtin_amdgcn_s_setprio(0); } while (0)
#define PG8_WAIT_V(n) asm volatile("s_waitcnt vmcnt(" #n ")" ::: "memory")
#define PG8_WAIT_L(n) asm volatile("s_waitcnt lgkmcnt(" #n ")" ::: "memory")
#define PG8_BAR __builtin_amdgcn_s_barrier()
#define PG8_SCHED __builtin_amdgcn_sched_barrier(0)
    Unit cur, nxt; int ui = 0;
    if (!S.next(0, cur)) return;
    f32x4 acc[2][2][4][2];
#pragma unroll
    for (int a = 0; a < 2; ++a)
#pragma unroll
        for (int b = 0; b < 2; ++b)
#pragma unroll
            for (int m = 0; m < 4; ++m)
#pragma unroll
                for (int n = 0; n < 2; ++n) acc[a][b][m][n] = (f32x4){0.f, 0.f, 0.f, 0.f};
    bf16x8 At[4][2], B0[2][2], B1[2][2];
    const char* cA = cur.a; const char* cB = cur.b;
    S.a_ready(cur);
    PG8_STAGE(PG8_SB(0, 0), cB, voffB); PG8_STAGE(PG8_SA(0, 0), cA, voffA); PG8_STAGE(PG8_SB(0, 1), cB + hstepB, voffB); PG8_STAGE(PG8_SA(0, 1), cA + hstepA, voffA);
    if (wr == 1) PG8_BAR;
    PG8_WAIT_V(4); PG8_BAR;
    PG8_STAGE(PG8_SB(1, 0), cB + kstep, voffB); PG8_STAGE(PG8_SA(1, 0), cA + kstep, voffA); PG8_STAGE(PG8_SB(1, 1), cB + hstepB + kstep, voffB);
    PG8_WAIT_V(6); PG8_BAR;
    PG8_STAMP();
    for (;;) {
        const bool has_next = S.next(ui + 1, nxt);
        const char* nA = has_next ? nxt.a : cA; const char* nB = has_next ? nxt.b : cB;
        const int ntc = cur.nt > 0 ? cur.nt : nt;
        for (int t = 0; t < ntc; t += 2) {
            const bool last = (t == ntc - 2);
            const char* a1 = cA + (size_t)(t + 1) * kstep;
            const char* a2 = last ? nA : cA + (size_t)(t + 2) * kstep; const char* b2 = last ? nB : cB + (size_t)(t + 2) * kstep;
            const char* a3 = a2 + kstep; const char* b3 = b2 + kstep;
            if (last && has_next) S.a_ready(nxt);
            PG8_LDB(B0, 0, 0); PG8_SCHED; PG8_LDA(At, 0, 0); PG8_STAGE(PG8_SA(1, 1), a1 + hstepA, voffA);
            PG8_WAIT_L(8); PG8_BAR; PG8_WAIT_L(0); PG8_MMA(0, 0, At, B0); PG8_BAR; PG8_SCHED;
            PG8_LDB(B1, 0, 1); PG8_STAGE(PG8_SB(0, 0), b2, voffB);
            PG8_BAR; PG8_WAIT_L(0); PG8_MMA(0, 1, At, B1); PG8_BAR;
            PG8_LDA(At, 0, 1); PG8_STAGE(PG8_SA(0, 0), a2, voffA);
            PG8_BAR; PG8_WAIT_L(0); PG8_MMA(1, 0, At, B0); PG8_BAR; PG8_SCHED;
            PG8_STAGE(PG8_SB(0, 1), b2 + hstepB, voffB);
            PG8_WAIT_V(6); PG8_BAR; PG8_MMA(1, 1, At, B1); PG8_BAR;
            PG8_LDB(B0, 1, 0); PG8_SCHED; PG8_LDA(At, 1, 0); PG8_STAGE(PG8_SA(0, 1), a2 + hstepA, voffA);
            PG8_WAIT_L(8); PG8_BAR; PG8_WAIT_L(0); PG8_MMA(0, 0, At, B0); PG8_BAR; PG8_SCHED;
            PG8_LDB(B1, 1, 1); PG8_STAGE(PG8_SB(1, 0), b3, voffB);
            PG8_BAR; PG8_WAIT_L(0); PG8_MMA(0, 1, At, B1); PG8_BAR;
            PG8_LDA(At, 1, 1); PG8_STAGE(PG8_SA(1, 0), a3, voffA);
            PG8_BAR; PG8_WAIT_L(0); PG8_MMA(1, 0, At, B0); PG8_BAR; PG8_SCHED;
            PG8_STAGE(PG8_SB(1, 1), b3 + hstepB, voffB);
            PG8_WAIT_V(6); PG8_BAR; PG8_MMA(1, 1, At, B1); PG8_BAR;
        }
        PG8_STAMP();
        if constexpr (!Epi::AFTER_DRAIN) { E(acc, cur, wr, wc, fr, fq); S.done(cur); }
        PG8_STAMP();
        if (!has_next) break;
#pragma unroll
        for (int a = 0; a < 2; ++a)
#pragma unroll
            for (int b = 0; b < 2; ++b)
#pragma unroll
                for (int m = 0; m < 4; ++m)
#pragma unroll
                    for (int n = 0; n < 2; ++n) acc[a][b][m][n] = (f32x4){0.f, 0.f, 0.f, 0.f};
        cur = nxt; cA = nA; cB = nB; ++ui;
    }
    PG8_WAIT_V(0);
    if (wr == 0) PG8_BAR;
    PG8_BAR;
    if constexpr (Epi::AFTER_DRAIN) { E.fused(acc, cur, wr, wc, fr, fq, lds, wid, lane); S.done(cur); }
    PG8_STAMP();
    if (STAMP && wid == 0) { stamps[lane] = lane < nts ? (((unsigned long long)(unsigned)ts_hi << 32) | (unsigned)ts_lo) : 0ull;
        if (lane == 62) stamps[62] = rt_entry; if (lane == 63) stamps[63] = (unsigned long long)wall_clock64(); }
#undef PG8_STAMP
#undef PG8_SA
#undef PG8_SB
#undef PG8_STAGE
#undef PG8_LDA
#undef PG8_LDB
#undef PG8_MMA
#undef PG8_WAIT_V
#undef PG8_WAIT_L
#undef PG8_BAR
#undef PG8_SCHED
}
}

namespace fk {
using pg8::bf16_t; using pg8::f32x4; using pg8::u32x4; using pg8::Unit; using pg8::Gemm; using pg8::cvt_pk_bf16;
typedef unsigned u32x2 __attribute__((ext_vector_type(2)));
typedef float f32x2 __attribute__((ext_vector_type(2)));
typedef unsigned u32x3 __attribute__((ext_vector_type(3)));
typedef unsigned u32x6 __attribute__((ext_vector_type(6)));
typedef float f32x32 __attribute__((ext_vector_type(32)));
constexpr int T = 65536, DM = 1024, SEQ = 8192, NBATCH = 8, NTHR = 512;
constexpr int LDS_BYTES = 147456;

constexpr size_t al256(size_t x) { return (x + 255) / 256 * 256; }
constexpr size_t OFF_BAR = 0, SZ_BAR = 16384;
constexpr size_t OFF_MOD = OFF_BAR + SZ_BAR, SZ_MOD = 8 * 6144 * 4;
constexpr size_t OFF_CS = OFF_MOD + al256(SZ_MOD), SZ_CS = (size_t)T * 16 * 2 * 4;
constexpr size_t OFF_BT1 = OFF_CS + al256(SZ_CS), SZ_BT1 = 1280 * 1024 * 2;
constexpr size_t OFF_BTQ = OFF_BT1 + al256(SZ_BT1), SZ_BTQ = 768 * 384 * 2;
constexpr size_t OFF_BTK = OFF_BTQ + al256(SZ_BTQ), SZ_BTK = 512 * 256 * 2;
constexpr size_t OFF_ATV = OFF_BTK + al256(SZ_BTK), SZ_ATV = 512 * 256 * 2;
constexpr size_t OFF_BTG = OFF_ATV + al256(SZ_ATV), SZ_BTG = 512 * 512 * 2;
constexpr size_t OFF_BTO1 = OFF_BTG + al256(SZ_BTG), SZ_BTO = 1024 * 512 * 2;
constexpr size_t OFF_BTO2 = OFF_BTO1 + al256(SZ_BTO);
constexpr size_t OFF_WST = OFF_BTO2 + al256(SZ_BTO), SZ_WST = (size_t)2048 * 1024 * 2;
constexpr size_t OFF_WT = OFF_WST + al256(SZ_WST), SZ_WT = (size_t)32 * 1024 * 1152 * 2;
constexpr size_t OFF_WSS = OFF_WT + al256(SZ_WT), SZ_WSS = (size_t)64 * 256 * 512 * 2;
constexpr size_t OFF_A64 = OFF_WSS + al256(SZ_WSS), SZ_A64 = 32 * 64 * 2 * 4;
constexpr size_t OFF_TU8 = OFF_A64 + al256(SZ_A64), SZ_T8 = (size_t)16384 * 1024;
constexpr size_t OFF_TV8 = OFF_TU8 + al256(SZ_T8);
constexpr size_t OFF_SCU = OFF_TV8 + al256(SZ_T8), SZ_SC = 16384 * 4;
constexpr size_t OFF_SCV = OFF_SCU + al256(SZ_SC);
constexpr size_t OFF_TU4 = OFF_TV8 + (size_t)16384 * 512;
constexpr size_t OFF_SCU4 = OFF_SCV + al256(SZ_SC);
constexpr size_t OFF_APOW = OFF_SCU4 + al256(SZ_SC), SZ_APOW = (size_t)32 * 65 * 64 * 8;
constexpr size_t OFF_BBCC = OFF_APOW + al256(SZ_APOW), SZ_BBCC = (size_t)32 * 2048 * 8;
constexpr size_t OFF_KTAB = OFF_BBCC + al256(SZ_BBCC), SZ_KTAB = (size_t)32 * 16384 * 4;
constexpr size_t OFF_R1 = OFF_KTAB + al256(SZ_KTAB), SZ_R1 = (size_t)T * 1024 * 2;
constexpr size_t OFF_R2 = OFF_R1 + SZ_R1, SZ_R2 = (size_t)T * 1280;
constexpr size_t OFF_R3 = OFF_R2 + SZ_R2, SZ_R3 = (size_t)32 * 1024 * 1152 * 2;
constexpr size_t OFF_R4 = OFF_R3 + al256(SZ_R3), SZ_R4 = (size_t)T * 8 * 96 * 2;
constexpr size_t OFF_PQ = OFF_R4 + SZ_R4, SZ_PQ = (size_t)T * 12 * 4;
constexpr size_t OFF_PKV = OFF_PQ + SZ_PQ, SZ_PKV = (size_t)T * 8 * 4;
constexpr size_t OFF_PMLA = OFF_PKV + SZ_PKV, SZ_PMLA = (size_t)T * 8 * 4;
constexpr size_t OFF_PS5 = OFF_PMLA + SZ_PMLA, SZ_PS5 = (size_t)T * 16 * 4;
constexpr size_t OFF_R5 = OFF_PS5 + SZ_PS5, SZ_R5 = (size_t)T * 512 * 2;
constexpr size_t OFF_R6 = OFF_R5 + SZ_R5, SZ_R6 = (size_t)T * 1024 * 2;
constexpr size_t WS_FAST_END = OFF_R6 + SZ_R6;
constexpr size_t OFF_RQ = WS_FAST_END, OFF_RK = OFF_RQ + (size_t)T * 4;
constexpr size_t OFF_H1 = OFF_R1;
constexpr size_t OFF_CQ = OFF_R2, OFF_CKV = OFF_R2 + (size_t)T * 384 * 2;
constexpr size_t OFF_UG = OFF_R3, OFF_KIMG = OFF_R4, OFF_VIMG = OFF_R5;

struct P {
    const float *x, *c; const int* pos; const float *w_ada, *b_ada, *w_in, *lam_re, *lam_im, *log_dt, *b_re, *b_im, *c_re, *c_im, *s5_d, *w_glu, *b_glu, *q_norm, *w_uq, *kv_norm, *w_ukv,
        *gn_s5, *gn_mla, *w_out, *ln1_g, *ln1_b, *w_query, *keys1, *keys2, *pu, *pv, *ln2_g, *ln2_b;
    float* out; char* ws;
};
__device__ __forceinline__ int otid() { int t = wgt_tid(); asm volatile("" : "+v"(t)); return t; }
__device__ __forceinline__ float bf2f(bf16_t v) { return __uint_as_float(((unsigned)v) << 16); }
__device__ __forceinline__ u32x4 pack8(const f32x4 a, const f32x4 b) { u32x4 w; w.x = cvt_pk_bf16(a[0], a[1]); w.y = cvt_pk_bf16(a[2], a[3]); w.z = cvt_pk_bf16(b[0], b[1]); w.w = cvt_pk_bf16(b[2], b[3]); return w; }

template <class PT> struct OrderT {
    int nM, nN, nwg, G, c; PT pt;
    __device__ void init(int nM_, int nN_, int G_, int c_, const PT& pt_) { nM = nM_; nN = nN_; nwg = nM * nN; G = G_; c = c_; pt = pt_; }
    __device__ bool next(int i, Unit& u) const {
        const long L = (long)i * G + c; if (L >= nwg) return false;
        int wgid = (int)L; { const int q = nwg / pg8::NXCD, r = nwg % pg8::NXCD, xcd = wgid % pg8::NXCD, off = wgid / pg8::NXCD; wgid = (xcd < r ? xcd * (q + 1) : r * (q + 1) + (xcd - r) * q) + off; }
        const int nig = pg8::WGM * nN, gid = wgid / nig, fm = gid * pg8::WGM, gsz = (nM - fm) < pg8::WGM ? (nM - fm) : pg8::WGM;
        u.nt = 0; pt.fill(u, fm + ((wgid % nig) % gsz), (wgid % nig) / gsz); return true;
    }
    __device__ __forceinline__ void a_ready(const Unit&) const {}
    __device__ __forceinline__ void done(const Unit&) const {}
};

__device__ __forceinline__ void phase_p0a(const P& p, char* lds) {
    const int tid = otid(); const size_t gtid = (size_t)blockIdx.x * NTHR + tid, gstr = (size_t)gridDim.x * NTHR;
    float* mod = (float*)(p.ws + OFF_MOD);
    {
        float* sl = (float*)lds; float* red = sl + 8192;
        for (int i = tid; i < 8192; i += NTHR) { const float cv = p.c[i]; sl[i] = cv / (1.0f + expf(-cv)); }
        __syncthreads();
        for (int cb = blockIdx.x; cb < 256; cb += gridDim.x) {
            if (tid < 504) { const int ks = tid / 24, col = tid % 24, n = cb * 24 + col;
                float a0 = 0.f, a1 = 0.f, a2 = 0.f, a3 = 0.f, a4 = 0.f, a5 = 0.f, a6 = 0.f, a7 = 0.f;
                for (int k = ks; k < 1024; k += 21) { const float w = p.w_ada[(size_t)k * 6144 + n];
                    a0 += sl[k] * w; a1 += sl[1024 + k] * w; a2 += sl[2048 + k] * w; a3 += sl[3072 + k] * w; a4 += sl[4096 + k] * w; a5 += sl[5120 + k] * w; a6 += sl[6144 + k] * w; a7 += sl[7168 + k] * w; }
                float* r = red + ks * 24 + col; r[0] = a0; r[504] = a1; r[1008] = a2; r[1512] = a3; r[2016] = a4; r[2520] = a5; r[3024] = a6; r[3528] = a7; }
            __syncthreads();
            if (tid < 192) { const int b = tid / 24, col = tid % 24, n = cb * 24 + col; float s = p.b_ada[n];
                for (int ks = 0; ks < 21; ++ks) s += red[b * 504 + ks * 24 + col];
                mod[b * 6144 + n] = s; }
            __syncthreads();
        }
    }
    {
        float* cs = (float*)(p.ws + OFF_CS);
        for (size_t idx = gtid; idx < (size_t)T * 16; idx += gstr) { const int t = (int)(idx >> 4), i = (int)(idx & 15);
            const double ang = (double)p.pos[t] * exp(-9.210340371976184 * (double)i / 16.0);
            cs[idx * 2] = (float)cos(ang); cs[idx * 2 + 1] = (float)sin(ang); }
    }
    {
        bf16_t* bt = (bf16_t*)(p.ws + OFF_BT1);
        for (size_t idx = gtid; idx < (size_t)1280 * 1024 / 2; idx += gstr) { const int n = (int)(idx >> 9), k = (int)(idx & 511) * 2;
            const float v0 = n < 1184 ? p.w_in[(size_t)k * 1184 + n] : 0.f, v1 = n < 1184 ? p.w_in[(size_t)(k + 1) * 1184 + n] : 0.f;
            ((unsigned*)bt)[idx] = cvt_pk_bf16(v0, v1); }
    }
    {
        unsigned* btq = (unsigned*)(p.ws + OFF_BTQ); unsigned* btk = (unsigned*)(p.ws + OFF_BTK); unsigned* atv = (unsigned*)(p.ws + OFF_ATV);
        for (size_t idx = gtid; idx < (size_t)768 * 384 / 2; idx += gstr) { const int n = (int)(idx / 192), k = (int)(idx % 192) * 2;
            btq[idx] = cvt_pk_bf16(p.q_norm[k] * p.w_uq[(size_t)k * 768 + n], p.q_norm[k + 1] * p.w_uq[(size_t)(k + 1) * 768 + n]); }
        for (size_t idx = gtid; idx < (size_t)512 * 256 / 2; idx += gstr) { const int n = (int)(idx >> 7), k = (int)(idx & 127) * 2, col = (n >> 6) * 128 + (n & 63);
            btk[idx] = cvt_pk_bf16(p.kv_norm[k] * p.w_ukv[(size_t)k * 1024 + col], p.kv_norm[k + 1] * p.w_ukv[(size_t)(k + 1) * 1024 + col]);
            atv[idx] = cvt_pk_bf16(p.kv_norm[k] * p.w_ukv[(size_t)k * 1024 + col + 64], p.kv_norm[k + 1] * p.w_ukv[(size_t)(k + 1) * 1024 + col + 64]); }
    }
}

__device__ __forceinline__ void phase_p0c(const P& p, char* lds) {
    const int tid = otid(); const size_t gtid = (size_t)blockIdx.x * NTHR + tid, gstr = (size_t)gridDim.x * NTHR;
    {   unsigned* btg = (unsigned*)(p.ws + OFF_BTG);
        for (size_t idx = gtid; idx < (size_t)512 * 512 / 2; idx += gstr) { const int n = (int)(idx >> 8), k = (int)(idx & 255) * 2;
            btg[idx] = cvt_pk_bf16(p.w_glu[(size_t)k * 512 + n], p.w_glu[(size_t)(k + 1) * 512 + n]); } }
    typedef float f32x2 __attribute__((ext_vector_type(2)));
    f32x2* Apl = (f32x2*)lds;
    f32x2* BB = Apl + 9 * 64;
    f32x2* CC = BB + 64 * 16;
    for (int wi = blockIdx.x; wi < 256; wi += gridDim.x) {
        const int g = wi & 31, slice = wi >> 5;
        __syncthreads();
        const double dt = exp((double)p.log_dt[g]);
        for (int idx = tid; idx < 9 * 64; idx += NTHR) { const int kl = idx >> 6, pp = idx & 63, k = (kl < 8) ? slice * 8 + kl : 64; const double lr = p.lam_re[g * 64 + pp], li = p.lam_im[g * 64 + pp];
            const double mag = exp((double)k * lr * dt), ang = (double)k * li * dt; const f32x2 v = (f32x2){(float)(mag * cos(ang)), (float)(mag * sin(ang))};
            Apl[idx] = v; if (kl < 8 || slice == 7) ((f32x2*)(p.ws + OFF_APOW))[((size_t)g * 65 + k) * 64 + pp] = v; }
        for (int idx = tid; idx < 1024; idx += NTHR) { const int pp = idx >> 4, h = idx & 15; const double lr = p.lam_re[g * 64 + pp], li = p.lam_im[g * 64 + pp];
            const double mag = exp(lr * dt), abr = mag * cos(li * dt), abi = mag * sin(li * dt), den = lr * lr + li * li, nr = abr - 1.0;
            const double cr = (nr * lr + abi * li) / den, ci = (abi * lr - nr * li) / den, br = p.b_re[(g * 64 + pp) * 16 + h], bi = p.b_im[(g * 64 + pp) * 16 + h];
            const f32x2 bv = (f32x2){(float)(cr * br - ci * bi), (float)(cr * bi + ci * br)}; BB[idx] = bv;
            const int hh = idx >> 6, p2 = idx & 63; const f32x2 cv = (f32x2){p.c_re[(g * 16 + hh) * 64 + p2], p.c_im[(g * 16 + hh) * 64 + p2]}; CC[idx] = cv;
            if (slice == 0) { ((f32x2*)(p.ws + OFF_BBCC))[(size_t)g * 2048 + idx] = bv; ((f32x2*)(p.ws + OFF_BBCC))[(size_t)g * 2048 + 1024 + idx] = cv; } }
        __syncthreads();
        for (int e = tid; e < 8 * 256; e += NTHR) { const int kl = e >> 8, h = (e >> 4) & 15, h2 = e & 15, k = slice * 8 + kl; float acc = 0.f;
            for (int pp = 0; pp < 64; ++pp) { const f32x2 c = CC[h * 64 + pp], a = Apl[kl * 64 + pp], b = BB[pp * 16 + h2];
                const float xr = c.x * a.x - c.y * a.y, xi = c.x * a.y + c.y * a.x; acc += xr * b.x - xi * b.y; }
            if (k == 0 && h == h2) acc += p.s5_d[g * 16 + h];
            ((float*)(p.ws + OFF_KTAB))[(size_t)g * 16384 + k * 256 + (e & 255)] = acc; }
    }
}
__device__ __forceinline__ void phase_p0e(const P& p, char* lds) {
    const int tid = otid();
    typedef float f32x2 __attribute__((ext_vector_type(2)));
    f32x2* Apow = (f32x2*)lds;
    f32x2* BB = Apow + 65 * 64;
    f32x2* CC = BB + 64 * 16;
    float* Ktab = (float*)(CC + 16 * 64);
    for (int wi = blockIdx.x; wi < 256; wi += gridDim.x) {
        const int g = wi & 31, slice = wi >> 5;
        __syncthreads();
        for (int idx = tid; idx < 65 * 64; idx += NTHR) Apow[idx] = ((const f32x2*)(p.ws + OFF_APOW))[(size_t)g * 65 * 64 + idx];
        for (int idx = tid; idx < 2048; idx += NTHR) BB[idx] = ((const f32x2*)(p.ws + OFF_BBCC))[(size_t)g * 2048 + idx];
        for (int idx = tid; idx < 16384 / 4; idx += NTHR) ((f32x4*)Ktab)[idx] = ((const f32x4*)(p.ws + OFF_KTAB))[(size_t)g * 4096 + idx];
        __syncthreads();
        unsigned* wt = (unsigned*)(p.ws + OFF_WT) + ((size_t)g * 1024 + slice * 128) * 576;
        for (int e = tid; e < 128 * 576; e += NTHR) { const int nl = e / 576, k = (e - nl * 576) * 2, n = slice * 128 + nl, i = n >> 4, h = n & 15; float v0, v1;
            if (k < 1024) { const int j = k >> 4, h2 = k & 15; v0 = (j <= i) ? Ktab[((i - j) * 16 + h) * 16 + h2] : 0.f; v1 = (j <= i) ? Ktab[((i - j) * 16 + h) * 16 + h2 + 1] : 0.f; }
            else { const int q = k - 1024, pp = q & 63; const f32x2 c0 = CC[h * 64 + pp], a0 = Apow[(i + 1) * 64 + pp], c1 = CC[h * 64 + pp + 1], a1 = Apow[(i + 1) * 64 + pp + 1];
                if (q < 64) { v0 = c0.x * a0.x - c0.y * a0.y; v1 = c1.x * a1.x - c1.y * a1.y; } else { v0 = -(c0.x * a0.y + c0.y * a0.x); v1 = -(c1.x * a1.y + c1.y * a1.x); } }
            wt[e] = cvt_pk_bf16(v0, v1); }
        for (int e = tid; e < 2 * 32 * 256; e += NTHR) { const int kh = e >> 13, rl = (e >> 8) & 31, kk = (e & 255) * 2, row = slice * 32 + rl; float v0 = 0.f, v1 = 0.f;
            if (row < 128) { const int pp = row & 63, j = kh * 32 + (kk >> 4), h2 = kk & 15; const f32x2 a = Apow[(63 - j) * 64 + pp], b0 = BB[pp * 16 + h2], b1 = BB[pp * 16 + h2 + 1];
                if (row < 64) { v0 = a.x * b0.x - a.y * b0.y; v1 = a.x * b1.x - a.y * b1.y; } else { v0 = a.x * b0.y + a.y * b0.x; v1 = a.x * b1.y + a.y * b1.x; } }
            ((unsigned*)(p.ws + OFF_WSS))[(((size_t)(g * 2 + kh) * 256 + row) * 512 + kk) >> 1] = cvt_pk_bf16(v0, v1); }
        if (slice == 0 && tid < 64) ((f32x2*)(p.ws + OFF_A64))[g * 64 + tid] = Apow[64 * 64 + tid];
    }
}
__device__ __forceinline__ void phase_p0d(const P& p, char* lds) {
    const int tid = otid(), lane = tid & 63; const size_t gtid = (size_t)blockIdx.x * NTHR + tid, gstr = (size_t)gridDim.x * NTHR;
    {   unsigned* b1 = (unsigned*)(p.ws + OFF_BTO1); unsigned* b2 = (unsigned*)(p.ws + OFF_BTO2);
        for (size_t idx = gtid; idx < (size_t)1024 * 512 / 2; idx += gstr) { const int n = (int)(idx >> 8), k = (int)(idx & 255) * 2;
            b1[idx] = cvt_pk_bf16(p.gn_s5[k] * p.w_out[(size_t)k * 1024 + n], p.gn_s5[k + 1] * p.w_out[(size_t)(k + 1) * 1024 + n]);
            b2[idx] = cvt_pk_bf16(p.gn_mla[k] * p.w_out[(size_t)(512 + k) * 1024 + n], p.gn_mla[k + 1] * p.w_out[(size_t)(513 + k) * 1024 + n]); } }
    {
        float* Kt = (float*)lds; float* Wq = Kt + 64 * 129;
        for (int tile = blockIdx.x; tile < 32 * 16; tile += gridDim.x) { const int nb = tile >> 4, kb = tile & 15, n0 = nb * 64, k0 = kb * 64, hh = n0 >> 8, half = (n0 >> 7) & 1, key0 = n0 & 127;
            const float* keys = (half ? p.keys2 : p.keys1) + ((size_t)hh * 128 + key0) * 128;
            __syncthreads();
            for (int e = tid; e < 64 * 128; e += NTHR) { const int r = e >> 7, d = e & 127; Kt[r * 129 + d] = keys[(size_t)r * 128 + d]; Wq[e] = p.w_query[(size_t)(k0 + r) * 2048 + hh * 256 + half * 128 + d]; }
            __syncthreads();
            const int tn = tid & 63, tk = (tid >> 6) * 8; float acc[8];
#pragma unroll
            for (int i = 0; i < 8; ++i) acc[i] = 0.f;
            for (int d = 0; d < 128; ++d) { const float kv = Kt[tn * 129 + d];
#pragma unroll
                for (int i = 0; i < 8; ++i) acc[i] += kv * Wq[(tk + i) * 128 + d]; }
            u32x4 w; w.x = cvt_pk_bf16(acc[0], acc[1]); w.y = cvt_pk_bf16(acc[2], acc[3]); w.z = cvt_pk_bf16(acc[4], acc[5]); w.w = cvt_pk_bf16(acc[6], acc[7]);
            *(u32x4*)((bf16_t*)(p.ws + OFF_WST) + (size_t)(n0 + tn) * 1024 + k0 + tk) = w; }
    }
    {
        const int wv = (int)(gtid >> 6), nwv = (int)(gstr >> 6);
        for (int r = wv; r < 2 * 16384; r += nwv) { const int which = r >> 14, e = r & 16383; const float* src = (which ? p.pv : p.pu) + (size_t)e * 1024 + lane * 16;
            f32x4 v[4]; float am = 0.f;
#pragma unroll
            for (int i = 0; i < 4; ++i) { v[i] = *(const f32x4*)(src + 4 * i); am = fmaxf(am, fmaxf(fmaxf(fabsf(v[i][0]), fabsf(v[i][1])), fmaxf(fabsf(v[i][2]), fabsf(v[i][3])))); }
#pragma unroll
            for (int o = 32; o > 0; o >>= 1) am = fmaxf(am, __shfl_xor(am, o));
            if (which == 0) {
            const float sc = am > 0.f ? 7.5f / am : 1.0f; unsigned c[16];
#pragma unroll
            for (int i = 0; i < 16; ++i) { const float x = v[i >> 2][i & 3] * sc, ax = fabsf(x);
                float cf = ax < 1.0f ? rintf(ax * 8.0f) : ax < 2.0f ? 8.0f + rintf((ax - 1.0f) * 8.0f) : ax < 4.0f ? 16.0f + rintf((ax - 2.0f) * 4.0f) : 24.0f + rintf((ax - 4.0f) * 2.0f);
                cf = fminf(cf, 31.0f); c[i] = (unsigned)cf | (x < 0.f ? 32u : 0u); }
            u32x3 w;
            w.x = c[0] | (c[1] << 6) | (c[2] << 12) | (c[3] << 18) | (c[4] << 24) | ((c[5] & 3u) << 30);
            w.y = (c[5] >> 2) | (c[6] << 4) | (c[7] << 10) | (c[8] << 16) | (c[9] << 22) | ((c[10] & 15u) << 28);
            w.z = (c[10] >> 4) | (c[11] << 2) | (c[12] << 8) | (c[13] << 14) | (c[14] << 20) | (c[15] << 26);
            *(u32x3*)(p.ws + OFF_TU8 + (size_t)e * 768 + lane * 12) = w;
            if (lane == 0) ((float*)(p.ws + OFF_SCU))[e] = am > 0.f ? am / 7.5f : 1.0f;
            {
                const float sc4 = am > 0.f ? 6.0f / am : 1.0f; unsigned lo = 0u, hi = 0u;
#pragma unroll
                for (int i = 0; i < 16; ++i) { const float x = v[i >> 2][i & 3] * sc4, ax = fabsf(x);
                    const unsigned c4 = (unsigned)(ax > 0.25f) + (unsigned)(ax > 0.75f) + (unsigned)(ax > 1.25f) + (unsigned)(ax > 1.75f) + (unsigned)(ax > 2.5f) + (unsigned)(ax > 3.5f) + (unsigned)(ax > 5.0f);
                    const unsigned cd = c4 | (x < 0.f ? 8u : 0u);
                    if (i < 8) lo |= cd << (4 * i); else hi |= cd << (4 * (i - 8)); }
                u32x2 w4; w4.x = lo; w4.y = hi;
                *(u32x2*)(p.ws + OFF_TU4 + (size_t)e * 512 + lane * 8) = w4;
                if (lane == 0) ((float*)(p.ws + OFF_SCU4))[e] = am > 0.f ? am / 6.0f : 1.0f; }
            } else {
            const float sc = am > 0.f ? 6.0f / am : 1.0f; unsigned lo = 0u, hi = 0u;
#pragma unroll
            for (int i = 0; i < 16; ++i) { const float x = v[i >> 2][i & 3] * sc, ax = fabsf(x);
                const unsigned c = (unsigned)(ax > 0.25f) + (unsigned)(ax > 0.75f) + (unsigned)(ax > 1.25f) + (unsigned)(ax > 1.75f) + (unsigned)(ax > 2.5f) + (unsigned)(ax > 3.5f) + (unsigned)(ax > 5.0f);
                const unsigned cd = c | (x < 0.f ? 8u : 0u);
                if (i < 8) lo |= cd << (4 * i); else hi |= cd << (4 * (i - 8)); }
            u32x2 w; w.x = lo; w.y = hi;
            *(u32x2*)(p.ws + OFF_TV8 + (size_t)e * 512 + lane * 8) = w;
            if (lane == 0) ((float*)(p.ws + OFF_SCV))[e] = am > 0.f ? am / 6.0f : 1.0f;
            }
            }
    }
}
__device__ __forceinline__ void phase_p0b(const P& p, char* lds) {
    const size_t gtid = (size_t)blockIdx.x * NTHR + otid(), gstr = (size_t)gridDim.x * NTHR;
    const float* mod = (const float*)(p.ws + OFF_MOD); bf16_t* h1 = (bf16_t*)(p.ws + OFF_H1);
    for (size_t i8 = gtid; i8 < (size_t)T * DM / 8; i8 += gstr) { const size_t e = i8 * 8; const int t = (int)(e >> 10), d = (int)(e & 1023), b = t >> 13;
        const f32x4 x0 = *(const f32x4*)(p.x + e), x1 = *(const f32x4*)(p.x + e + 4);
        const float* mb = mod + b * 6144;
        const f32x4 sh0 = *(const f32x4*)(mb + d), sh1 = *(const f32x4*)(mb + d + 4), sc0 = *(const f32x4*)(mb + 1024 + d), sc1 = *(const f32x4*)(mb + 1024 + d + 4);
        *(u32x4*)(h1 + e) = pack8(x0 * (sc0 + 1.0f) + sh0, x1 * (sc1 + 1.0f) + sh1); }
}

__device__ __forceinline__ void phase_g1(const P& p, char* lds) {
    const int tid = otid(); const size_t gtid = (size_t)blockIdx.x * NTHR + tid, gstr = (size_t)gridDim.x * NTHR;
    float* mod = (float*)(p.ws + OFF_MOD);
    {
        float* sl = (float*)lds; float* red = sl + 8192;
        for (int i = tid; i < 8192; i += NTHR) { const float cv = p.c[i]; sl[i] = cv / (1.0f + expf(-cv)); }
        __syncthreads();
        for (int cb = blockIdx.x; cb < 256; cb += gridDim.x) {
            if (tid < 510) { const int ks = tid / 6, c4 = tid - ks * 6; const float* wp = p.w_ada + (size_t)ks * 6144 + cb * 24 + c4 * 4;
                f32x4 w[13];
#pragma unroll
                for (int i = 0; i < 13; ++i) w[i] = (i < 12 || ks < 4) ? *(const f32x4*)(wp + (size_t)i * 85 * 6144) : (f32x4){0.f, 0.f, 0.f, 0.f};
                f32x4 a[8];
#pragma unroll
                for (int b = 0; b < 8; ++b) a[b] = (f32x4){0.f, 0.f, 0.f, 0.f};
#pragma unroll
                for (int i = 0; i < 13; ++i) { const int k = min(ks + 85 * i, 1023);
#pragma unroll
                    for (int b = 0; b < 8; ++b) a[b] += w[i] * sl[b * 1024 + k]; }
#pragma unroll
                for (int b = 0; b < 8; ++b) *(f32x4*)(red + (ks * 8 + b) * 24 + c4 * 4) = a[b]; }
            __syncthreads();
            if (tid < 192) { const int b = tid / 24, col = tid % 24, n = cb * 24 + col; float s = p.b_ada[n];
#pragma unroll 5
                for (int ks = 0; ks < 85; ++ks) s += red[(ks * 8 + b) * 24 + col];
                mod[b * 6144 + n] = s; }
            __syncthreads();
        }
    }
    {
        typedef float f32x2 __attribute__((ext_vector_type(2)));
        f32x2* cs = (f32x2*)(p.ws + OFF_CS);
        const double invf = exp(-9.210340371976184 * (double)(int)(gtid & 15) / 16.0);
        for (size_t idx = gtid; idx < (size_t)T * 16; idx += gstr) { const int t = (int)(idx >> 4);
            const double ang = (double)p.pos[t] * invf; const float r = (float)(ang - 6.283185307179586 * rint(ang * 0.15915494309189535));
            cs[idx] = (f32x2){cosf(r), sinf(r)}; }
    }
    __syncthreads();
    typedef float f32x2 __attribute__((ext_vector_type(2)));
    f32x2* Apl = (f32x2*)lds;
    f32x2* BB = Apl + 9 * 64;
    f32x2* CC = BB + 64 * 16;
    for (int wi = blockIdx.x; wi < 256; wi += gridDim.x) {
        const int g = wi & 31, slice = wi >> 5;
        __syncthreads();
        const double dt = exp((double)p.log_dt[g]);
        for (int idx = tid; idx < 9 * 64; idx += NTHR) { const int kl = idx >> 6, pp = idx & 63, k = (kl < 8) ? slice * 8 + kl : 64; const double lr = p.lam_re[g * 64 + pp], li = p.lam_im[g * 64 + pp];
            const double mag = exp((double)k * lr * dt), ang = (double)k * li * dt; const f32x2 v = (f32x2){(float)(mag * cos(ang)), (float)(mag * sin(ang))};
            Apl[idx] = v; if (kl < 8 || slice == 7) ((f32x2*)(p.ws + OFF_APOW))[((size_t)g * 65 + k) * 64 + pp] = v; }
        for (int idx = tid; idx < 1024; idx += NTHR) { const int pp = idx >> 4, h = idx & 15; const double lr = p.lam_re[g * 64 + pp], li = p.lam_im[g * 64 + pp];
            const double mag = exp(lr * dt), abr = mag * cos(li * dt), abi = mag * sin(li * dt), den = lr * lr + li * li, nr = abr - 1.0;
            const double cr = (nr * lr + abi * li) / den, ci = (abi * lr - nr * li) / den, br = p.b_re[(g * 64 + pp) * 16 + h], bi = p.b_im[(g * 64 + pp) * 16 + h];
            const f32x2 bv = (f32x2){(float)(cr * br - ci * bi), (float)(cr * bi + ci * br)}; BB[idx] = bv;
            const int hh = idx >> 6, p2 = idx & 63; const f32x2 cv = (f32x2){p.c_re[(g * 16 + hh) * 64 + p2], p.c_im[(g * 16 + hh) * 64 + p2]}; CC[idx] = cv;
            if (slice == 0) { ((f32x2*)(p.ws + OFF_BBCC))[(size_t)g * 2048 + idx] = bv; ((f32x2*)(p.ws + OFF_BBCC))[(size_t)g * 2048 + 1024 + idx] = cv; } }
        __syncthreads();
        for (int e = tid; e < 8 * 256; e += NTHR) { const int kl = e >> 8, h = (e >> 4) & 15, h2 = e & 15, k = slice * 8 + kl; float acc = 0.f;
            for (int pp = 0; pp < 64; ++pp) { const f32x2 c = CC[h * 64 + pp], a = Apl[kl * 64 + pp], b = BB[pp * 16 + h2];
                const float xr = c.x * a.x - c.y * a.y, xi = c.x * a.y + c.y * a.x; acc += xr * b.x - xi * b.y; }
            if (k == 0 && h == h2) acc += p.s5_d[g * 16 + h];
            ((float*)(p.ws + OFF_KTAB))[(size_t)g * 16384 + k * 256 + (e & 255)] = acc; }
    }
}
__device__ __forceinline__ void phase_g2(const P& p, char* lds) {
    const int tid = otid(), lane = tid & 63; const size_t gtid = (size_t)blockIdx.x * NTHR + tid, gstr = (size_t)gridDim.x * NTHR;
    const bool rev = (blockIdx.x >> 3) & 1;
#pragma unroll 1
    for (int step = 0; step < 5; ++step) {
        const int task = rev ? 4 - step : step;
        if (task == 0) {


    const float* mod = (const float*)(p.ws + OFF_MOD); bf16_t* h1 = (bf16_t*)(p.ws + OFF_H1);
    if (gstr == (size_t)131072) {
        const size_t e0 = gtid * 8; const int d = (int)(e0 & 1023);
#pragma unroll 1
        for (int b = 0; b < 8; ++b) { const float* mb = mod + b * 6144;
            const f32x4 sh0 = *(const f32x4*)(mb + d), sh1 = *(const f32x4*)(mb + d + 4), sc0 = *(const f32x4*)(mb + 1024 + d) + 1.0f, sc1 = *(const f32x4*)(mb + 1024 + d + 4) + 1.0f;
#pragma unroll
            for (int k = 0; k < 8; ++k) { const size_t e = e0 + ((size_t)(b * 8 + k) << 20);
                const f32x4 x0 = *(const f32x4*)(p.x + e), x1 = *(const f32x4*)(p.x + e + 4);
                *(u32x4*)(h1 + e) = pack8(x0 * sc0 + sh0, x1 * sc1 + sh1); } }
    } else {
#pragma unroll 4
    for (size_t i8 = gtid; i8 < (size_t)T * DM / 8; i8 += gstr) { const size_t e = i8 * 8; const int t = (int)(e >> 10), d = (int)(e & 1023), b = t >> 13;
        const f32x4 x0 = *(const f32x4*)(p.x + e), x1 = *(const f32x4*)(p.x + e + 4);
        const float* mb = mod + b * 6144;
        const f32x4 sh0 = *(const f32x4*)(mb + d), sh1 = *(const f32x4*)(mb + d + 4), sc0 = *(const f32x4*)(mb + 1024 + d), sc1 = *(const f32x4*)(mb + 1024 + d + 4);
        *(u32x4*)(h1 + e) = pack8(x0 * (sc0 + 1.0f) + sh0, x1 * (sc1 + 1.0f) + sh1); }
    }
        } else if (task == 1) {
    {
        const int wv = (int)(gtid >> 6), nwv = (int)(gstr >> 6);
#pragma unroll 2
        for (int r = wv; r < 2 * 16384; r += nwv) { const int which = r >> 14, e = r & 16383; const float* src = (which ? p.pv : p.pu) + (size_t)e * 1024 + lane * 16;
            f32x4 v[4]; float am = 0.f;
#pragma unroll
            for (int i = 0; i < 4; ++i) { v[i] = *(const f32x4*)(src + 4 * i); am = fmaxf(am, fmaxf(fmaxf(fabsf(v[i][0]), fabsf(v[i][1])), fmaxf(fabsf(v[i][2]), fabsf(v[i][3])))); }
#pragma unroll
            for (int o = 32; o > 0; o >>= 1) am = fmaxf(am, __shfl_xor(am, o));
            if (which == 0) {
                const float sc4 = am > 0.f ? 6.0f / am : 1.0f; unsigned lo = 0u, hi = 0u;
#define FK_E4(W, I, B4) W = __builtin_amdgcn_cvt_scalef32_pk_fp4_f32(W, v[(I) >> 2][(I) & 3] * sc4, v[((I) + 1) >> 2][((I) + 1) & 3] * sc4, 1.0f, B4);
                FK_E4(lo, 0, 0) FK_E4(lo, 2, 1) FK_E4(lo, 4, 2) FK_E4(lo, 6, 3) FK_E4(hi, 8, 0) FK_E4(hi, 10, 1) FK_E4(hi, 12, 2) FK_E4(hi, 14, 3)
#undef FK_E4
                u32x2 w4; w4.x = lo; w4.y = hi;
                *(u32x2*)(p.ws + OFF_TU4 + (size_t)e * 512 + lane * 8) = w4;
                if (lane == 0) ((float*)(p.ws + OFF_SCU4))[e] = am > 0.f ? am / 6.0f : 1.0f;
            } else {
            const float sc = am > 0.f ? 6.0f / am : 1.0f; unsigned lo = 0u, hi = 0u;
#define FK_E4(W, I, B4) W = __builtin_amdgcn_cvt_scalef32_pk_fp4_f32(W, v[(I) >> 2][(I) & 3] * sc, v[((I) + 1) >> 2][((I) + 1) & 3] * sc, 1.0f, B4);
            FK_E4(lo, 0, 0) FK_E4(lo, 2, 1) FK_E4(lo, 4, 2) FK_E4(lo, 6, 3) FK_E4(hi, 8, 0) FK_E4(hi, 10, 1) FK_E4(hi, 12, 2) FK_E4(hi, 14, 3)
#undef FK_E4
            u32x2 w; w.x = lo; w.y = hi;
            *(u32x2*)(p.ws + OFF_TV8 + (size_t)e * 512 + lane * 8) = w;
            if (lane == 0) ((float*)(p.ws + OFF_SCV))[e] = am > 0.f ? am / 6.0f : 1.0f;
            }
            }
    }
        } else if (task == 2) {
    {
        float* tl = (float*)lds;
        for (int tile = blockIdx.x; tile < 776; tile += gridDim.x) {
            const float* W; const float* sc; bf16_t* Bt; int ldw, ldb, kT, krow0 = 0, coladd = 0, colmul = 64, nreal = 1 << 30, tt = tile;
            if (tt < 320) { W = p.w_in; sc = nullptr; Bt = (bf16_t*)(p.ws + OFF_BT1); ldw = 1184; ldb = 1024; kT = 16; nreal = 1184; }
            else if ((tt -= 320) < 72) { W = p.w_uq; sc = p.q_norm; Bt = (bf16_t*)(p.ws + OFF_BTQ); ldw = 768; ldb = 384; kT = 6; }
            else if ((tt -= 72) < 32) { W = p.w_ukv; sc = p.kv_norm; Bt = (bf16_t*)(p.ws + OFF_BTK); ldw = 1024; ldb = 256; kT = 4; colmul = 128; }
            else if ((tt -= 32) < 32) { W = p.w_ukv; sc = p.kv_norm; Bt = (bf16_t*)(p.ws + OFF_ATV); ldw = 1024; ldb = 256; kT = 4; colmul = 128; coladd = 64; }
            else if ((tt -= 32) < 64) { W = p.w_glu; sc = nullptr; Bt = (bf16_t*)(p.ws + OFF_BTG); ldw = 512; ldb = 512; kT = 8; }
            else if ((tt -= 64) < 128) { W = p.w_out; sc = p.gn_s5; Bt = (bf16_t*)(p.ws + OFF_BTO1); ldw = 1024; ldb = 512; kT = 8; }
            else { tt -= 128; W = p.w_out; sc = p.gn_mla; Bt = (bf16_t*)(p.ws + OFF_BTO2); ldw = 1024; ldb = 512; kT = 8; krow0 = 512; }
            const int nt_ = tt / kT, k0 = (tt - nt_ * kT) * 64, n0 = nt_ * 64, col0 = nt_ * colmul + coladd, nval = nreal - n0;
            __syncthreads();
            {   const int r = tid >> 3, c8 = (tid & 7) * 8; const float g = sc ? sc[k0 + r] : 1.0f; const float* src = W + (size_t)(krow0 + k0 + r) * ldw + col0 + c8;
                const f32x4 z4 = {0.f, 0.f, 0.f, 0.f}; const f32x4 v0 = (c8 < nval) ? *(const f32x4*)src : z4, v1 = (c8 + 4 < nval) ? *(const f32x4*)(src + 4) : z4;
#pragma unroll
                for (int i = 0; i < 4; ++i) { tl[r * 65 + c8 + i] = v0[i] * g; tl[r * 65 + c8 + 4 + i] = v1[i] * g; } }
            __syncthreads();
            {   const int n = tid >> 3, kq = (tid & 7) * 8; f32x4 o0, o1;
#pragma unroll
                for (int i = 0; i < 4; ++i) { o0[i] = tl[(kq + i) * 65 + n]; o1[i] = tl[(kq + 4 + i) * 65 + n]; }
                *(u32x4*)(Bt + (size_t)(n0 + n) * ldb + k0 + kq) = pack8(o0, o1); }
        }
    }
        } else if (task == 3) {
    {
        float* Kt = (float*)lds; float* Wq = Kt + 64 * 129;
        for (int tile = blockIdx.x; tile < 32 * 16; tile += gridDim.x) { const int nb = tile >> 4, kb = tile & 15, n0 = nb * 64, k0 = kb * 64, hh = n0 >> 8, half = (n0 >> 7) & 1, key0 = n0 & 127;
            const float* keys = (half ? p.keys2 : p.keys1) + ((size_t)hh * 128 + key0) * 128;
            __syncthreads();
            for (int e = tid; e < 64 * 128; e += NTHR) { const int r = e >> 7, d = e & 127; Kt[r * 129 + d] = keys[(size_t)r * 128 + d]; Wq[e] = p.w_query[(size_t)(k0 + r) * 2048 + hh * 256 + half * 128 + d]; }
            __syncthreads();
            const int tn = tid & 63, tk = (tid >> 6) * 8; float acc[8];
#pragma unroll
            for (int i = 0; i < 8; ++i) acc[i] = 0.f;
            for (int d = 0; d < 128; d += 4) { const float k0 = Kt[tn * 129 + d], k1 = Kt[tn * 129 + d + 1], k2 = Kt[tn * 129 + d + 2], k3 = Kt[tn * 129 + d + 3];
#pragma unroll
                for (int i = 0; i < 8; ++i) { const f32x4 wq = *(const f32x4*)(Wq + (tk + i) * 128 + d); acc[i] += (k0 * wq[0] + k1 * wq[1]) + (k2 * wq[2] + k3 * wq[3]); } }
            u32x4 w; w.x = cvt_pk_bf16(acc[0], acc[1]); w.y = cvt_pk_bf16(acc[2], acc[3]); w.z = cvt_pk_bf16(acc[4], acc[5]); w.w = cvt_pk_bf16(acc[6], acc[7]);
            *(u32x4*)((bf16_t*)(p.ws + OFF_WST) + (size_t)(n0 + tn) * 1024 + k0 + tk) = w; }
    }
        } else {


    typedef float f32x2 __attribute__((ext_vector_type(2)));
    f32x2* Apow = (f32x2*)lds;
    f32x2* BB = Apow + 65 * 64;
    f32x2* CC = BB + 64 * 16;
    float* Ktab = (float*)(CC + 16 * 64);
    for (int wi = blockIdx.x; wi < 256; wi += gridDim.x) {
        const int g = wi & 31, slice = wi >> 5;
        __syncthreads();
        for (int idx = tid; idx < 65 * 64; idx += NTHR) Apow[idx] = ((const f32x2*)(p.ws + OFF_APOW))[(size_t)g * 65 * 64 + idx];
        for (int idx = tid; idx < 2048; idx += NTHR) BB[idx] = ((const f32x2*)(p.ws + OFF_BBCC))[(size_t)g * 2048 + idx];
        for (int idx = tid; idx < 16384 / 4; idx += NTHR) ((f32x4*)Ktab)[idx] = ((const f32x4*)(p.ws + OFF_KTAB))[(size_t)g * 4096 + idx];
        __syncthreads();
        unsigned* wt = (unsigned*)(p.ws + OFF_WT) + ((size_t)g * 1024 + slice * 128) * 576;
        for (int e = tid; e < 128 * 576; e += NTHR) { const int nl = e / 576, k = (e - nl * 576) * 2, n = slice * 128 + nl, i = n >> 4, h = n & 15; float v0, v1;
            if (k >= 128 + 256 * ((i >> 4) + 1)) continue;
            if (k >= 128) { const int kk = k - 128, j = kk >> 4, h2 = kk & 15; v0 = (j <= i) ? Ktab[((i - j) * 16 + h) * 16 + h2] : 0.f; v1 = (j <= i) ? Ktab[((i - j) * 16 + h) * 16 + h2 + 1] : 0.f; }
            else { const int q = k, pp = q & 63; const f32x2 c0 = CC[h * 64 + pp], a0 = Apow[(i + 1) * 64 + pp], c1 = CC[h * 64 + pp + 1], a1 = Apow[(i + 1) * 64 + pp + 1];
                if (q < 64) { v0 = c0.x * a0.x - c0.y * a0.y; v1 = c1.x * a1.x - c1.y * a1.y; } else { v0 = -(c0.x * a0.y + c0.y * a0.x); v1 = -(c1.x * a1.y + c1.y * a1.x); } }
            wt[e] = cvt_pk_bf16(v0, v1); }
        for (int e = tid; e < 2 * 32 * 256; e += NTHR) { const int kh = e >> 13, rl = (e >> 8) & 31, kk = (e & 255) * 2, row = slice * 32 + rl; float v0 = 0.f, v1 = 0.f;
            if (row < 128) { const int pp = row & 63, j = kh * 32 + (kk >> 4), h2 = kk & 15; const f32x2 a = Apow[(63 - j) * 64 + pp], b0 = BB[pp * 16 + h2], b1 = BB[pp * 16 + h2 + 1];
                if (row < 64) { v0 = a.x * b0.x - a.y * b0.y; v1 = a.x * b1.x - a.y * b1.y; } else { v0 = a.x * b0.y + a.y * b0.x; v1 = a.x * b1.y + a.y * b1.x; } }
            ((unsigned*)(p.ws + OFF_WSS))[(((size_t)(g * 2 + kh) * 256 + row) * 512 + kk) >> 1] = cvt_pk_bf16(v0, v1); }
        if (slice == 0 && tid < 64) ((f32x2*)(p.ws + OFF_A64))[g * 64 + tid] = Apow[64 * 64 + tid];
    }
        }
        __syncthreads();
    }
}
struct PtrP1 { const char* A; const char* B; __device__ void fill(Unit& u, int PM, int pn) const { u.pm = PM; u.pn = pn; u.pz = 0; u.a = A + (size_t)PM * 256 * 1024 * 2; u.b = B + (size_t)pn * 256 * 1024 * 2; } };
struct EpiP1 {
    static constexpr bool PERM = true, AFTER_DRAIN = false;
    bf16_t* UG; bf16_t* cq; bf16_t* ckv; float* partq; float* partkv; bf16_t* Kimg; const float* cs;
    __device__ __forceinline__ void operator()(const f32x4 (&acc)[2][2][4][2], const Unit& u, int wr, int wc, int fr_, int fq_) const {
        int fr = fr_, fq = fq_; asm volatile("" : "+v"(fr), "+v"(fq));
#pragma unroll
        for (int bj = 0; bj < 2; ++bj) {
            const int c32 = u.pn * 256 + bj * 128 + wc * 32, c8 = c32 + 8 * fq;
#pragma unroll
            for (int ai = 0; ai < 2; ++ai)
#pragma unroll
                for (int m = 0; m < 4; ++m) {
                    const int t = u.pm * 256 + ai * 128 + wr * 64 + m * 16 + fr;
                    const f32x4 v0 = acc[ai][bj][m][0], v1 = acc[ai][bj][m][1];
                    if (c32 < 512) {
                        *(u32x4*)(UG + ((size_t)(c8 >> 4) * 1024 + (t >> 6)) * 1152 + 128 + (t & 63) * 16 + (c8 & 15)) = pack8(v0, v1);
                    } else if (c32 < 1152) {
                        float s = (v0[0] * v0[0] + v0[1] * v0[1]) + (v0[2] * v0[2] + v0[3] * v0[3]) + (v1[0] * v1[0] + v1[1] * v1[1]) + (v1[2] * v1[2] + v1[3] * v1[3]);
                        s += __shfl_xor(s, 16); s += __shfl_xor(s, 32);
                        if (c32 < 896) { *(u32x4*)(cq + (size_t)t * 384 + (c8 - 512)) = pack8(v0, v1); if (fq == 0) partq[(size_t)t * 12 + ((c32 - 512) >> 5)] = s; }
                        else { *(u32x4*)(ckv + (size_t)t * 256 + (c8 - 896)) = pack8(v0, v1); if (fq == 0) partkv[(size_t)t * 8 + ((c32 - 896) >> 5)] = s; }
                    } else if (c32 < 1184) {
                        const float* csr = cs + ((size_t)t * 16 + (fq & 1) * 8) * 2;
                        f32x4 o0, o1;
#pragma unroll
                        for (int e = 0; e < 4; ++e) {
                            const float a0 = v0[e], a1 = v1[e], b0 = __shfl_xor(a0, 32), b1 = __shfl_xor(a1, 32);
                            const float c0 = csr[e * 2], s0 = csr[e * 2 + 1], c1 = csr[(4 + e) * 2], s1 = csr[(4 + e) * 2 + 1];
                            o0[e] = (fq < 2) ? a0 * c0 - b0 * s0 : a0 * c0 + b0 * s0;
                            o1[e] = (fq < 2) ? a1 * c1 - b1 * s1 : a1 * c1 + b1 * s1; }
                        const u32x4 w = pack8(o0, o1);
                        const int b = t >> 13, tile = (t & 8191) >> 6, key = t & 63;
#pragma unroll
                        for (int h = 0; h < 8; ++h) *(u32x4*)(Kimg + ((((size_t)(b * 8 + h) * 128 + tile) * 12 + 8 + fq) * 64 + key) * 8) = w;
                    }
                }
        }
    }
};
__device__ __forceinline__ void phase_p1(const P& p, char* lds) {
    OrderT<PtrP1> S; PtrP1 pt; pt.A = p.ws + OFF_H1; pt.B = p.ws + OFF_BT1; S.init(T / 256, 5, (int)gridDim.x, (int)blockIdx.x, pt);
    EpiP1 E; E.UG = (bf16_t*)(p.ws + OFF_UG); E.cq = (bf16_t*)(p.ws + OFF_CQ); E.ckv = (bf16_t*)(p.ws + OFF_CKV); E.partq = (float*)(p.ws + OFF_PQ); E.partkv = (float*)(p.ws + OFF_PKV);
    E.Kimg = (bf16_t*)(p.ws + OFF_KIMG); E.cs = (const float*)(p.ws + OFF_CS);
    Gemm g; g.K = 1024; g.lda = 1024; g.ldb = 1024;
    pg8::gemm_phase<EpiP1, OrderT<PtrP1>, false>((PG8_LAS unsigned char*)lds, g, S, E, nullptr);
}


constexpr size_t OFF_QB = OFF_R1;
constexpr size_t OFF_E = OFF_R1 + (size_t)T * 8 * 96 * 2;
constexpr size_t OFF_YMLA = OFF_R2;
constexpr float QSCALE = 0.10206207261596577f * 1.4426950408889634f;
struct PtrAB { const char* A; const char* B; size_t sa, sb; __device__ void fill(Unit& u, int PM, int pn) const { u.pm = PM; u.pn = pn; u.pz = 0; u.a = A + (size_t)PM * sa; u.b = B + (size_t)pn * sb; } };
struct EpiQ {
    static constexpr bool PERM = true, AFTER_DRAIN = false;
    bf16_t* Qb; const float* rqa; const float* cs;
    __device__ __forceinline__ void operator()(const f32x4 (&acc)[2][2][4][2], const Unit& u, int wr, int wc, int fr_, int fq_) const {
        int fr = fr_, fq = fq_; asm volatile("" : "+v"(fr), "+v"(fq));
        float rq[8];
#pragma unroll
        for (int r8 = 0; r8 < 8; ++r8) rq[r8] = rqa[u.pm * 256 + (r8 >> 2) * 128 + wr * 64 + (r8 & 3) * 16 + fr];
        const int g0 = (u.pn * 256 + wc * 32) >> 5, j0 = g0 % 3, j1 = (g0 + 4) % 3;
        const bool rope = (j0 == 2) || (j1 == 2);
#pragma unroll
        for (int rp = 0; rp < 4; ++rp) { const int ai = rp >> 1, mb = (rp & 1) * 2;
            f32x4 csv[2][4];
            if (rope) {
#pragma unroll
                for (int mm = 0; mm < 2; ++mm) { const int t = u.pm * 256 + ai * 128 + wr * 64 + (mb + mm) * 16 + fr; const f32x4* csr = (const f32x4*)(cs + ((size_t)t * 16 + (fq & 1) * 8) * 2);
#pragma unroll
                    for (int q = 0; q < 4; ++q) csv[mm][q] = csr[q]; } }
#pragma unroll
            for (int mm = 0; mm < 2; ++mm) { const int m = mb + mm; const int t = u.pm * 256 + ai * 128 + wr * 64 + m * 16 + fr; const float rqv = rq[ai * 4 + m];
#pragma unroll
                for (int bj = 0; bj < 2; ++bj) {
                    const int c32 = u.pn * 256 + bj * 128 + wc * 32, g32 = c32 >> 5, h = g32 / 3, j = g32 - 3 * h;
                    f32x4 v0 = acc[ai][bj][m][0] * rqv, v1 = acc[ai][bj][m][1] * rqv;
                    if (j == 2) {
                        f32x4 o0, o1;
#pragma unroll
                        for (int e = 0; e < 4; ++e) {
                            const float a0 = v0[e], a1 = v1[e], b0 = __shfl_xor(a0, 32), b1 = __shfl_xor(a1, 32);
                            const float c0 = csv[mm][e >> 1][(e & 1) * 2], s0 = csv[mm][e >> 1][(e & 1) * 2 + 1], c1 = csv[mm][2 + (e >> 1)][(e & 1) * 2], s1 = csv[mm][2 + (e >> 1)][(e & 1) * 2 + 1];
                            o0[e] = (fq < 2) ? a0 * c0 - b0 * s0 : a0 * c0 + b0 * s0;
                            o1[e] = (fq < 2) ? a1 * c1 - b1 * s1 : a1 * c1 + b1 * s1; }
                        v0 = o0; v1 = o1;
                    }
                    *(u32x4*)(Qb + ((size_t)((t >> 13) * 8 + h) * SEQ + (t & 8191)) * 96 + j * 32 + 8 * fq) = pack8(v0, v1);
                }
            }
            asm volatile("" ::: "memory");
        }
    }
};
struct EpiK {
    static constexpr bool PERM = true, AFTER_DRAIN = false;
    bf16_t* Kimg; const float* partkv;
    __device__ __forceinline__ void operator()(const f32x4 (&acc)[2][2][4][2], const Unit& u, int wr, int wc, int fr_, int fq_) const {
        int fr = fr_, fq = fq_; asm volatile("" : "+v"(fr), "+v"(fq));
#pragma unroll
        for (int ai = 0; ai < 2; ++ai)
#pragma unroll
            for (int m = 0; m < 4; ++m) { const int t = u.pm * 256 + ai * 128 + wr * 64 + m * 16 + fr;
                const float rk = partkv[t];
                const int bb = t >> 13, tile = (t & 8191) >> 6, key = t & 63;
#pragma unroll
                for (int bj = 0; bj < 2; ++bj) { const int c8 = u.pn * 256 + bj * 128 + wc * 32 + 8 * fq, h = c8 >> 6, chunk = (c8 & 63) >> 3;
                    *(u32x4*)(Kimg + ((((size_t)(bb * 8 + h) * 128 + tile) * 12 + chunk) * 64 + key) * 8) = pack8(acc[ai][bj][m][0] * rk, acc[ai][bj][m][1] * rk); }
                }
    }
};
struct EpiV {
    static constexpr bool PERM = false, AFTER_DRAIN = false;
    bf16_t* Vimg; const float* partkv;
    __device__ __forceinline__ void operator()(const f32x4 (&acc)[2][2][4][2], const Unit& u, int wr, int wc, int fr_, int fq_) const {
        int fr = fr_, fq = fq_; asm volatile("" : "+v"(fr), "+v"(fq));
#pragma unroll
        for (int bj = 0; bj < 2; ++bj)
#pragma unroll
            for (int n = 0; n < 2; ++n) {
                const int tk = u.pn * 256 + bj * 128 + wc * 32 + 16 * n + 4 * fq;
                const f32x4 rk = *(const f32x4*)(partkv + tk);
                const int bb = tk >> 13, tile = (tk & 8191) >> 6, key = tk & 63, pos = ((fq & 1) << 3) | ((fq >> 1) << 2), g = (key >> 4) * 2 + (pos >> 3);
#pragma unroll
                for (int ai = 0; ai < 2; ++ai)
#pragma unroll
                    for (int m = 0; m < 4; ++m) { const int r = u.pm * 256 + ai * 128 + wr * 64 + m * 16 + fr, h = r >> 6, d = r & 63;
                        const f32x4 v = acc[ai][bj][m][n] * rk; u32x2 w; w.x = cvt_pk_bf16(v[0], v[1]); w.y = cvt_pk_bf16(v[2], v[3]);
                        *(u32x2*)(Vimg + ((size_t)(bb * 8 + h) * 128 + tile) * 4096 + d * 64 + ((g ^ ((d >> 1) & 7)) * 8) + (pos & 7)) = w; }
                asm volatile("" ::: "memory");
            }
    }
};

struct PtrState { const char* UG; const char* W; __device__ void fill(Unit& u, int PM, int pn) const { u.pm = PM; u.pn = pn; u.pz = 0; const int g = PM >> 2, rt = PM & 3;
    u.a = UG + ((size_t)(g * 1024 + rt * 256) * 1152 + 128 + pn * 512) * 2; u.b = W + (size_t)(g * 2 + pn) * 256 * 512 * 2; } };
struct EpiE {
    static constexpr bool PERM = false, AFTER_DRAIN = false;
    float* E;
    __device__ __forceinline__ void operator()(const f32x4 (&acc)[2][2][4][2], const Unit& u, int wr, int wc, int fr_, int fq_) const {
        int fr = fr_, fq = fq_; asm volatile("" : "+v"(fr), "+v"(fq));
        const int g = u.pm >> 2, rt = u.pm & 3;
#pragma unroll
        for (int ai = 0; ai < 2; ++ai)
#pragma unroll
            for (int m = 0; m < 4; ++m) { const int c = rt * 256 + ai * 128 + wr * 64 + m * 16 + fr;
#pragma unroll
                for (int n = 0; n < 2; ++n) *(f32x4*)(E + ((size_t)(g * 2 + u.pn) * 1024 + c) * 128 + wc * 32 + 16 * n + 4 * fq) = acc[ai][0][m][n]; }
    }
};
__device__ __forceinline__ void phase_p2(const P& p, char* lds) {
    {
        const int tid = otid(); float* rqa = (float*)(p.ws + OFF_RQ); float* rka = (float*)(p.ws + OFF_RK); const float* partq = (const float*)(p.ws + OFF_PQ); const float* partkv = (const float*)(p.ws + OFF_PKV);
        PtrAB pt0; pt0.A = nullptr; pt0.B = nullptr; pt0.sa = 0; pt0.sb = 0; Unit u;
        {   OrderT<PtrAB> S; S.init(T / 256, 3, (int)gridDim.x, (int)blockIdx.x, pt0);
            for (int i = 0; S.next(i, u); ++i) if (tid < 256) { const int t = u.pm * 256 + tid; const f32x4* pp = (const f32x4*)(partq + (size_t)t * 12);
                const f32x4 a = pp[0], b = pp[1], c = pp[2]; const float s = ((a[0] + a[1]) + (a[2] + a[3])) + ((b[0] + b[1]) + (b[2] + b[3])) + ((c[0] + c[1]) + (c[2] + c[3]));
                rqa[t] = QSCALE / sqrtf(s * (1.0f / 384.0f) + 1e-6f); } }
#define FK_RKROW(T_) { const int t = (T_); const f32x4* pp = (const f32x4*)(partkv + (size_t)t * 8); const f32x4 a = pp[0], b = pp[1]; \
            rka[t] = 1.0f / sqrtf((((a[0] + a[1]) + (a[2] + a[3])) + ((b[0] + b[1]) + (b[2] + b[3]))) * (1.0f / 256.0f) + 1e-6f); }
        {   OrderT<PtrAB> S; S.init(T / 256, 2, (int)gridDim.x, (int)blockIdx.x, pt0);
            for (int i = 0; S.next(i, u); ++i) if (tid < 256) FK_RKROW(u.pm * 256 + tid) }
        {   OrderT<PtrAB> S; S.init(2, T / 256, (int)gridDim.x, (int)blockIdx.x, pt0);
            for (int i = 0; S.next(i, u); ++i) if (tid < 256) FK_RKROW(u.pn * 256 + tid) }
#undef FK_RKROW
        asm volatile("s_waitcnt vmcnt(0)" ::: "memory"); __syncthreads();
    }
    {   OrderT<PtrAB> S; PtrAB pt; pt.A = p.ws + OFF_CQ; pt.B = p.ws + OFF_BTQ; pt.sa = (size_t)256 * 384 * 2; pt.sb = (size_t)256 * 384 * 2; S.init(T / 256, 3, (int)gridDim.x, (int)blockIdx.x, pt);
        EpiQ E; E.Qb = (bf16_t*)(p.ws + OFF_QB); E.rqa = (const float*)(p.ws + OFF_RQ); E.cs = (const float*)(p.ws + OFF_CS);
        Gemm g; g.K = 384; g.lda = 384; g.ldb = 384;
        pg8::gemm_phase<EpiQ, OrderT<PtrAB>, false>((PG8_LAS unsigned char*)lds, g, S, E, nullptr); }
    __syncthreads();
    {   OrderT<PtrAB> S; PtrAB pt; pt.A = p.ws + OFF_CKV; pt.B = p.ws + OFF_BTK; pt.sa = (size_t)256 * 256 * 2; pt.sb = (size_t)256 * 256 * 2; S.init(T / 256, 2, (int)gridDim.x, (int)blockIdx.x, pt);
        EpiK E; E.Kimg = (bf16_t*)(p.ws + OFF_KIMG); E.partkv = (const float*)(p.ws + OFF_RK);
        Gemm g; g.K = 256; g.lda = 256; g.ldb = 256;
        pg8::gemm_phase<EpiK, OrderT<PtrAB>, false>((PG8_LAS unsigned char*)lds, g, S, E, nullptr); }
    __syncthreads();
    {   OrderT<PtrAB> S; PtrAB pt; pt.A = p.ws + OFF_ATV; pt.B = p.ws + OFF_CKV; pt.sa = (size_t)256 * 256 * 2; pt.sb = (size_t)256 * 256 * 2; S.init(2, T / 256, (int)gridDim.x, (int)blockIdx.x, pt);
        EpiV E; E.Vimg = (bf16_t*)(p.ws + OFF_VIMG); E.partkv = (const float*)(p.ws + OFF_RK);
        Gemm g; g.K = 256; g.lda = 256; g.ldb = 256;
        pg8::gemm_phase<EpiV, OrderT<PtrAB>, false>((PG8_LAS unsigned char*)lds, g, S, E, nullptr); }
    __syncthreads();
    {   OrderT<PtrState> S; PtrState pt; pt.UG = p.ws + OFF_UG; pt.W = p.ws + OFF_WSS; S.init(128, 2, (int)gridDim.x, (int)blockIdx.x, pt);
        EpiE E; E.E = (float*)(p.ws + OFF_E);
        Gemm g; g.K = 512; g.lda = 1152; g.ldb = 512;
        pg8::gemm_phase<EpiE, OrderT<PtrState>, false>((PG8_LAS unsigned char*)lds, g, S, E, nullptr); }
}
typedef short bf16x8 __attribute__((ext_vector_type(8)));
typedef float f32x16 __attribute__((ext_vector_type(16)));
#define FK_MFMA32(a, b, c) __builtin_amdgcn_mfma_f32_32x32x16_bf16(a, b, c, 0, 0, 0)
constexpr int ATT_TILE_BYTES = 20480;
__device__ __forceinline__ void attn_stage(const bf16_t* kt, const bf16_t* vt, PG8_LAS unsigned char* buf, int w, int lane) {
    const bf16_t* s0 = kt + w * 512 + lane * 8;
    const bf16_t* s1 = (w < 4) ? kt + (w + 8) * 512 + lane * 8 : vt + (w - 4) * 512 + lane * 8;
    __builtin_amdgcn_global_load_lds((const unsigned*)s0, (PG8_LAS unsigned*)(buf + w * 1024), 16, 0, 0);
    __builtin_amdgcn_global_load_lds((const unsigned*)s1, (PG8_LAS unsigned*)(buf + (w + 8) * 1024), 16, 0, 0);
    if (w < 4) __builtin_amdgcn_global_load_lds((const unsigned*)(vt + (w + 4) * 512 + lane * 8), (PG8_LAS unsigned*)(buf + (w + 16) * 1024), 16, 0, 0);
}
__device__ __forceinline__ void attn_unit(const P& p, PG8_LAS unsigned char* lds, int b, int h, int qb) {
    const int tid = otid(), lane = tid & 63, r32 = lane & 31, hi = lane >> 5; const int w = __builtin_amdgcn_readfirstlane(tid >> 6);
    const bf16_t* kimg = (const bf16_t*)(p.ws + OFF_KIMG) + (size_t)(b * 8 + h) * 128 * 6144;
    const bf16_t* vimg = (const bf16_t*)(p.ws + OFF_VIMG) + (size_t)(b * 8 + h) * 128 * 4096;
    const int q0 = qb * 256 + w * 32, NT = 4 * qb + 4, my_nt = 4 * qb + (w >> 1) + 1;
    const bf16_t* qrow = (const bf16_t*)(p.ws + OFF_QB) + ((size_t)(b * 8 + h) * SEQ + q0 + r32) * 96;
    bf16x8 qf[6];
#pragma unroll
    for (int d0 = 0; d0 < 6; ++d0) qf[d0] = *(const bf16x8*)(qrow + d0 * 16 + hi * 8);
    f32x16 o0, o1;
#pragma unroll
    for (int r = 0; r < 16; ++r) { o0[r] = 0.f; o1[r] = 0.f; }
    float m_ref = 0.f, l_run = 0.f; f32x16 negm, s0, s1;
#pragma unroll
    for (int r = 0; r < 16; ++r) negm[r] = 0.f;
#define FK_QK(dst0, dst1, kb_) { _Pragma("unroll") for (int d0 = 0; d0 < 6; ++d0) { \
        const bf16x8 k0_ = *(const PG8_LAS bf16x8*)((kb_) + ((2 * d0 + hi) * 64 + r32) * 16), k1_ = *(const PG8_LAS bf16x8*)((kb_) + ((2 * d0 + hi) * 64 + 32 + r32) * 16); \
        dst0 = FK_MFMA32(k0_, qf[d0], d0 == 0 ? negm : dst0); dst1 = FK_MFMA32(k1_, qf[d0], d0 == 0 ? negm : dst1); } }
#define FK_WAIT_OLDER() { if (w < 4) asm volatile("s_waitcnt vmcnt(3)" ::: "memory"); else asm volatile("s_waitcnt vmcnt(2)" ::: "memory"); }
    asm volatile("s_waitcnt vmcnt(0)" ::: "memory");
    attn_stage(kimg, vimg, lds, w, lane);
    attn_stage(kimg + 6144, vimg + 4096, lds + ATT_TILE_BYTES, w, lane);
    attn_stage(kimg + 2 * 6144, vimg + 2 * 4096, lds + 2 * ATT_TILE_BYTES, w, lane);
    FK_WAIT_OLDER()
    __syncthreads();
#define FK_SOFTMAX(first_) { \
            float mx = fmaxf(fmaxf(s0[0], s0[1]), s1[0]); \
            _Pragma("unroll") for (int r = 2; r < 16; r += 2) mx = fmaxf(fmaxf(mx, s0[r]), s0[r + 1]); \
            _Pragma("unroll") for (int r = 1; r < 15; r += 2) mx = fmaxf(fmaxf(mx, s1[r]), s1[r + 1]); \
            mx = fmaxf(mx, s1[15]); \
            mx = fmaxf(mx, __shfl_xor(mx, 32)); \
            if ((first_) || __builtin_amdgcn_ballot_w64(mx > 8.0f) != 0ull) { \
                const float delta = (first_) ? mx : fmaxf(mx, 0.f), sc = __builtin_amdgcn_exp2f(-delta); \
                m_ref += delta; l_run *= sc; \
                _Pragma("unroll") for (int r = 0; r < 16; ++r) { s0[r] -= delta; s1[r] -= delta; o0[r] *= sc; o1[r] *= sc; negm[r] = -m_ref; } \
            } \
            float ls0 = 0.f, ls1 = 0.f; \
            _Pragma("unroll") for (int r = 0; r < 8; ++r) { const float a0 = __builtin_amdgcn_exp2f(s0[2 * r]), a1 = __builtin_amdgcn_exp2f(s0[2 * r + 1]), b0 = __builtin_amdgcn_exp2f(s1[2 * r]), b1 = __builtin_amdgcn_exp2f(s1[2 * r + 1]); \
                ls0 += a0 + a1; ls1 += b0 + b1; pw[r] = cvt_pk_bf16(a0, a1); pw[8 + r] = cvt_pk_bf16(b0, b1); } \
            l_run += ls0 + ls1; }
#define FK_RDV(vb_) { _Pragma("unroll") for (int ks = 0; ks < 4; ++ks) { const int g = 2 * ks + hi; \
                vf0[ks] = *(const PG8_LAS bf16x8*)((vb_) + r32 * 128 + ((g ^ ((r32 >> 1) & 7)) * 16)); \
                vf1[ks] = *(const PG8_LAS bf16x8*)((vb_) + (32 + r32) * 128 + ((g ^ (((32 + r32) >> 1) & 7)) * 16)); } }
#define FK_RDK(kb_) { _Pragma("unroll") for (int d0 = 0; d0 < 6; ++d0) { kf0[d0] = *(const PG8_LAS bf16x8*)((kb_) + ((2 * d0 + hi) * 64 + r32) * 16); kf1[d0] = *(const PG8_LAS bf16x8*)((kb_) + ((2 * d0 + hi) * 64 + 32 + r32) * 16); } }
#define FK_PV() { _Pragma("unroll") for (int ks = 0; ks < 4; ++ks) { union { bf16x8 v; unsigned u[4]; } pf; \
                _Pragma("unroll") for (int jj = 0; jj < 4; ++jj) pf.u[jj] = pw[ks * 4 + jj]; \
                o0 = FK_MFMA32(vf0[ks], pf.v, o0); o1 = FK_MFMA32(vf1[ks], pf.v, o1); } }
#define FK_QKF() { s0 = FK_MFMA32(kf0[0], qf[0], negm); s1 = FK_MFMA32(kf1[0], qf[0], negm); \
                _Pragma("unroll") for (int d0 = 1; d0 < 6; ++d0) { s0 = FK_MFMA32(kf0[d0], qf[d0], s0); s1 = FK_MFMA32(kf1[d0], qf[d0], s1); } }
    if (w < 4) {
    FK_QK(s0, s1, lds)
    int slot = 0;
    for (int t = 0; t < NT; ++t) {
        if (t > 0) { if (t + 2 < NT) { FK_WAIT_OLDER() } else asm volatile("s_waitcnt vmcnt(0)" ::: "memory"); asm volatile("s_barrier" ::: "memory"); }
        const int slot1 = slot == 4 ? 0 : slot + 1, slot3 = slot >= 2 ? slot - 2 : slot + 3;
        if (t + 3 < NT) attn_stage(kimg + (size_t)(t + 3) * 6144, vimg + (size_t)(t + 3) * 4096, lds + slot3 * ATT_TILE_BYTES, w, lane);
        if (t < my_nt) {
            const bool more = (t + 1 < my_nt);
            const PG8_LAS unsigned char* kb1 = lds + slot1 * ATT_TILE_BYTES; const PG8_LAS unsigned char* vb = lds + slot * ATT_TILE_BYTES + 12288;
            bf16x8 kf0[6], kf1[6], vf0[4], vf1[4]; unsigned pw[16];
            FK_RDV(vb)
            __builtin_amdgcn_sched_barrier(0);
            FK_SOFTMAX(t == 0)
            __builtin_amdgcn_sched_barrier(0);
            if (more) FK_RDK(kb1)
            FK_PV()
            if (more) FK_QKF()
        }
        slot = slot1;
    }
    } else {
    unsigned pw[16];
#pragma unroll
    for (int r = 0; r < 16; ++r) { pw[r] = 0u; s0[r] = 0.f; s1[r] = 0.f; }
    int slot = 0;
    for (int t = 0; t < NT; ++t) {
        if (t > 0) { if (t + 2 < NT) { FK_WAIT_OLDER() } else asm volatile("s_waitcnt vmcnt(0)" ::: "memory"); asm volatile("s_barrier" ::: "memory"); }
        const int slot1 = slot == 4 ? 0 : slot + 1, slot3 = slot >= 2 ? slot - 2 : slot + 3, slotm = slot == 0 ? 4 : slot - 1;
        if (t + 3 < NT) attn_stage(kimg + (size_t)(t + 3) * 6144, vimg + (size_t)(t + 3) * 4096, lds + slot3 * ATT_TILE_BYTES, w, lane);
        const bool dopv = t >= 1 && t <= my_nt, doqk = t < my_nt;
        bf16x8 kf0[6], kf1[6], vf0[4], vf1[4];
        if (dopv) FK_RDV(lds + slotm * ATT_TILE_BYTES + 12288)
        if (doqk) FK_RDK(lds + slot * ATT_TILE_BYTES)
        if (dopv) FK_PV()
        if (doqk) { FK_QKF()
            __builtin_amdgcn_sched_barrier(0);
            __builtin_amdgcn_s_setprio(0);
            FK_SOFTMAX(t == 0)
            __builtin_amdgcn_s_setprio(2); }
        slot = slot1;
    }
    if (my_nt == NT) { bf16x8 vf0[4], vf1[4]; const int slotm = slot == 0 ? 4 : slot - 1;
        FK_RDV(lds + slotm * ATT_TILE_BYTES + 12288)
        FK_PV() }
    }
#undef FK_SOFTMAX
#undef FK_RDV
#undef FK_RDK
#undef FK_PV
#undef FK_QKF
    __syncthreads();
#undef FK_QK
#undef FK_WAIT_OLDER
    const float lt = l_run + __shfl_xor(l_run, 32), inv = 1.0f / lt;
    bf16_t* yrow = (bf16_t*)(p.ws + OFF_YMLA) + ((size_t)b * SEQ + q0 + r32) * 512 + h * 64;
    float ss = 0.f;
#pragma unroll
    for (int rg = 0; rg < 4; ++rg) {
        const float a0 = o0[4 * rg] * inv, a1 = o0[4 * rg + 1] * inv, a2 = o0[4 * rg + 2] * inv, a3 = o0[4 * rg + 3] * inv;
        const float b0 = o1[4 * rg] * inv, b1 = o1[4 * rg + 1] * inv, b2 = o1[4 * rg + 2] * inv, b3 = o1[4 * rg + 3] * inv;
        ss += (a0 * a0 + a1 * a1) + (a2 * a2 + a3 * a3) + (b0 * b0 + b1 * b1) + (b2 * b2 + b3 * b3);
        u32x2 wa, wb; wa.x = cvt_pk_bf16(a0, a1); wa.y = cvt_pk_bf16(a2, a3); wb.x = cvt_pk_bf16(b0, b1); wb.y = cvt_pk_bf16(b2, b3);
        *(u32x2*)(yrow + 8 * rg + 4 * hi) = wa; *(u32x2*)(yrow + 32 + 8 * rg + 4 * hi) = wb; }
    ss += __shfl_xor(ss, 32);
    if (hi == 0) ((float*)(p.ws + OFF_PMLA))[((size_t)b * SEQ + q0 + r32) * 8 + h] = ss;
}
__device__ __forceinline__ void s5_carry_scan(const P& p, char* lds) {
    typedef float f32x2 __attribute__((ext_vector_type(2)));
    const int tid_ = otid();
    float* el = (float*)lds;
    for (int cb = blockIdx.x; cb < 256; cb += gridDim.x) { const int g = cb & 31, b = cb >> 5;
        const float* e0 = (const float*)(p.ws + OFF_E) + ((size_t)(g * 2) * 1024 + b * 128) * 128; const float* e1 = e0 + (size_t)1024 * 128;
        __syncthreads();
#pragma unroll
        for (int i = 0; i < 8; ++i) { const int i4 = (i * NTHR + tid_) * 4; const f32x4 x0 = *(const f32x4*)(e0 + i4), x1 = *(const f32x4*)(e1 + i4); *(f32x4*)(el + i4) = x0 + x1; }
        __syncthreads();
        if (tid_ < 64) { const int pp = tid_; const f32x2 a = ((const f32x2*)(p.ws + OFF_A64))[g * 64 + pp];
            bf16_t* sp = (bf16_t*)(p.ws + OFF_UG) + ((size_t)g * 1024 + b * 128) * 1152 + pp;
            float sr = 0.f, si = 0.f;
#pragma unroll 8
            for (int cl = 0; cl < 128; ++cl) {
                sp[(size_t)cl * 1152] = (bf16_t)(cvt_pk_bf16(sr, 0.f) & 0xffffu); sp[(size_t)cl * 1152 + 64] = (bf16_t)(cvt_pk_bf16(si, 0.f) & 0xffffu);
                const float er = el[cl * 128 + pp], ei = el[cl * 128 + 64 + pp];
                const float nr = a.x * sr - a.y * si + er, ni = a.x * si + a.y * sr + ei; sr = nr; si = ni; } }
    }
    __syncthreads();
}
__device__ __forceinline__ void phase_p3(const P& p, char* lds) {
    s5_carry_scan(p, lds);
    const int xcd = blockIdx.x & 7, slot = blockIdx.x >> 3, nslot = gridDim.x >> 3;
    if (__builtin_amdgcn_readfirstlane(otid() >> 6) < 4) __builtin_amdgcn_s_setprio(1); else __builtin_amdgcn_s_setprio(2);
    for (int li = slot; li < 128; li += nslot) { const int bh = xcd + 8 * (li >> 4), pr = li & 15;
#pragma unroll 1
        for (int half = 0; half < 2; ++half) attn_unit(p, (PG8_LAS unsigned char*)lds, bh >> 3, bh & 7, half ? 31 - pr : pr); }
    __builtin_amdgcn_s_setprio(0);
}

constexpr size_t OFF_YG = OFF_R1, OFF_YS5 = OFF_R1 + (size_t)T * 512 * 2;
__device__ __forceinline__ float gelu_fast(float x) {
    const float z = x * (0.7978845608028654f + 0.035677408136300125f * x * x);
    return x * __builtin_amdgcn_rcpf(1.0f + __builtin_amdgcn_exp2f(-2.885390081777927f * z)); }
struct PtrToep { const char* UG; const char* W; __device__ void fill(Unit& u, int PM, int pn) const { u.pm = PM; u.pn = pn; u.pz = 0; const int g = PM >> 2, rt = PM & 3;
    u.a = UG + (size_t)(g * 1024 + rt * 256) * 1152 * 2; u.b = W + (size_t)(g * 1024 + pn * 256) * 1152 * 2; u.nt = 2 + 4 * (pn + 1); } };
struct OrderToep { int G, c; PtrToep pt;
    __device__ bool next(int i, Unit& u) const { const long L = (long)i * G + c; if (L >= 512) return false;
        const int half = (int)(L >> 8), idx = (int)(L & 255), x = idx & 7, slot = idx >> 3, g = x * 4 + (slot >> 3), rt = (slot >> 1) & 3, pnlow = slot & 1;
        pt.fill(u, g * 4 + rt, half ? 3 - pnlow : pnlow); return true; }
    __device__ __forceinline__ void a_ready(const Unit&) const {}
    __device__ __forceinline__ void done(const Unit&) const {}
};
struct EpiY {
    static constexpr bool PERM = true, AFTER_DRAIN = false;
    bf16_t* yg;
    __device__ __forceinline__ void operator()(const f32x4 (&acc)[2][2][4][2], const Unit& u, int wr, int wc, int fr_, int fq_) const {
        int fr = fr_, fq = fq_; asm volatile("" : "+v"(fr), "+v"(fq));
        const int g = u.pm >> 2, rt = u.pm & 3;
#pragma unroll
        for (int ai = 0; ai < 2; ++ai)
#pragma unroll
            for (int m = 0; m < 4; ++m) { const int c = rt * 256 + ai * 128 + wr * 64 + m * 16 + fr;
#pragma unroll
                for (int bj = 0; bj < 2; ++bj) { const int n8 = u.pn * 256 + bj * 128 + wc * 32 + 8 * fq, i = n8 >> 4, h0 = n8 & 15;
                    f32x4 v0 = acc[ai][bj][m][0], v1 = acc[ai][bj][m][1];
#pragma unroll
                    for (int e = 0; e < 4; ++e) { v0[e] = gelu_fast(v0[e]); v1[e] = gelu_fast(v1[e]); }
                    *(u32x4*)(yg + ((size_t)c * 64 + i) * 512 + g * 16 + h0) = pack8(v0, v1); } }
    }
};
__device__ __forceinline__ void phase_p4(const P& p, char* lds) {
    OrderToep S; S.pt.UG = p.ws + OFF_UG; S.pt.W = p.ws + OFF_WT; S.G = (int)gridDim.x; S.c = (int)blockIdx.x;
    EpiY E; E.yg = (bf16_t*)(p.ws + OFF_YG);
    Gemm g; g.K = 1152; g.lda = 1152; g.ldb = 1152;
    pg8::gemm_phase<EpiY, OrderToep, false>((PG8_LAS unsigned char*)lds, g, S, E, nullptr);
}
struct EpiG {
    static constexpr bool PERM = true, AFTER_DRAIN = false;
    const bf16_t* yg; bf16_t* ys5; float* parts5; const float* b_glu;
    __device__ __forceinline__ void operator()(const f32x4 (&acc)[2][2][4][2], const Unit& u, int wr, int wc, int fr_, int fq_) const {
        int fr = fr_, fq = fq_; asm volatile("" : "+v"(fr), "+v"(fq));
#pragma unroll
        for (int bj = 0; bj < 2; ++bj) { const int c32 = u.pn * 256 + bj * 128 + wc * 32, c8 = c32 + 8 * fq;
            const f32x4 bg0 = *(const f32x4*)(b_glu + c8), bg1 = *(const f32x4*)(b_glu + c8 + 4);
#pragma unroll
            for (int ai = 0; ai < 2; ++ai)
#pragma unroll
                for (int m = 0; m < 4; ++m) { const int t = u.pm * 256 + ai * 128 + wr * 64 + m * 16 + fr;
                    const u32x4 yw = *(const u32x4*)(yg + (size_t)t * 512 + c8);
                    const f32x4 z0 = acc[ai][bj][m][0] + bg0, z1 = acc[ai][bj][m][1] + bg1; f32x4 o0, o1;
#pragma unroll
                    for (int e = 0; e < 4; ++e) { const unsigned w0 = yw[e >> 1], w1 = yw[2 + (e >> 1)];
                        const float y0 = (e & 1) ? __uint_as_float(w0 & 0xffff0000u) : __uint_as_float(w0 << 16), y1 = (e & 1) ? __uint_as_float(w1 & 0xffff0000u) : __uint_as_float(w1 << 16);
                        o0[e] = y0 * __builtin_amdgcn_rcpf(1.0f + __builtin_amdgcn_exp2f(-1.4426950408889634f * z0[e])); o1[e] = y1 * __builtin_amdgcn_rcpf(1.0f + __builtin_amdgcn_exp2f(-1.4426950408889634f * z1[e])); }
                    float sq = (o0[0] * o0[0] + o0[1] * o0[1]) + (o0[2] * o0[2] + o0[3] * o0[3]) + (o1[0] * o1[0] + o1[1] * o1[1]) + (o1[2] * o1[2] + o1[3] * o1[3]);
                    sq += __shfl_xor(sq, 16); sq += __shfl_xor(sq, 32);
                    *(u32x4*)(ys5 + (size_t)t * 512 + c8) = pack8(o0, o1);
                    if (fq == 0) parts5[(size_t)t * 16 + (c32 >> 5)] = sq; }
            asm volatile("" ::: "memory"); }
    }
};
__device__ __forceinline__ void phase_p5(const P& p, char* lds) {
    OrderT<PtrAB> S; PtrAB pt; pt.A = p.ws + OFF_YG; pt.B = p.ws + OFF_BTG; pt.sa = (size_t)256 * 512 * 2; pt.sb = (size_t)256 * 512 * 2; S.init(T / 256, 2, (int)gridDim.x, (int)blockIdx.x, pt);
    EpiG E; E.yg = (const bf16_t*)(p.ws + OFF_YG); E.ys5 = (bf16_t*)(p.ws + OFF_YS5); E.parts5 = (float*)(p.ws + OFF_PS5); E.b_glu = p.b_glu;
    Gemm g; g.K = 512; g.lda = 512; g.ldb = 512;
    pg8::gemm_phase<EpiG, OrderT<PtrAB>, false>((PG8_LAS unsigned char*)lds, g, S, E, nullptr);
}

struct EpiPlain {
    static constexpr bool PERM = true, AFTER_DRAIN = false;
    bf16_t* O; int ldc, coff;
    __device__ __forceinline__ void operator()(const f32x4 (&acc)[2][2][4][2], const Unit& u, int wr, int wc, int fr_, int fq_) const {
        int fr = fr_, fq = fq_; asm volatile("" : "+v"(fr), "+v"(fq));
#pragma unroll
        for (int ai = 0; ai < 2; ++ai)
#pragma unroll
            for (int m = 0; m < 4; ++m) { bf16_t* rowp = O + (size_t)(u.pm * 256 + ai * 128 + wr * 64 + m * 16 + fr) * ldc + coff + u.pn * 256 + wc * 32 + 8 * fq;
#pragma unroll
                for (int bj = 0; bj < 2; ++bj) *(u32x4*)(rowp + bj * 128) = pack8(acc[ai][bj][m][0], acc[ai][bj][m][1]); }
    }
};
struct PtrP6 { const char* A1; const char* A2; const char* B1; const char* B2;
    __device__ void fill(Unit& u, int PM, int pn) const { u.pm = PM; u.pn = pn; u.pz = 0; const size_t st = (size_t)256 * 512 * 2;
        u.a = (pn < 4 ? A1 : A2) + (size_t)PM * st; u.b = pn < 4 ? B1 + (size_t)pn * st : B2 + (size_t)(pn - 4) * st; } };
__device__ __forceinline__ void phase_p6(const P& p, char* lds) {
    bf16_t* Y12 = (bf16_t*)p.out;
    OrderT<PtrP6> S; PtrP6 pt; pt.A1 = p.ws + OFF_YS5; pt.A2 = p.ws + OFF_YMLA; pt.B1 = p.ws + OFF_BTO1; pt.B2 = p.ws + OFF_BTO2; S.init(T / 256, 8, (int)gridDim.x, (int)blockIdx.x, pt);
    EpiPlain E; E.O = Y12; E.ldc = 2048; E.coff = 0; Gemm g; g.K = 512; g.lda = 512; g.ldb = 512;
    pg8::gemm_phase<EpiPlain, OrderT<PtrP6>, false>((PG8_LAS unsigned char*)lds, g, S, E, nullptr);
}
constexpr size_t OFF_X1 = OFF_R1, OFF_H2 = OFF_R6;
constexpr float DN_ALPHA = 1.189207115002721f;
__device__ __forceinline__ void unpack8(const u32x4 w, float (&o)[8]) {
#pragma unroll
    for (int i = 0; i < 4; ++i) { o[2 * i] = __uint_as_float(w[i] << 16); o[2 * i + 1] = __uint_as_float(w[i] & 0xffff0000u); } }
__device__ __forceinline__ void phase_p7(const P& p, char* lds) {
    const int tid = otid(), lane = tid & 63, w = tid >> 6, c0 = lane * 16;
    const bf16_t* Y12 = (const bf16_t*)p.out; const float* mod = (const float*)(p.ws + OFF_MOD);
    for (int tb = blockIdx.x; tb < T / 256; tb += gridDim.x) {
        const int b = (tb * 256) >> 13; const float* mb = mod + b * 6144;
        float g1[16], sc2[16], sh2[16], lg[16], lb[16];
#pragma unroll
        for (int i = 0; i < 16; ++i) { g1[i] = 1.0f + mb[2048 + c0 + i]; sc2[i] = 1.0f + mb[4096 + c0 + i]; sh2[i] = mb[3072 + c0 + i]; lg[i] = p.ln1_g[c0 + i]; lb[i] = p.ln1_b[c0 + i]; }
        for (int it = 0; it < 32; ++it) { const int t = tb * 256 + it * 8 + w;
            const float* ps = (const float*)(p.ws + OFF_PS5) + (size_t)t * 16; const float* pm = (const float*)(p.ws + OFF_PMLA) + (size_t)t * 8;
            float s5 = 0.f, sm = 0.f;
#pragma unroll
            for (int i = 0; i < 16; ++i) s5 += ps[i];
#pragma unroll
            for (int i = 0; i < 8; ++i) sm += pm[i];
            const float r5 = 1.0f / sqrtf(s5 * (1.0f / 512.0f) + 1e-6f), rm = 1.0f / sqrtf(sm * (1.0f / 512.0f) + 1e-6f);
            float y1[16], y2[16], v[16];
            unpack8(*(const u32x4*)(Y12 + (size_t)t * 2048 + c0), *(float(*)[8])&y1[0]); unpack8(*(const u32x4*)(Y12 + (size_t)t * 2048 + c0 + 8), *(float(*)[8])&y1[8]);
            unpack8(*(const u32x4*)(Y12 + (size_t)t * 2048 + 1024 + c0), *(float(*)[8])&y2[0]); unpack8(*(const u32x4*)(Y12 + (size_t)t * 2048 + 1024 + c0 + 8), *(float(*)[8])&y2[8]);
            float sum = 0.f;
#pragma unroll
            for (int i = 0; i < 4; ++i) { const f32x4 xv = *(const f32x4*)(p.x + (size_t)t * 1024 + c0 + 4 * i);
#pragma unroll
                for (int e = 0; e < 4; ++e) { const int k = 4 * i + e; v[k] = DN_ALPHA * xv[e] + g1[k] * (r5 * y1[k] + rm * y2[k]); sum += v[k]; } }
#pragma unroll
            for (int o = 32; o > 0; o >>= 1) sum += __shfl_xor(sum, o);
            const float mu = sum * (1.0f / 1024.0f); float q = 0.f;
#pragma unroll
            for (int k = 0; k < 16; ++k) { const float d = v[k] - mu; q += d * d; }
#pragma unroll
            for (int o = 32; o > 0; o >>= 1) q += __shfl_xor(q, o);
            const float rstd = 1.0f / sqrtf(q * (1.0f / 1024.0f) + 1e-6f);
            f32x4 a[4], hh[4];
#pragma unroll
            for (int k = 0; k < 16; ++k) { const float x1 = (v[k] - mu) * rstd * lg[k] + lb[k]; a[k >> 2][k & 3] = x1; hh[k >> 2][k & 3] = x1 * sc2[k] + sh2[k]; }
            *(u32x4*)((bf16_t*)(p.ws + OFF_X1) + (size_t)t * 1024 + c0) = pack8(a[0], a[1]); *(u32x4*)((bf16_t*)(p.ws + OFF_X1) + (size_t)t * 1024 + c0 + 8) = pack8(a[2], a[3]);
            *(u32x4*)((bf16_t*)(p.ws + OFF_H2) + (size_t)t * 1024 + c0) = pack8(hh[0], hh[1]); *(u32x4*)((bf16_t*)(p.ws + OFF_H2) + (size_t)t * 1024 + c0 + 8) = pack8(hh[2], hh[3]);
        }
    }
}
struct EpiS {
    static constexpr bool PERM = true, AFTER_DRAIN = false;
    bf16_t* S;
    __device__ __forceinline__ void operator()(const f32x4 (&acc)[2][2][4][2], const Unit& u, int wr, int wc, int fr_, int fq_) const {
        int fr = fr_, fq = fq_; asm volatile("" : "+v"(fr), "+v"(fq));
#pragma unroll
        for (int ai = 0; ai < 2; ++ai)
#pragma unroll
            for (int m = 0; m < 4; ++m) { const int t = u.pm * 256 + ai * 128 + wr * 64 + m * 16 + fr;
#pragma unroll
                for (int bj = 0; bj < 2; ++bj) { const int c8 = bj * 128 + wc * 32 + 8 * fq;
                    *(u32x4*)(S + ((((size_t)(t >> 6) * 8 + u.pn) * 32 + (c8 >> 3)) * 64 + (t & 63)) * 8) = pack8(acc[ai][bj][m][0], acc[ai][bj][m][1]); } }
    }
};
__device__ __forceinline__ void phase_p8(const P& p, char* lds) {
    OrderT<PtrAB> S; PtrAB pt; pt.A = p.ws + OFF_H2; pt.B = p.ws + OFF_WST; pt.sa = (size_t)256 * 1024 * 2; pt.sb = (size_t)256 * 1024 * 2; S.init(T / 256, 8, (int)gridDim.x, (int)blockIdx.x, pt);
    EpiS E; E.S = (bf16_t*)p.out; Gemm g; g.K = 1024; g.lda = 1024; g.ldb = 1024;
    pg8::gemm_phase<EpiS, OrderT<PtrAB>, false>((PG8_LAS unsigned char*)lds, g, S, E, nullptr);
}
constexpr size_t OFF_PK = OFF_R2;
#define FK_MED3(a, b, c) __builtin_amdgcn_fmed3f(a, b, c)
#define FK_INS16(L, x) { _Pragma("unroll") for (int j_ = 15; j_ >= 1; --j_) L[j_] = FK_MED3(L[j_ - 1], L[j_], (x)); L[0] = fmaxf(L[0], (x)); }
__device__ __forceinline__ void topk128(const bf16_t* sp, float (&L)[16]) {
#pragma unroll
    for (int j = 0; j < 16; ++j) L[j] = -INFINITY;
#pragma unroll 8
    for (int cg = 0; cg < 16; ++cg) { const u32x4 w = *(const u32x4*)(sp + (size_t)cg * 512);
#pragma unroll
        for (int i = 0; i < 4; ++i) { const float x0 = __uint_as_float((w[i] << 16) | (unsigned)(cg * 8 + 2 * i)), x1 = __uint_as_float((w[i] & 0xffff0000u) | (unsigned)(cg * 8 + 2 * i + 1));
            FK_INS16(L, x0) FK_INS16(L, x1) } }
}
__device__ __forceinline__ void phase_p9(const P& p, char* lds) {
    const int tid = otid(), lane = tid & 63, h = tid >> 6;
    const float* scu = (const float*)(p.ws + OFF_SCU); const float* scv = (const float*)(p.ws + OFF_SCV);
    for (int tb = blockIdx.x; tb < T / 64; tb += gridDim.x) {
        const bf16_t* sp = (const bf16_t*)p.out + (((size_t)tb * 8 + h) * 32 * 64 + lane) * 8;
        float A[16], B[16], TL[16];
        topk128(sp, A); topk128(sp + (size_t)16 * 512, B);
#pragma unroll
        for (int j = 0; j < 16; ++j) TL[j] = -INFINITY;
#pragma unroll
        for (int i = 0; i < 16; ++i)
#pragma unroll
            for (int j = 0; j < 16; ++j) if ((i + 1) * (j + 1) <= 16) {
                const unsigned ua = __float_as_uint(A[i]), ub = __float_as_uint(B[j]);
                const float sum = __uint_as_float(ua & 0xffffff80u) + __uint_as_float(ub & 0xffffff80u);
                const float key = __uint_as_float((__float_as_uint(sum) & 0xffffc000u) | ((ua & 127u) << 7) | (ub & 127u));
                FK_INS16(TL, key) }
        float e[16], den = 0.f; const float m0 = __uint_as_float(__float_as_uint(TL[0]) & 0xffffc000u);
#pragma unroll
        for (int j = 0; j < 16; ++j) { e[j] = __builtin_amdgcn_exp2f((__uint_as_float(__float_as_uint(TL[j]) & 0xffffc000u) - m0) * 1.4426950408889634f); den += e[j]; }
        const float rden = 1.0f / den;
        unsigned long long* pk = (unsigned long long*)(p.ws + OFF_PK) + ((size_t)(tb * 64 + lane) * 8 + h) * 16;
#pragma unroll
        for (int j = 0; j < 16; j += 2) { const unsigned id0 = __float_as_uint(TL[j]) & 0x3fffu, id1 = __float_as_uint(TL[j + 1]) & 0x3fffu;
            const float su0 = scu[id0], su1 = scu[id1], gv0 = e[j] * rden * scv[id0], gv1 = e[j + 1] * rden * scv[id1];
            u32x4 w; w.x = id0 | (cvt_pk_bf16(su0, 0.f) << 16); w.y = __float_as_uint(gv0); w.z = id1 | (cvt_pk_bf16(su1, 0.f) << 16); w.w = __float_as_uint(gv1);
            *(u32x4*)(pk + j) = w; }
    }
}
__device__ __forceinline__ f32x32 cvt32(const u32x3 a, const u32x3 b) { u32x6 w; w[0] = a.x; w[1] = a.y; w[2] = a.z; w[3] = b.x; w[4] = b.y; w[5] = b.z; return __builtin_amdgcn_cvt_scalef32_pk32_f32_fp6(w, 1.0f); }
__device__ __forceinline__ void phase_p10(const P& p, char* lds) {
    const int tid = otid(), lane = tid & 63; const int w = __builtin_amdgcn_readfirstlane(tid >> 6);
    const float* mod = (const float*)(p.ws + OFF_MOD); const unsigned l12 = (unsigned)lane * 12u;
    const __amdgpu_buffer_rsrc_t ru = __builtin_amdgcn_make_buffer_rsrc((void*)(p.ws + OFF_TU8), 0, 16384 * 768, 0x00020000), rv = __builtin_amdgcn_make_buffer_rsrc((void*)(p.ws + OFF_TV8), 0, 16384 * 768, 0x00020000);
    const int jl = ((lane >> 5) & 1) * 8 + ((lane >> 4) & 1) * 4 + ((lane >> 3) & 1) * 2 + ((lane >> 2) & 1);
    for (int t = blockIdx.x * 8 + w; t < T; t += gridDim.x * 8) {
        int c0 = lane * 16; asm volatile("" : "+v"(c0));
        float hv[16], acc[16];
        unpack8(*(const u32x4*)((const bf16_t*)(p.ws + OFF_H2) + (size_t)t * 1024 + c0), *(float(*)[8])&hv[0]); unpack8(*(const u32x4*)((const bf16_t*)(p.ws + OFF_H2) + (size_t)t * 1024 + c0 + 8), *(float(*)[8])&hv[8]);
#pragma unroll
        for (int i = 0; i < 16; ++i) acc[i] = 0.f;
        const unsigned long long* pk = (const unsigned long long*)(p.ws + OFF_PK) + (size_t)t * 128;
#pragma unroll 1
        for (int h = 0; h < 8; ++h) {
            unsigned ids[16];
#pragma unroll
            for (int j = 0; j < 16; ++j) ids[j] = (unsigned)__builtin_amdgcn_readfirstlane((int)(unsigned)pk[h * 16 + j]) & 0x3fffu;
            u32x3 ur[16], vr[16];
#pragma unroll
            for (int j = 0; j < 16; ++j) ur[j] = __builtin_amdgcn_raw_buffer_load_b96(ru, l12, ids[j] * 768u, 0);
#pragma unroll
            for (int j = 0; j < 8; ++j) vr[j] = __builtin_amdgcn_raw_buffer_load_b96(rv, l12, ids[j] * 768u, 0);
            const unsigned long long mine = pk[h * 16 + jl];
            float d[16];
#pragma unroll
            for (int j = 0; j < 16; j += 2) { const f32x32 uf = cvt32(ur[j], ur[j + 1]); f32x2 a0 = {0.f, 0.f}, a1 = {0.f, 0.f};
#pragma unroll
                for (int i = 0; i < 16; i += 2) { const f32x2 h2 = {hv[i], hv[i + 1]}; a0 += (f32x2){uf[i], uf[i + 1]} * h2; a1 += (f32x2){uf[16 + i], uf[17 + i]} * h2; }
                d[j] = a0[0] + a0[1]; d[j + 1] = a1[0] + a1[1]; }
            __builtin_amdgcn_sched_barrier(0);
#pragma unroll
            for (int j = 8; j < 16; ++j) vr[j] = __builtin_amdgcn_raw_buffer_load_b96(rv, l12, ids[j] * 768u, 0);
            { const bool b5 = lane & 32;
#pragma unroll
              for (int j = 0; j < 8; ++j) { const float keep = b5 ? d[j + 8] : d[j], give = b5 ? d[j] : d[j + 8]; d[j] = keep + __shfl_xor(give, 32); }
              const bool b4 = lane & 16;
#pragma unroll
              for (int j = 0; j < 4; ++j) { const float keep = b4 ? d[j + 4] : d[j], give = b4 ? d[j] : d[j + 4]; d[j] = keep + __shfl_xor(give, 16); }
              const bool b3 = lane & 8;
#pragma unroll
              for (int j = 0; j < 2; ++j) { const float keep = b3 ? d[j + 2] : d[j], give = b3 ? d[j] : d[j + 2]; d[j] = keep + __shfl_xor(give, 8); }
              const bool b2 = lane & 4;
              { const float keep = b2 ? d[1] : d[0], give = b2 ? d[0] : d[1]; d[0] = keep + __shfl_xor(give, 4); }
              d[0] += __shfl_xor(d[0], 2); d[0] += __shfl_xor(d[0], 1); }
            const float su = __uint_as_float(((unsigned)mine) & 0xffff0000u), gsv = __uint_as_float((unsigned)(mine >> 32));
            const float pre = d[0] * su; const float wgt = gsv * gelu_fast(pre);
#pragma unroll
            for (int j = 0; j < 16; j += 2) { const int src0 = ((j >> 3) & 1) * 32 + ((j >> 2) & 1) * 16 + ((j >> 1) & 1) * 8 + (j & 1) * 4, src1 = src0 + 4;
                const float w0 = __uint_as_float((unsigned)__builtin_amdgcn_readlane((int)__float_as_uint(wgt), src0)), w1 = __uint_as_float((unsigned)__builtin_amdgcn_readlane((int)__float_as_uint(wgt), src1));
                const f32x32 vf = cvt32(vr[j], vr[j + 1]);
#pragma unroll
                for (int i = 0; i < 16; ++i) acc[i] += w0 * vf[i] + w1 * vf[16 + i]; }
        }
        const float* mb = mod + (t >> 13) * 6144; float x1[16], v[16], sum = 0.f;
        unpack8(*(const u32x4*)((const bf16_t*)(p.ws + OFF_X1) + (size_t)t * 1024 + c0), *(float(*)[8])&x1[0]); unpack8(*(const u32x4*)((const bf16_t*)(p.ws + OFF_X1) + (size_t)t * 1024 + c0 + 8), *(float(*)[8])&x1[8]);
#pragma unroll
        for (int i = 0; i < 4; ++i) { const f32x4 g2 = *(const f32x4*)(mb + 5120 + c0 + 4 * i);
#pragma unroll
            for (int e = 0; e < 4; ++e) { const int k = 4 * i + e; v[k] = DN_ALPHA * x1[k] + (1.0f + g2[e]) * acc[k]; sum += v[k]; } }
#pragma unroll
        for (int o = 32; o > 0; o >>= 1) sum += __shfl_xor(sum, o);
        const float mu = sum * (1.0f / 1024.0f); float q = 0.f;
#pragma unroll
        for (int k = 0; k < 16; ++k) { const float dd = v[k] - mu; q += dd * dd; }
#pragma unroll
        for (int o = 32; o > 0; o >>= 1) q += __shfl_xor(q, o);
        const float rstd = 1.0f / sqrtf(q * (1.0f / 1024.0f) + 1e-6f);
#pragma unroll
        for (int i = 0; i < 4; ++i) { const f32x4 lg = *(const f32x4*)(p.ln2_g + c0 + 4 * i), lb = *(const f32x4*)(p.ln2_b + c0 + 4 * i); f32x4 o;
#pragma unroll
            for (int e = 0; e < 4; ++e) o[e] = (v[4 * i + e] - mu) * rstd * lg[e] + lb[e];
            *(f32x4*)(p.out + (size_t)t * 1024 + c0 + 4 * i) = o; }
    }
}

__device__ __forceinline__ void phase_p9p10(const P& p, char* lds) {
    const int tid = otid();
    const float* scu = (const float*)(p.ws + OFF_SCU); const float* scu4 = (const float*)(p.ws + OFF_SCU4); const float* scv = (const float*)(p.ws + OFF_SCV);

    const int w = __builtin_amdgcn_readfirstlane(tid >> 6);
    const float* mod = (const float*)(p.ws + OFF_MOD);
    const __amdgpu_buffer_rsrc_t ru = __builtin_amdgcn_make_buffer_rsrc((void*)(p.ws + OFF_TU8), 0, 16384 * 768, 0x00020000), rv = __builtin_amdgcn_make_buffer_rsrc((void*)(p.ws + OFF_TV8), 0, 16384 * 512, 0x00020000), ru4 = __builtin_amdgcn_make_buffer_rsrc((void*)(p.ws + OFF_TU4), 0, 16384 * 512, 0x00020000), ruv = __builtin_amdgcn_make_buffer_rsrc((void*)(p.ws + OFF_TV8), 0, 16384 * 1024, 0x00020000);
    const int nb = (T / 64 - (int)blockIdx.x + (int)gridDim.x - 1) / (int)gridDim.x;
    volatile PG8_LAS unsigned* qcnt = (volatile PG8_LAS unsigned*)(lds + 131072 + 64);
    if (tid == 0) { qcnt[0] = 0u; qcnt[1] = 0u; }
#pragma unroll 1
    for (int st = 0; st <= nb; ++st) {
      if (st == 0 || w == 7) {
        if (st >= 1 && (int)__builtin_amdgcn_mbcnt_hi(~0u, __builtin_amdgcn_mbcnt_lo(~0u, 0u)) == 0) qcnt[(st + 1) & 1] = 0u;
        if (st < nb) {
        const int tb = (int)blockIdx.x + st * (int)gridDim.x; char* ldb = lds + (st & 1) * 65536;
        const int h0 = st == 0 ? w : 0, h1 = st == 0 ? w + 1 : 8;
#pragma unroll 1
        for (int hh = h0; hh < h1; ++hh) {
        int lane_o = (int)__builtin_amdgcn_mbcnt_hi(~0u, __builtin_amdgcn_mbcnt_lo(~0u, 0u)); asm volatile("" : "+v"(lane_o));
        const bf16_t* sp = (const bf16_t*)p.out + (((size_t)tb * 8 + hh) * 32 * 64 + lane_o) * 8;
        float A[16], B[16], TL[16];
        topk128(sp, A); topk128(sp + (size_t)16 * 512, B);
#pragma unroll
        for (int j = 0; j < 16; ++j) TL[j] = -INFINITY;
#pragma unroll
        for (int i = 0; i < 16; ++i)
#pragma unroll
            for (int j = 0; j < 16; ++j) if ((i + 1) * (j + 1) <= 16) {
                const unsigned ua = __float_as_uint(A[i]), ub = __float_as_uint(B[j]);
                const float sum = __uint_as_float(ua & 0xffffff80u) + __uint_as_float(ub & 0xffffff80u);
                const float key = __uint_as_float((__float_as_uint(sum) & 0xffffc000u) | ((ua & 127u) << 7) | (ub & 127u));
                FK_INS16(TL, key) }
        float e[16], den = 0.f; const float m0 = __uint_as_float(__float_as_uint(TL[0]) & 0xffffc000u);
#pragma unroll
        for (int j = 0; j < 16; ++j) { e[j] = __builtin_amdgcn_exp2f((__uint_as_float(__float_as_uint(TL[j]) & 0xffffc000u) - m0) * 1.4426950408889634f); den += e[j]; }
        const float rden = 1.0f / den;
        PG8_LAS unsigned long long* pk = (PG8_LAS unsigned long long*)ldb + (lane_o * 8 + hh) * 16;
#pragma unroll
        for (int j = 0; j < 16; j += 2) { const unsigned id0 = __float_as_uint(TL[j]) & 0x3fffu, id1 = __float_as_uint(TL[j + 1]) & 0x3fffu;
            const float su0 = scu4[id0], su1 = scu4[id1], gv0 = e[j] * rden * scv[id0], gv1 = e[j + 1] * rden * scv[id1];
            u32x4 w; w.x = id0 | (cvt_pk_bf16(su0, 0.f) << 16); w.y = __float_as_uint(gv0); w.z = id1 | (cvt_pk_bf16(su1, 0.f) << 16); w.w = __float_as_uint(gv1);
            *(PG8_LAS u32x4*)(pk + j) = w; }
        }
            asm volatile("s_waitcnt lgkmcnt(0)" ::: "memory");
        }
      } else {
        const int tb = (int)blockIdx.x + (st - 1) * (int)gridDim.x; const char* ldb = lds + ((st - 1) & 1) * 65536;
        if (w & 1) __builtin_amdgcn_s_setprio(2); else __builtin_amdgcn_s_setprio(1);
        for (;;) { int c0 = (int)__builtin_amdgcn_mbcnt_hi(~0u, __builtin_amdgcn_mbcnt_lo(~0u, 0u)) * 16; asm volatile("" : "+v"(c0)); unsigned tk = 0u; if (c0 == 0) tk = __hip_atomic_fetch_add((PG8_LAS unsigned*)(lds + 131072 + 64) + (st & 1), 1u, __ATOMIC_RELAXED, __HIP_MEMORY_SCOPE_WORKGROUP);
            const int tl = __builtin_amdgcn_readfirstlane((int)tk); if (tl >= 64) break; const int t = tb * 64 + tl;
        const int jl = ((c0 >> 9) & 1) * 8 + ((c0 >> 8) & 1) * 4 + ((c0 >> 7) & 1) * 2 + ((c0 >> 6) & 1);
        typedef int i32x8 __attribute__((ext_vector_type(8)));
        const int ln = c0 >> 4, nn = ln & 15, cch = ln >> 4, jpar = nn & 1, e8 = nn >> 1;
        float acc[16]; float hinv; i32x8 Bq[4];
        {
            const bf16_t* hp = (const bf16_t*)(p.ws + OFF_H2) + (size_t)t * 1024 + 128 * jpar + 16 * cch;
            u32x4 hr[16];
#pragma unroll
            for (int q = 0; q < 4; ++q) { hr[4 * q] = *(const u32x4*)(hp + 256 * q); hr[4 * q + 1] = *(const u32x4*)(hp + 256 * q + 8); hr[4 * q + 2] = *(const u32x4*)(hp + 256 * q + 64); hr[4 * q + 3] = *(const u32x4*)(hp + 256 * q + 72); }
            unsigned mx = 0u;
#pragma unroll
            for (int i = 0; i < 16; ++i)
#pragma unroll
                for (int d = 0; d < 4; ++d) { const unsigned wv = hr[i][d]; mx = max(mx, (wv << 16) & 0x7fff0000u); mx = max(mx, wv & 0x7fff0000u); }
            float am = __uint_as_float(mx);
            am = fmaxf(am, __uint_as_float((unsigned)__builtin_amdgcn_ds_swizzle((int)__float_as_uint(am), (1 << 10) | 0x1f))); am = fmaxf(am, __uint_as_float((unsigned)__builtin_amdgcn_ds_swizzle((int)__float_as_uint(am), (16 << 10) | 0x1f)));
            { const auto r2 = __builtin_amdgcn_permlane32_swap(__float_as_uint(am), __float_as_uint(am), false, false); am = fmaxf(__uint_as_float(r2[0]), __uint_as_float(r2[1])); }
            const unsigned E = (__float_as_uint(am) >> 23) & 0xffu; const bool okE = E >= 8u && E <= 250u;
            const float hsc = okE ? __uint_as_float((261u - E) << 23) : 1.0f; hinv = okE ? __uint_as_float((E - 7u) << 23) : 1.0f;
#pragma unroll
            for (int q = 0; q < 4; ++q) { float hf[32];
                unpack8(hr[4 * q], *(float(*)[8])&hf[0]); unpack8(hr[4 * q + 1], *(float(*)[8])&hf[8]); unpack8(hr[4 * q + 2], *(float(*)[8])&hf[16]); unpack8(hr[4 * q + 3], *(float(*)[8])&hf[24]);
#pragma unroll
                for (int d4 = 0; d4 < 8; ++d4) { int p_ = __builtin_amdgcn_cvt_pk_fp8_f32(hf[4 * d4] * hsc, hf[4 * d4 + 1] * hsc, 0, false); p_ = __builtin_amdgcn_cvt_pk_fp8_f32(hf[4 * d4 + 2] * hsc, hf[4 * d4 + 3] * hsc, p_, true); Bq[q][d4] = p_; } } }
#pragma unroll
        for (int i = 0; i < 16; ++i) acc[i] = 0.f;
        const PG8_LAS unsigned long long* pk = (const PG8_LAS unsigned long long*)ldb + tl * 128;
#pragma unroll 1
        for (int h = 0; h < 8; ++h) {
            const unsigned idu0 = (unsigned)pk[h * 16 + e8] & 0x3fffu, idu1 = (unsigned)pk[h * 16 + 8 + e8] & 0x3fffu;
            const unsigned lo = (unsigned)((4 * jpar + cch) * 16);
            u32x4 ua[2][4];
#pragma unroll
            for (int q = 0; q < 4; ++q) { ua[0][q] = __builtin_amdgcn_raw_buffer_load_b128(ru4, idu0 * 512u + lo, (unsigned)q * 128u, 0); ua[1][q] = __builtin_amdgcn_raw_buffer_load_b128(ru4, idu1 * 512u + lo, (unsigned)q * 128u, 0); }
            unsigned ids[16];
#pragma unroll
            for (int j = 0; j < 16; ++j) ids[j] = (unsigned)__builtin_amdgcn_readfirstlane((int)(unsigned)pk[h * 16 + j]) & 0x3fffu;
            u32x2 vr[16];
#pragma unroll
            for (int j = 0; j < 16; ++j) vr[j] = __builtin_amdgcn_raw_buffer_load_b64(rv, (unsigned)c0 >> 1, ids[j] * 512u, 0);
            const u32x4 en0 = *(const PG8_LAS u32x4*)(pk + h * 16 + 2 * cch), en1 = *(const PG8_LAS u32x4*)(pk + h * 16 + 8 + 2 * cch);
            float wg[2][2];
#pragma unroll
            for (int G = 0; G < 2; ++G) { f32x4 cm = {0.f, 0.f, 0.f, 0.f};
#pragma unroll
                for (int q = 0; q < 4; ++q) { i32x8 A; A[0] = (int)ua[G][q].x; A[1] = (int)ua[G][q].y; A[2] = (int)ua[G][q].z; A[3] = (int)ua[G][q].w; A[4] = 0; A[5] = 0; A[6] = 0; A[7] = 0;
                    cm = __builtin_amdgcn_mfma_scale_f32_16x16x128_f8f6f4(A, Bq[q], cm, 4, 0, 0, 0x7f7f7f7f, 0, 0x7f7f7f7f); }
                const float x0 = jpar ? cm[1] : cm[0], x1 = jpar ? cm[3] : cm[2];
                const float t0 = x0 + __uint_as_float((unsigned)__builtin_amdgcn_ds_swizzle((int)__float_as_uint(x0), (1 << 10) | 0x1f)), t1 = x1 + __uint_as_float((unsigned)__builtin_amdgcn_ds_swizzle((int)__float_as_uint(x1), (1 << 10) | 0x1f));
                const u32x4 en = G ? en1 : en0;
                wg[G][0] = __uint_as_float(en.y) * gelu_fast(t0 * (__uint_as_float(en.x & 0xffff0000u) * hinv)); wg[G][1] = __uint_as_float(en.w) * gelu_fast(t1 * (__uint_as_float(en.z & 0xffff0000u) * hinv)); }
#pragma unroll
            for (int j = 0; j < 16; ++j) {
                const float wj = __uint_as_float((unsigned)__builtin_amdgcn_readlane((int)__float_as_uint(wg[j >> 3][j & 1]), ((j & 7) >> 1) * 16));
#define FK_AX4(B4) { const auto lo2 = __builtin_amdgcn_cvt_scalef32_pk_f32_fp4(vr[j].x, 1.0f, B4), hi2 = __builtin_amdgcn_cvt_scalef32_pk_f32_fp4(vr[j].y, 1.0f, B4); \
                    acc[2 * B4] += wj * lo2[0]; acc[2 * B4 + 1] += wj * lo2[1]; acc[8 + 2 * B4] += wj * hi2[0]; acc[8 + 2 * B4 + 1] += wj * hi2[1]; }
                FK_AX4(0) FK_AX4(1) FK_AX4(2) FK_AX4(3)
#undef FK_AX4
            }
        }
        const float* mb = mod + (t >> 13) * 6144; float x1[16], v[16], sum = 0.f;
        unpack8(*(const u32x4*)((const bf16_t*)(p.ws + OFF_X1) + (size_t)t * 1024 + c0), *(float(*)[8])&x1[0]); unpack8(*(const u32x4*)((const bf16_t*)(p.ws + OFF_X1) + (size_t)t * 1024 + c0 + 8), *(float(*)[8])&x1[8]);
#pragma unroll
        for (int i = 0; i < 4; ++i) { const f32x4 g2 = *(const f32x4*)(mb + 5120 + c0 + 4 * i);
#pragma unroll
            for (int e = 0; e < 4; ++e) { const int k = 4 * i + e; v[k] = DN_ALPHA * x1[k] + (1.0f + g2[e]) * acc[k]; sum += v[k]; } }
#pragma unroll
        for (int o = 32; o > 0; o >>= 1) sum += __shfl_xor(sum, o);
        const float mu = sum * (1.0f / 1024.0f); float q = 0.f;
#pragma unroll
        for (int k = 0; k < 16; ++k) { const float dd = v[k] - mu; q += dd * dd; }
#pragma unroll
        for (int o = 32; o > 0; o >>= 1) q += __shfl_xor(q, o);
        const float rstd = 1.0f / sqrtf(q * (1.0f / 1024.0f) + 1e-6f);
#pragma unroll
        for (int i = 0; i < 4; ++i) { const f32x4 lg = *(const f32x4*)(p.ln2_g + c0 + 4 * i), lb = *(const f32x4*)(p.ln2_b + c0 + 4 * i); f32x4 o;
#pragma unroll
            for (int e = 0; e < 4; ++e) o[e] = (v[4 * i + e] - mu) * rstd * lg[e] + lb[e];
            *(f32x4*)(p.out + (size_t)t * 1024 + c0 + 4 * i) = o; }
    }
        __builtin_amdgcn_s_setprio(0);
      }
      __syncthreads();
    }
}

template <int PH> __global__ __launch_bounds__(512, 2) void k_phase(P p) {
    extern __shared__ __attribute__((aligned(16))) char lds[];
    if constexpr (PH == 0) phase_p0a(p, lds);
    if constexpr (PH == 1) phase_p0b(p, lds);
    if constexpr (PH == 2) phase_p1(p, lds);
    if constexpr (PH == 3) phase_p2(p, lds);
    if constexpr (PH == 4) phase_p3(p, lds);
    if constexpr (PH == 5) phase_p0c(p, lds);
    if constexpr (PH == 6) phase_p4(p, lds);
    if constexpr (PH == 7) phase_p5(p, lds);
    if constexpr (PH == 8) phase_p0d(p, lds);
    if constexpr (PH == 9) phase_p6(p, lds);
    if constexpr (PH == 10) phase_p7(p, lds);
    if constexpr (PH == 11) phase_p8(p, lds);
    if constexpr (PH == 12) phase_p9(p, lds);
    if constexpr (PH == 13) phase_p10(p, lds);
}
template <int PH> static void launch_phase(const P& p, hipStream_t st) {
    static bool init = false;
    if (!init) { (void)hipFuncSetAttribute((const void*)k_phase<PH>, hipFuncAttributeMaxDynamicSharedMemorySize, LDS_BYTES); init = true; }
    hipLaunchKernelGGL(k_phase<PH>, dim3(256), dim3(NTHR), LDS_BYTES, st, p);
}
__global__ void k_adapt_proj(const char* ws, int b, float* proj) {
    const size_t idx = (size_t)blockIdx.x * 256 + threadIdx.x; if (idx >= (size_t)SEQ * 1184) return;
    const int tl = (int)(idx / 1184), c = (int)(idx % 1184), t = b * SEQ + tl;
    bf16_t v;
    if (c < 512) v = ((const bf16_t*)(ws + OFF_UG))[((size_t)(c >> 4) * 1024 + (t >> 6)) * 1152 + (t & 63) * 16 + (c & 15)];
    else if (c < 896) v = ((const bf16_t*)(ws + OFF_CQ))[(size_t)t * 384 + c - 512];
    else if (c < 1152) v = ((const bf16_t*)(ws + OFF_CKV))[(size_t)t * 256 + c - 896];
    else { const int i = c - 1152; v = ((const bf16_t*)(ws + OFF_KIMG))[((((size_t)(b * 8 + 0) * 128 + (tl >> 6)) * 12 + 8 + (i >> 3)) * 64 + (tl & 63)) * 8 + (i & 7)]; }
    proj[idx] = bf2f(v);
}
__global__ void k_adapt_ymla(const char* ws, int b, float* ymla) {
    const size_t idx = (size_t)blockIdx.x * 256 + threadIdx.x; if (idx >= (size_t)SEQ * 512) return;
    ymla[idx] = bf2f(((const bf16_t*)(ws + OFF_YMLA))[(size_t)b * SEQ * 512 + idx]);
}
__global__ void k_adapt_ys5(const char* ws, int b, float* ys5) {
    const size_t idx = (size_t)blockIdx.x * 256 + threadIdx.x; if (idx >= (size_t)SEQ * 512) return;
    ys5[idx] = bf2f(((const bf16_t*)(ws + OFF_YS5))[(size_t)b * SEQ * 512 + idx]);
}
__global__ void k_adapt_x1(const char* ws, int b, float* x1) {
    const size_t idx = (size_t)blockIdx.x * 256 + threadIdx.x; if (idx >= (size_t)SEQ * 1024) return;
    x1[idx] = bf2f(((const bf16_t*)(ws + OFF_X1))[(size_t)b * SEQ * 1024 + idx]);
}
}

namespace fk {
__global__ void __launch_bounds__(512, 2) mk_fwd(P p, unsigned* barw) {
    extern __shared__ __attribute__((aligned(16))) char lds[];
    if (threadIdx.x == 0) *(uint4*)(lds + 131072) = make_uint4(0u, 0u, 0u, 0u);
    if ((threadIdx.x & 63) == 0) wgt_file((int)(threadIdx.x >> 6));
    __syncthreads();
    XcdBarrier bar = xcd_barrier_post(barw, (volatile LAS unsigned*)(lds + 131072));
#define MK_PHASE(fn) { fn(p, lds); }
    MK_PHASE(phase_g1)
    xcd_barrier(bar);
    MK_PHASE(phase_g2)
    xcd_barrier(bar);
    MK_PHASE(phase_p1)
    xcd_barrier(bar);
    MK_PHASE(phase_p2)
    xcd_barrier(bar);
    MK_PHASE(phase_p3)
    xcd_barrier(bar);
    MK_PHASE(phase_p4)
    xcd_barrier(bar);
    MK_PHASE(phase_p5)
    xcd_barrier(bar);
    MK_PHASE(phase_p6)
    xcd_barrier(bar);
    MK_PHASE(phase_p7)
    xcd_barrier(bar);
    MK_PHASE(phase_p8)
    xcd_barrier(bar);
    MK_PHASE(phase_p9p10)
#undef MK_PHASE
}
}

extern "C" void kernel_launch(void* const* d_in, const int* in_sizes, int n_in, void* d_out, int out_size, void* d_ws, size_t ws_size, hipStream_t stream) {
    fk::P p{};
    p.x = (const float*)d_in[0]; p.c = (const float*)d_in[1]; p.pos = (const int*)d_in[2]; p.w_ada = (const float*)d_in[3]; p.b_ada = (const float*)d_in[4]; p.w_in = (const float*)d_in[5];
    p.lam_re = (const float*)d_in[6]; p.lam_im = (const float*)d_in[7]; p.log_dt = (const float*)d_in[8]; p.b_re = (const float*)d_in[9]; p.b_im = (const float*)d_in[10];
    p.c_re = (const float*)d_in[11]; p.c_im = (const float*)d_in[12]; p.s5_d = (const float*)d_in[13]; p.w_glu = (const float*)d_in[14]; p.b_glu = (const float*)d_in[15];
    p.q_norm = (const float*)d_in[16]; p.w_uq = (const float*)d_in[17]; p.kv_norm = (const float*)d_in[18]; p.w_ukv = (const float*)d_in[19]; p.gn_s5 = (const float*)d_in[20];
    p.gn_mla = (const float*)d_in[21]; p.w_out = (const float*)d_in[22]; p.ln1_g = (const float*)d_in[23]; p.ln1_b = (const float*)d_in[24]; p.w_query = (const float*)d_in[25];
    p.keys1 = (const float*)d_in[26]; p.keys2 = (const float*)d_in[27]; p.pu = (const float*)d_in[28]; p.pv = (const float*)d_in[29]; p.ln2_g = (const float*)d_in[30]; p.ln2_b = (const float*)d_in[31];
    p.out = (float*)d_out; p.ws = (char*)d_ws;
    static int grid = 0;
    if (!grid) {
        int dev = 0, cus = 0, per_cu = 0;
        (void)hipGetDevice(&dev);
        (void)hipDeviceGetAttribute(&cus, hipDeviceAttributeMultiprocessorCount, dev);
        (void)hipFuncSetAttribute((const void*)fk::mk_fwd, hipFuncAttributeMaxDynamicSharedMemorySize, fk::LDS_BYTES);
        (void)hipOccupancyMaxActiveBlocksPerMultiprocessor(&per_cu, fk::mk_fwd, fk::NTHR, fk::LDS_BYTES);
        grid = cus > 0 ? cus : 256;
        if (per_cu < 1) fprintf(stderr, "kernel_launch: occupancy query reports %d workgroups per CU\n", per_cu);
    }
    (void)hipMemsetAsync(d_ws, 0, fk::SZ_BAR, stream);
    hipLaunchKernelGGL(fk::mk_fwd, dim3(grid), dim3(fk::NTHR), fk::LDS_BYTES, stream, p, (unsigned*)d_ws);
}
```

```cpp
#include <hip/hip_runtime.h>
#include <hip/hip_bf16.h>
#include <stdint.h>
#include <stdio.h>
#define XB_TMO      128
#define XB_XCNT(j)  (256  + 64 * (j))
#define XB_XSUB(j)  (1280 + 64 * (j))
#define XB_XGEN(j)  (2304 + 64 * (j))
#define XB_TOP      3328
#define XB_TOPGEN   3392
#define XCD_BAR_WORDS 3456
#define XB_SPIN_CAP (1u << 22)
#define LAS __attribute__((address_space(3)))

__device__ __forceinline__ unsigned xb_ld(unsigned* p)              { return __hip_atomic_load(p, __ATOMIC_RELAXED, __HIP_MEMORY_SCOPE_AGENT); }
__device__ __forceinline__ unsigned xb_add(unsigned* p, unsigned v) { return __hip_atomic_fetch_add(p, v, __ATOMIC_RELAXED, __HIP_MEMORY_SCOPE_AGENT); }
#define WGT_LDS_OFF (131072 + 256)
__device__ __forceinline__ unsigned wgt_hw_slot() { return (unsigned)__builtin_amdgcn_s_getreg((5 << 11) | 4) & 63u; }
__device__ __forceinline__ void wgt_file(int wave_index) { ((volatile LAS int*)(unsigned)WGT_LDS_OFF)[wgt_hw_slot()] = wave_index; }
__device__ __forceinline__ int wgt_tid() {
    const int wv = __builtin_amdgcn_readfirstlane(((volatile LAS int*)(unsigned)WGT_LDS_OFF)[wgt_hw_slot()]);
    unsigned z = 0u; asm volatile("" : "+v"(z));
    return wv * 64 + (int)__builtin_amdgcn_mbcnt_hi(~0u, __builtin_amdgcn_mbcnt_lo(~0u, z));
}
__device__ __forceinline__ unsigned xb_xcc_id() { return (unsigned)__builtin_amdgcn_s_getreg((3 << 11) | 20) & 0xFu; }
#define XB_SPIN(cond, bar) do { unsigned _sp = 0; while (cond) { __builtin_amdgcn_s_sleep(1); \
    if ((++_sp & 255u) == 0u) { if (xb_ld(&(bar)[XB_TMO])) break; if (_sp > XB_SPIN_CAP) { atomicAdd(&(bar)[XB_TMO], 1u); break; } } } } while (0)

struct XcdBarrier {
    unsigned* bar; unsigned x;
    volatile LAS unsigned* st;
};

__device__ __forceinline__ XcdBarrier xcd_barrier_post(unsigned* bar, volatile LAS unsigned* st) {
    XcdBarrier b; b.bar = bar; b.x = xb_xcc_id(); b.st = st;
    if (wgt_tid() == 0) (void)xb_add(&bar[XB_XCNT(b.x)], 1u);
    return b;
}
__device__ __forceinline__ void xcd_barrier_complete(unsigned* bar, unsigned x, unsigned& nloc, unsigned& nx) {
    const unsigned G = gridDim.x * gridDim.y * gridDim.z;
    unsigned sum, cnt, mine, sp = 0u;
    for (;;) {
        sum = 0u; cnt = 0u; mine = 0u;
#pragma unroll
        for (unsigned j = 0; j < 16; ++j) { const unsigned c = xb_ld(&bar[XB_XCNT(j)]); sum += c; cnt += (c > 0u) ? 1u : 0u; mine = (j == x) ? c : mine; }
        if (sum == G) break;
        __builtin_amdgcn_s_sleep(1);
        if ((++sp & 255u) == 0u) { if (xb_ld(&bar[XB_TMO])) break; if (sp > XB_SPIN_CAP) { atomicAdd(&bar[XB_TMO], 1u); break; } }
    }
    nloc = mine > 0u ? mine : 1u; nx = cnt > 0u ? cnt : 1u;
}

__device__ __forceinline__ void xcd_barrier(const XcdBarrier& b) {
    asm volatile("s_waitcnt vmcnt(0)" ::: "memory");
    __syncthreads();
    if (wgt_tid() == 0) {
        unsigned* bar = b.bar;
        __builtin_amdgcn_s_waitcnt(0);
        unsigned nloc = b.st[0], nx = b.st[1];
        if (nloc == 0u) { xcd_barrier_complete(bar, b.x, nloc, nx); b.st[0] = nloc; b.st[1] = nx; }
        const unsigned old = xb_add(&bar[XB_XSUB(b.x)], 1u);
        const unsigned gen = old / nloc;
        if (old + 1u == (gen + 1u) * nloc) {
            __builtin_amdgcn_fence(__ATOMIC_RELEASE, "agent");
            asm volatile("s_waitcnt vmcnt(0)" ::: "memory");
            const unsigned og = xb_add(&bar[XB_TOP], 1u);
            const unsigned tg = og / nx;
            if (og + 1u == (tg + 1u) * nx) xb_add(&bar[XB_TOPGEN], 1u);
            else XB_SPIN(xb_ld(&bar[XB_TOPGEN]) == tg, bar);
            __builtin_amdgcn_fence(__ATOMIC_ACQUIRE, "agent");
            xb_add(&bar[XB_XGEN(b.x)], 1u);
            asm volatile("s_waitcnt vmcnt(0)" ::: "memory");
        } else {
            XB_SPIN(xb_ld(&bar[XB_XGEN(b.x)]) == gen, bar);
            __builtin_amdgcn_fence(__ATOMIC_ACQUIRE, "agent");
            asm volatile("s_waitcnt vmcnt(0)" ::: "memory");
        }
    }
    __syncthreads();
}


namespace pg8 {
#define PG8_LAS __attribute__((address_space(3)))
typedef unsigned short bf16_t;
typedef short bf16x8 __attribute__((ext_vector_type(8)));
typedef float f32x4 __attribute__((ext_vector_type(4)));
typedef unsigned u32x4 __attribute__((ext_vector_type(4)));
constexpr int BM = 256, BK = 64, HALF = 128, HTB = HALF * BK * 2  , STAGE_BYTES = 8 * HTB, NXCD = 8, WGM = 8;

__host__ __device__ __forceinline__ int lds_byte(int r, int c) { const int st = (r >> 4) * 2 + (c >> 5), rr = r & 15, cc = c & 31, ob = rr * 64 + cc * 2; return st * 1024 + (ob ^ (((ob >> 9) & 1) << 5)); }
__host__ __device__ __forceinline__ void stage_rc(int b, int& R, int& C) { const int st = b / 1024, sb = b % 1024, swz = sb ^ (((sb >> 9) & 1) << 5); R = (st >> 1) * 16 + swz / 64; C = (st & 1) * 32 + (swz % 64) / 2; }
__host__ __device__ __forceinline__ int perm32(int rho) { const int n = rho >> 4, i = rho & 15; return 8 * (i >> 2) + 4 * n + (i & 3); }

struct Unit { int pm, pn, pz; const char* a; const char* b; int nt; };
struct Gemm { int K, lda, ldb; };

struct StaticOrder {
    int nM, nN, nwg, G, c;
    __host__ __device__ void init(int M, int N, int G_, int c_) { nM = M / BM; nN = N / BM; nwg = nM * nN; G = G_; c = c_; }
    __host__ __device__ bool next(int i, Unit& u) const {
        const long L = (long)i * G + c; if (L >= nwg) return false;
        int wgid = (int)L; { const int q = nwg / NXCD, r = nwg % NXCD, xcd = wgid % NXCD, off = wgid / NXCD; wgid = (xcd < r ? xcd * (q + 1) : r * (q + 1) + (xcd - r) * q) + off; }
        const int nig = WGM * nN, gid = wgid / nig, fm = gid * WGM, gsz = (nM - fm) < WGM ? (nM - fm) : WGM;
        u.pm = fm + ((wgid % nig) % gsz); u.pn = (wgid % nig) / gsz; return true;
    }
    __device__ __forceinline__ void a_ready(const Unit&) const {}
    __device__ __forceinline__ void done(const Unit&) const {}
};
__device__ __forceinline__ unsigned cvt_pk_bf16(float lo, float hi) { unsigned r; asm volatile("v_cvt_pk_bf16_f32 %0, %1, %2" : "=v"(r) : "v"(lo), "v"(hi)); return r; }
typedef float f32x2 __attribute__((ext_vector_type(2)));
__device__ __forceinline__ f32x2 gelu_pk(f32x2 v) {
    const f32x2 av = __builtin_elementwise_abs(v), d = av * 0.2316418882f + 1.0f;
    f32x2 t; t.x = __builtin_amdgcn_rcpf(d.x); t.y = __builtin_amdgcn_rcpf(d.y);
    f32x2 q = t * 0.5307027145f + (-0.7265760135f); q = q * t + 0.7107068705f; q = q * t + (-0.142248368f); q = q * t + 0.127414796f; q = q * t;
    const f32x2 s = (v * v) * (-0.72134752044f);
    f32x2 e; e.x = __builtin_amdgcn_exp2f(s.x); e.y = __builtin_amdgcn_exp2f(s.y);
    const f32x2 m = v * (q * e), r = v - m;
    f32x2 o; o.x = v.x < 0.f ? m.x : r.x; o.y = v.y < 0.f ? m.y : r.y; return o;
}

struct EpiF32 {
    static constexpr bool PERM = false, AFTER_DRAIN = false;
    float* C; int ldc; const float* bias;
    __device__ __forceinline__ void operator()(const f32x4 (&acc)[2][2][4][2], const Unit& u, int wr, int wc, int fr, int fq) const {
        const int row0 = u.pm * BM + wr * 64 + fr, col0 = u.pn * BM + wc * 32 + 4 * fq;
        f32x4 bv[2][2];
#pragma unroll
        for (int bj = 0; bj < 2; ++bj)
#pragma unroll
            for (int n = 0; n < 2; ++n) bv[bj][n] = bias ? *(const f32x4*)(bias + col0 + bj * HALF + n * 16) : (f32x4){0.f, 0.f, 0.f, 0.f};
#pragma unroll
        for (int ai = 0; ai < 2; ++ai)
#pragma unroll
            for (int m = 0; m < 4; ++m) { float* rowp = C + (size_t)(row0 + ai * HALF + m * 16) * ldc + col0;
#pragma unroll
                for (int bj = 0; bj < 2; ++bj)
#pragma unroll
                    for (int n = 0; n < 2; ++n) *(f32x4*)(rowp + bj * HALF + n * 16) = acc[ai][bj][m][n] + bv[bj][n]; }
    }
};
template <int ACT  > struct EpiBf16 {
    static constexpr bool PERM = true, AFTER_DRAIN = false;
    bf16_t* O; int ldc; const float* bias; int split_cols; size_t split_stride;
    __device__ __forceinline__ void operator()(const f32x4 (&acc)[2][2][4][2], const Unit& u, int wr, int wc, int fr, int fq) const {
        const int row0 = u.pm * BM + wr * 64 + fr; int colt = u.pn * BM; bf16_t* base = O;
        if (split_cols) { const int t = colt / split_cols; base += (size_t)t * split_stride; colt -= t * split_cols; }
        const int col0 = colt + wc * 32 + 8 * fq, bcol0 = u.pn * BM + wc * 32 + 8 * fq;
        f32x4 bv[2][2];
#pragma unroll
        for (int bj = 0; bj < 2; ++bj)
#pragma unroll
            for (int n = 0; n < 2; ++n) bv[bj][n] = bias ? *(const f32x4*)(bias + bcol0 + bj * HALF + 4 * n) : (f32x4){0.f, 0.f, 0.f, 0.f};
#pragma unroll
        for (int ai = 0; ai < 2; ++ai)
#pragma unroll
            for (int m = 0; m < 4; ++m) { bf16_t* rowp = base + (size_t)(row0 + ai * HALF + m * 16) * ldc + col0;
#pragma unroll
                for (int bj = 0; bj < 2; ++bj) { f32x4 v0 = acc[ai][bj][m][0] + bv[bj][0], v1 = acc[ai][bj][m][1] + bv[bj][1];
                    if (ACT == 1) { f32x2 a = gelu_pk((f32x2){v0[0], v0[1]}), b = gelu_pk((f32x2){v0[2], v0[3]}), c = gelu_pk((f32x2){v1[0], v1[1]}), d = gelu_pk((f32x2){v1[2], v1[3]});
                        v0 = (f32x4){a.x, a.y, b.x, b.y}; v1 = (f32x4){c.x, c.y, d.x, d.y}; }
                    if (ACT == 2) {
#pragma unroll
                        for (int j = 0; j < 4; ++j) { v0[j] = 0.5f * v0[j] * (1.0f + erff(v0[j] * 0.70710678f)); v1[j] = 0.5f * v1[j] * (1.0f + erff(v1[j] * 0.70710678f)); } }
                    u32x4 w; w.x = cvt_pk_bf16(v0[0], v0[1]); w.y = cvt_pk_bf16(v0[2], v0[3]); w.z = cvt_pk_bf16(v1[0], v1[1]); w.w = cvt_pk_bf16(v1[2], v1[3]);
                    *(u32x4*)(rowp + bj * HALF) = w; } }
    }
};

template <class Epi, class Sched, bool STAMP = false>
__device__ __forceinline__ void gemm_phase(PG8_LAS unsigned char* lds, const Gemm g, const Sched& S, const Epi& E, unsigned long long* stamps) {
    int tid_op = wgt_tid(); asm volatile("" : "+v"(tid_op));
    const int tid = tid_op, wid = __builtin_amdgcn_readfirstlane(tid >> 6), lane = tid & 63, wr = wid >> 2, wc = wid & 3, fr = lane & 15, fq = lane >> 4;
    int Kop = g.K; asm volatile("" : "+s"(Kop));
    const int K = Kop, nt = K / BK;
    int ts_lo = 0, ts_hi = 0, nts = 0; const unsigned long long rt_entry = STAMP ? (unsigned long long)wall_clock64() : 0ull;
#define PG8_STAMP() do { if (STAMP && wid == 0 && nts < 64) { const unsigned long long _c = (unsigned long long)clock64(); \
        ts_lo = (lane == nts) ? (int)(unsigned)_c : ts_lo; ts_hi = (lane == nts) ? (int)(unsigned)(_c >> 32) : ts_hi; ++nts; } } while (0)
    PG8_STAMP();
    unsigned voffA[2], voffB[2];
#pragma unroll
    for (int i = 0; i < 2; ++i) { int R, C; stage_rc(tid * 16 + i * 8192, R, C); const int Rb = Epi::PERM ? ((R & ~31) + perm32(R & 31)) : R;
        voffA[i] = (unsigned)(R * g.lda + C) * 2u; voffB[i] = (unsigned)(Rb * g.ldb + C) * 2u; }
    const size_t kstep = (size_t)(BK * 2);
    const size_t hstepA = (size_t)HALF * g.lda * 2, hstepB = (size_t)HALF * g.ldb * 2;
    const unsigned ldsw = (unsigned)wid * 1024u;
    const int aoff = lds_byte(wr * 64 + fr, fq * 8), boff = lds_byte(wc * 32 + fr, fq * 8);
#define PG8_SA(b, h) (((b) * 2 + (h)) * HTB)
#define PG8_SB(b, h) ((4 + (b) * 2 + (h)) * HTB)
#define PG8_STAGE(bufoff, gbase, voff) do { _Pragma("unroll") for (int _i = 0; _i < 2; ++_i) \
        __builtin_amdgcn_global_load_lds((const unsigned*)((const char*)(gbase) + (voff)[_i]), (PG8_LAS unsigned*)(lds + (bufoff) + ldsw + _i * 8192), 16, 0, 0); } while (0)
#define PG8_LDA(dst, b, h) do { _Pragma("unroll") for (int m = 0; m < 4; ++m) _Pragma("unroll") for (int k = 0; k < 2; ++k) dst[m][k] = *(const PG8_LAS bf16x8*)(lds + PG8_SA(b, h) + aoff + m * 2048 + k * 1024); } while (0)
#define PG8_LDB(dst, b, h) do { _Pragma("unroll") for (int n = 0; n < 2; ++n) _Pragma("unroll") for (int k = 0; k < 2; ++k) dst[n][k] = *(const PG8_LAS bf16x8*)(lds + PG8_SB(b, h) + boff + n * 2048 + k * 1024); } while (0)
#define PG8_MMA(ai, bj, At, Bt) do { __builtin_amdgcn_s_setprio(1); _Pragma("unroll") for (int m = 0; m < 4; ++m) _Pragma("unroll") for (int n = 0; n < 2; ++n) _Pragma("unroll") for (int k = 0; k < 2; ++k) \
        acc[ai][bj][m][n] = __builtin_amdgcn_mfma_f32_16x16x32_bf16(Bt[n][k], At[m][k], acc[ai][bj][m][n], 0, 0, 0); __builtin_amdgcn_s_setprio(0); } while (0)
#define PG8_WAIT_V(n) asm volatile("s_waitcnt vmcnt(" #n ")" ::: "memory")
#define PG8_WAIT_L(n) asm volatile("s_waitcnt lgkmcnt(" #n ")" ::: "memory")
#define PG8_BAR __builtin_amdgcn_s_barrier()
#define PG8_SCHED __builtin_amdgcn_sched_barrier(0)
    Unit cur, nxt; int ui = 0;
    if (!S.next(0, cur)) return;
    f32x4 acc[2][2][4][2];
#pragma unroll
    for (int a = 0; a < 2; ++a)
#pragma unroll
        for (int b = 0; b < 2; ++b)
#pragma unroll
            for (int m = 0; m < 4; ++m)
#pragma unroll
                for (int n = 0; n < 2; ++n) acc[a][b][m][n] = (f32x4){0.f, 0.f, 0.f, 0.f};
    bf16x8 At[4][2], B0[2][2], B1[2][2];
    const char* cA = cur.a; const char* cB = cur.b;
    S.a_ready(cur);
    PG8_STAGE(PG8_SB(0, 0), cB, voffB); PG8_STAGE(PG8_SA(0, 0), cA, voffA); PG8_STAGE(PG8_SB(0, 1), cB + hstepB, voffB); PG8_STAGE(PG8_SA(0, 1), cA + hstepA, voffA);
    if (wr == 1) PG8_BAR;
    PG8_WAIT_V(4); PG8_BAR;
    PG8_STAGE(PG8_SB(1, 0), cB + kstep, voffB); PG8_STAGE(PG8_SA(1, 0), cA + kstep, voffA); PG8_STAGE(PG8_SB(1, 1), cB + hstepB + kstep, voffB);
    PG8_WAIT_V(6); PG8_BAR;
    PG8_STAMP();
    for (;;) {
        const bool has_next = S.next(ui + 1, nxt);
        const char* nA = has_next ? nxt.a : cA; const char* nB = has_next ? nxt.b : cB;
        const int ntc = cur.nt > 0 ? cur.nt : nt;
        for (int t = 0; t < ntc; t += 2) {
            const bool last = (t == ntc - 2);
            const char* a1 = cA + (size_t)(t + 1) * kstep;
            const char* a2 = last ? nA : cA + (size_t)(t + 2) * kstep; const char* b2 = last ? nB : cB + (size_t)(t + 2) * kstep;
            const char* a3 = a2 + kstep; const char* b3 = b2 + kstep;
            if (last && has_next) S.a_ready(nxt);
            PG8_LDB(B0, 0, 0); PG8_SCHED; PG8_LDA(At, 0, 0); PG8_STAGE(PG8_SA(1, 1), a1 + hstepA, voffA);
            PG8_WAIT_L(8); PG8_BAR; PG8_WAIT_L(0); PG8_MMA(0, 0, At, B0); PG8_BAR; PG8_SCHED;
            PG8_LDB(B1, 0, 1); PG8_STAGE(PG8_SB(0, 0), b2, voffB);
            PG8_BAR; PG8_WAIT_L(0); PG8_MMA(0, 1, At, B1); PG8_BAR;
            PG8_LDA(At, 0, 1); PG8_STAGE(PG8_SA(0, 0), a2, voffA);
            PG8_BAR; PG8_WAIT_L(0); PG8_MMA(1, 0, At, B0); PG8_BAR; PG8_SCHED;
            PG8_STAGE(PG8_SB(0, 1), b2 + hstepB, voffB);
            PG8_WAIT_V(6); PG8_BAR; PG8_MMA(1, 1, At, B1); PG8_BAR;
            PG8_LDB(B0, 1, 0); PG8_SCHED; PG8_LDA(At, 1, 0); PG8_STAGE(PG8_SA(0, 1), a2 + hstepA, voffA);
            PG8_WAIT_L(8); PG8_BAR; PG8_WAIT_L(0); PG8_MMA(0, 0, At, B0); PG8_BAR; PG8_SCHED;
            PG8_LDB(B1, 1, 1); PG8_STAGE(PG8_SB(1, 0), b3, voffB);
            PG8_BAR; PG8_WAIT_L(0); PG8_MMA(0, 1, At, B1); PG8_BAR;
            PG8_LDA(At, 1, 1); PG8_STAGE(PG8_SA(1, 0), a3, voffA);
            PG8_BAR; PG8_WAIT_L(0); PG8_MMA(1, 0, At, B0); PG8_BAR; PG8_SCHED;
            PG8_STAGE(PG8_SB(1, 1), b3 + hstepB, voffB);
            PG8_WAIT_V(6); PG8_BAR; PG8_MMA(1, 1, At, B1); PG8_BAR;
        }
        PG8_STAMP();
        if constexpr (!Epi::AFTER_DRAIN) { E(acc, cur, wr, wc, fr, fq); S.done(cur); }
        PG8_STAMP();
        if (!has_next) break;
#pragma unroll
        for (int a = 0; a < 2; ++a)
#pragma unroll
            for (int b = 0; b < 2; ++b)
#pragma unroll
                for (int m = 0; m < 4; ++m)
#pragma unroll
                    for (int n = 0; n < 2; ++n) acc[a][b][m][n] = (f32x4){0.f, 0.f, 0.f, 0.f};
        cur = nxt; cA = nA; cB = nB; ++ui;
    }
    PG8_WAIT_V(0);
    if (wr == 0) PG8_BAR;
    PG8_BAR;
    if constexpr (Epi::AFTER_DRAIN) { E.fused(acc, cur, wr, wc, fr, fq, lds, wid, lane); S.done(cur); }
    PG8_STAMP();
    if (STAMP && wid == 0) { stamps[lane] = lane < nts ? (((unsigned long long)(unsigned)ts_hi << 32) | (unsigned)ts_lo) : 0ull;
        if (lane == 62) stamps[62] = rt_entry; if (lane == 63) stamps[63] = (unsigned long long)wall_clock64(); }
#undef PG8_STAMP
#undef PG8_SA
#undef PG8_SB
#undef PG8_STAGE
#undef PG8_LDA
#undef PG8_LDB
#undef PG8_MMA
#undef PG8_WAIT_V
#undef PG8_WAIT_L
#undef PG8_BAR
#undef PG8_SCHED
}
}

namespace fk {
using pg8::bf16_t; using pg8::f32x4; using pg8::u32x4; using pg8::Unit; using pg8::Gemm; using pg8::cvt_pk_bf16;
typedef unsigned u32x2 __attribute__((ext_vector_type(2)));
typedef float f32x2 __attribute__((ext_vector_type(2)));
typedef unsigned u32x3 __attribute__((ext_vector_type(3)));
typedef unsigned u32x6 __attribute__((ext_vector_type(6)));
typedef float f32x32 __attribute__((ext_vector_type(32)));
constexpr int T = 65536, DM = 1024, SEQ = 8192, NBATCH = 8, NTHR = 512;
constexpr int LDS_BYTES = 147456;

constexpr size_t al256(size_t x) { return (x + 255) / 256 * 256; }
constexpr size_t OFF_BAR = 0, SZ_BAR = 16384;
constexpr size_t OFF_MOD = OFF_BAR + SZ_BAR, SZ_MOD = 8 * 6144 * 4;
constexpr size_t OFF_CS = OFF_MOD + al256(SZ_MOD), SZ_CS = (size_t)T * 16 * 2 * 4;
constexpr size_t OFF_BT1 = OFF_CS + al256(SZ_CS), SZ_BT1 = 1280 * 1024 * 2;
constexpr size_t OFF_BTQ = OFF_BT1 + al256(SZ_BT1), SZ_BTQ = 768 * 384 * 2;
constexpr size_t OFF_BTK = OFF_BTQ + al256(SZ_BTQ), SZ_BTK = 512 * 256 * 2;
constexpr size_t OFF_ATV = OFF_BTK + al256(SZ_BTK), SZ_ATV = 512 * 256 * 2;
constexpr size_t OFF_BTG = OFF_ATV + al256(SZ_ATV), SZ_BTG = 512 * 512 * 2;
constexpr size_t OFF_BTO1 = OFF_BTG + al256(SZ_BTG), SZ_BTO = 1024 * 512 * 2;
constexpr size_t OFF_BTO2 = OFF_BTO1 + al256(SZ_BTO);
constexpr size_t OFF_WST = OFF_BTO2 + al256(SZ_BTO), SZ_WST = (size_t)2048 * 1024 * 2;
constexpr size_t OFF_WT = OFF_WST + al256(SZ_WST), SZ_WT = (size_t)32 * 1024 * 1152 * 2;
constexpr size_t OFF_WSS = OFF_WT + al256(SZ_WT), SZ_WSS = (size_t)64 * 256 * 512 * 2;
constexpr size_t OFF_A64 = OFF_WSS + al256(SZ_WSS), SZ_A64 = 32 * 64 * 2 * 4;
constexpr size_t OFF_TU8 = OFF_A64 + al256(SZ_A64), SZ_T8 = (size_t)16384 * 1024;
constexpr size_t OFF_TV8 = OFF_TU8 + al256(SZ_T8);
constexpr size_t OFF_SCU = OFF_TV8 + al256(SZ_T8), SZ_SC = 16384 * 4;
constexpr size_t OFF_SCV = OFF_SCU + al256(SZ_SC);
constexpr size_t OFF_TU4 = OFF_TV8 + (size_t)16384 * 512;
constexpr size_t OFF_SCU4 = OFF_SCV + al256(SZ_SC);
constexpr size_t OFF_APOW = OFF_SCU4 + al256(SZ_SC), SZ_APOW = (size_t)32 * 65 * 64 * 8;
constexpr size_t OFF_BBCC = OFF_APOW + al256(SZ_APOW), SZ_BBCC = (size_t)32 * 2048 * 8;
constexpr size_t OFF_KTAB = OFF_BBCC + al256(SZ_BBCC), SZ_KTAB = (size_t)32 * 16384 * 4;
constexpr size_t OFF_R1 = OFF_KTAB + al256(SZ_KTAB), SZ_R1 = (size_t)T * 1024 * 2;
constexpr size_t OFF_R2 = OFF_R1 + SZ_R1, SZ_R2 = (size_t)T * 1280;
constexpr size_t OFF_R3 = OFF_R2 + SZ_R2, SZ_R3 = (size_t)32 * 1024 * 1152 * 2;
constexpr size_t OFF_R4 = OFF_R3 + al256(SZ_R3), SZ_R4 = (size_t)T * 8 * 96 * 2;
constexpr size_t OFF_PQ = OFF_R4 + SZ_R4, SZ_PQ = (size_t)T * 12 * 4;
constexpr size_t OFF_PKV = OFF_PQ + SZ_PQ, SZ_PKV = (size_t)T * 8 * 4;
constexpr size_t OFF_PMLA = OFF_PKV + SZ_PKV, SZ_PMLA = (size_t)T * 8 * 4;
constexpr size_t OFF_PS5 = OFF_PMLA + SZ_PMLA, SZ_PS5 = (size_t)T * 16 * 4;
constexpr size_t OFF_R5 = OFF_PS5 + SZ_PS5, SZ_R5 = (size_t)T * 512 * 2;
constexpr size_t OFF_R6 = OFF_R5 + SZ_R5, SZ_R6 = (size_t)T * 1024 * 2;
constexpr size_t WS_FAST_END = OFF_R6 + SZ_R6;
constexpr size_t OFF_RQ = WS_FAST_END, OFF_RK = OFF_RQ + (size_t)T * 4;
constexpr size_t OFF_H1 = OFF_R1;
constexpr size_t OFF_CQ = OFF_R2, OFF_CKV = OFF_R2 + (size_t)T * 384 * 2;
constexpr size_t OFF_UG = OFF_R3, OFF_KIMG = OFF_R4, OFF_VIMG = OFF_R5;

struct P {
    const float *x, *c; const int* pos; const float *w_ada, *b_ada, *w_in, *lam_re, *lam_im, *log_dt, *b_re, *b_im, *c_re, *c_im, *s5_d, *w_glu, *b_glu, *q_norm, *w_uq, *kv_norm, *w_ukv,
        *gn_s5, *gn_mla, *w_out, *ln1_g, *ln1_b, *w_query, *keys1, *keys2, *pu, *pv, *ln2_g, *ln2_b;
    float* out; char* ws;
};
__device__ __forceinline__ int otid() { int t = wgt_tid(); asm volatile("" : "+v"(t)); return t; }
__device__ __forceinline__ float bf2f(bf16_t v) { return __uint_as_float(((unsigned)v) << 16); }
__device__ __forceinline__ u32x4 pack8(const f32x4 a, const f32x4 b) { u32x4 w; w.x = cvt_pk_bf16(a[0], a[1]); w.y = cvt_pk_bf16(a[2], a[3]); w.z = cvt_pk_bf16(b[0], b[1]); w.w = cvt_pk_bf16(b[2], b[3]); return w; }

template <class PT> struct OrderT {
    int nM, nN, nwg, G, c; PT pt;
    __device__ void init(int nM_, int nN_, int G_, int c_, const PT& pt_) { nM = nM_; nN = nN_; nwg = nM * nN; G = G_; c = c_; pt = pt_; }
    __device__ bool next(int i, Unit& u) const {
        const long L = (long)i * G + c; if (L >= nwg) return false;
        int wgid = (int)L; { const int q = nwg / pg8::NXCD, r = nwg % pg8::NXCD, xcd = wgid % pg8::NXCD, off = wgid / pg8::NXCD; wgid = (xcd < r ? xcd * (q + 1) : r * (q + 1) + (xcd - r) * q) + off; }
        const int nig = pg8::WGM * nN, gid = wgid / nig, fm = gid * pg8::WGM, gsz = (nM - fm) < pg8::WGM ? (nM - fm) : pg8::WGM;
        u.nt = 0; pt.fill(u, fm + ((wgid % nig) % gsz), (wgid % nig) / gsz); return true;
    }
    __device__ __forceinline__ void a_ready(const Unit&) const {}
    __device__ __forceinline__ void done(const Unit&) const {}
};

__device__ __forceinline__ void phase_p0a(const P& p, char* lds) {
    const int tid = otid(); const size_t gtid = (size_t)blockIdx.x * NTHR + tid, gstr = (size_t)gridDim.x * NTHR;
    float* mod = (float*)(p.ws + OFF_MOD);
    {
        float* sl = (float*)lds; float* red = sl + 8192;
        for (int i = tid; i < 8192; i += NTHR) { const float cv = p.c[i]; sl[i] = cv / (1.0f + expf(-cv)); }
        __syncthreads();
        for (int cb = blockIdx.x; cb < 256; cb += gridDim.x) {
            if (tid < 504) { const int ks = tid / 24, col = tid % 24, n = cb * 24 + col;
                float a0 = 0.f, a1 = 0.f, a2 = 0.f, a3 = 0.f, a4 = 0.f, a5 = 0.f, a6 = 0.f, a7 = 0.f;
                for (int k = ks; k < 1024; k += 21) { const float w = p.w_ada[(size_t)k * 6144 + n];
                    a0 += sl[k] * w; a1 += sl[1024 + k] * w; a2 += sl[2048 + k] * w; a3 += sl[3072 + k] * w; a4 += sl[4096 + k] * w; a5 += sl[5120 + k] * w; a6 += sl[6144 + k] * w; a7 += sl[7168 + k] * w; }
                float* r = red + ks * 24 + col; r[0] = a0; r[504] = a1; r[1008] = a2; r[1512] = a3; r[2016] = a4; r[2520] = a5; r[3024] = a6; r[3528] = a7; }
            __syncthreads();
            if (tid < 192) { const int b = tid / 24, col = tid % 24, n = cb * 24 + col; float s = p.b_ada[n];
                for (int ks = 0; ks < 21; ++ks) s += red[b * 504 + ks * 24 + col];
                mod[b * 6144 + n] = s; }
            __syncthreads();
        }
    }
    {
        float* cs = (float*)(p.ws + OFF_CS);
        for (size_t idx = gtid; idx < (size_t)T * 16; idx += gstr) { const int t = (int)(idx >> 4), i = (int)(idx & 15);
            const double ang = (double)p.pos[t] * exp(-9.210340371976184 * (double)i / 16.0);
            cs[idx * 2] = (float)cos(ang); cs[idx * 2 + 1] = (float)sin(ang); }
    }
    {
        bf16_t* bt = (bf16_t*)(p.ws + OFF_BT1);
        for (size_t idx = gtid; idx < (size_t)1280 * 1024 / 2; idx += gstr) { const int n = (int)(idx >> 9), k = (int)(idx & 511) * 2;
            const float v0 = n < 1184 ? p.w_in[(size_t)k * 1184 + n] : 0.f, v1 = n < 1184 ? p.w_in[(size_t)(k + 1) * 1184 + n] : 0.f;
            ((unsigned*)bt)[idx] = cvt_pk_bf16(v0, v1); }
    }
    {
        unsigned* btq = (unsigned*)(p.ws + OFF_BTQ); unsigned* btk = (unsigned*)(p.ws + OFF_BTK); unsigned* atv = (unsigned*)(p.ws + OFF_ATV);
        for (size_t idx = gtid; idx < (size_t)768 * 384 / 2; idx += gstr) { const int n = (int)(idx / 192), k = (int)(idx % 192) * 2;
            btq[idx] = cvt_pk_bf16(p.q_norm[k] * p.w_uq[(size_t)k * 768 + n], p.q_norm[k + 1] * p.w_uq[(size_t)(k + 1) * 768 + n]); }
        for (size_t idx = gtid; idx < (size_t)512 * 256 / 2; idx += gstr) { const int n = (int)(idx >> 7), k = (int)(idx & 127) * 2, col = (n >> 6) * 128 + (n & 63);
            btk[idx] = cvt_pk_bf16(p.kv_norm[k] * p.w_ukv[(size_t)k * 1024 + col], p.kv_norm[k + 1] * p.w_ukv[(size_t)(k + 1) * 1024 + col]);
            atv[idx] = cvt_pk_bf16(p.kv_norm[k] * p.w_ukv[(size_t)k * 1024 + col + 64], p.kv_norm[k + 1] * p.w_ukv[(size_t)(k + 1) * 1024 + col + 64]); }
    }
}

__device__ __forceinline__ void phase_p0c(const P& p, char* lds) {
    const int tid = otid(); const size_t gtid = (size_t)blockIdx.x * NTHR + tid, gstr = (size_t)gridDim.x * NTHR;
    {   unsigned* btg = (unsigned*)(p.ws + OFF_BTG);
        for (size_t idx = gtid; idx < (size_t)512 * 512 / 2; idx += gstr) { const int n = (int)(idx >> 8), k = (int)(idx & 255) * 2;
            btg[idx] = cvt_pk_bf16(p.w_glu[(size_t)k * 512 + n], p.w_glu[(size_t)(k + 1) * 512 + n]); } }
    typedef float f32x2 __attribute__((ext_vector_type(2)));
    f32x2* Apl = (f32x2*)lds;
    f32x2* BB = Apl + 9 * 64;
    f32x2* CC = BB + 64 * 16;
    for (int wi = blockIdx.x; wi < 256; wi += gridDim.x) {
        const int g = wi & 31, slice = wi >> 5;
        __syncthreads();
        const double dt = exp((double)p.log_dt[g]);
        for (int idx = tid; idx < 9 * 64; idx += NTHR) { const int kl = idx >> 6, pp = idx & 63, k = (kl < 8) ? slice * 8 + kl : 64; const double lr = p.lam_re[g * 64 + pp], li = p.lam_im[g * 64 + pp];
            const double mag = exp((double)k * lr * dt), ang = (double)k * li * dt; const f32x2 v = (f32x2){(float)(mag * cos(ang)), (float)(mag * sin(ang))};
            Apl[idx] = v; if (kl < 8 || slice == 7) ((f32x2*)(p.ws + OFF_APOW))[((size_t)g * 65 + k) * 64 + pp] = v; }
        for (int idx = tid; idx < 1024; idx += NTHR) { const int pp = idx >> 4, h = idx & 15; const double lr = p.lam_re[g * 64 + pp], li = p.lam_im[g * 64 + pp];
            const double mag = exp(lr * dt), abr = mag * cos(li * dt), abi = mag * sin(li * dt), den = lr * lr + li * li, nr = abr - 1.0;
            const double cr = (nr * lr + abi * li) / den, ci = (abi * lr - nr * li) / den, br = p.b_re[(g * 64 + pp) * 16 + h], bi = p.b_im[(g * 64 + pp) * 16 + h];
            const f32x2 bv = (f32x2){(float)(cr * br - ci * bi), (float)(cr * bi + ci * br)}; BB[idx] = bv;
            const int hh = idx >> 6, p2 = idx & 63; const f32x2 cv = (f32x2){p.c_re[(g * 16 + hh) * 64 + p2], p.c_im[(g * 16 + hh) * 64 + p2]}; CC[idx] = cv;
            if (slice == 0) { ((f32x2*)(p.ws + OFF_BBCC))[(size_t)g * 2048 + idx] = bv; ((f32x2*)(p.ws + OFF_BBCC))[(size_t)g * 2048 + 1024 + idx] = cv; } }
        __syncthreads();
        for (int e = tid; e < 8 * 256; e += NTHR) { const int kl = e >> 8, h = (e >> 4) & 15, h2 = e & 15, k = slice * 8 + kl; float acc = 0.f;
            for (int pp = 0; pp < 64; ++pp) { const f32x2 c = CC[h * 64 + pp], a = Apl[kl * 64 + pp], b = BB[pp * 16 + h2];
                const float xr = c.x * a.x - c.y * a.y, xi = c.x * a.y + c.y * a.x; acc += xr * b.x - xi * b.y; }
            if (k == 0 && h == h2) acc += p.s5_d[g * 16 + h];
            ((float*)(p.ws + OFF_KTAB))[(size_t)g * 16384 + k * 256 + (e & 255)] = acc; }
    }
}
__device__ __forceinline__ void phase_p0e(const P& p, char* lds) {
    const int tid = otid();
    typedef float f32x2 __attribute__((ext_vector_type(2)));
    f32x2* Apow = (f32x2*)lds;
    f32x2* BB = Apow + 65 * 64;
    f32x2* CC = BB + 64 * 16;
    float* Ktab = (float*)(CC + 16 * 64);
    for (int wi = blockIdx.x; wi < 256; wi += gridDim.x) {
        const int g = wi & 31, slice = wi >> 5;
        __syncthreads();
        for (int idx = tid; idx < 65 * 64; idx += NTHR) Apow[idx] = ((const f32x2*)(p.ws + OFF_APOW))[(size_t)g * 65 * 64 + idx];
        for (int idx = tid; idx < 2048; idx += NTHR) BB[idx] = ((const f32x2*)(p.ws + OFF_BBCC))[(size_t)g * 2048 + idx];
        for (int idx = tid; idx < 16384 / 4; idx += NTHR) ((f32x4*)Ktab)[idx] = ((const f32x4*)(p.ws + OFF_KTAB))[(size_t)g * 4096 + idx];
        __syncthreads();
        unsigned* wt = (unsigned*)(p.ws + OFF_WT) + ((size_t)g * 1024 + slice * 128) * 576;
        for (int e = tid; e < 128 * 576; e += NTHR) { const int nl = e / 576, k = (e - nl * 576) * 2, n = slice * 128 + nl, i = n >> 4, h = n & 15; float v0, v1;
            if (k < 1024) { const int j = k >> 4, h2 = k & 15; v0 = (j <= i) ? Ktab[((i - j) * 16 + h) * 16 + h2] : 0.f; v1 = (j <= i) ? Ktab[((i - j) * 16 + h) * 16 + h2 + 1] : 0.f; }
            else { const int q = k - 1024, pp = q & 63; const f32x2 c0 = CC[h * 64 + pp], a0 = Apow[(i + 1) * 64 + pp], c1 = CC[h * 64 + pp + 1], a1 = Apow[(i + 1) * 64 + pp + 1];
                if (q < 64) { v0 = c0.x * a0.x - c0.y * a0.y; v1 = c1.x * a1.x - c1.y * a1.y; } else { v0 = -(c0.x * a0.y + c0.y * a0.x); v1 = -(c1.x * a1.y + c1.y * a1.x); } }
            wt[e] = cvt_pk_bf16(v0, v1); }
        for (int e = tid; e < 2 * 32 * 256; e += NTHR) { const int kh = e >> 13, rl = (e >> 8) & 31, kk = (e & 255) * 2, row = slice * 32 + rl; float v0 = 0.f, v1 = 0.f;
            if (row < 128) { const int pp = row & 63, j = kh * 32 + (kk >> 4), h2 = kk & 15; const f32x2 a = Apow[(63 - j) * 64 + pp], b0 = BB[pp * 16 + h2], b1 = BB[pp * 16 + h2 + 1];
                if (row < 64) { v0 = a.x * b0.x - a.y * b0.y; v1 = a.x * b1.x - a.y * b1.y; } else { v0 = a.x * b0.y + a.y * b0.x; v1 = a.x * b1.y + a.y * b1.x; } }
            ((unsigned*)(p.ws + OFF_WSS))[(((size_t)(g * 2 + kh) * 256 + row) * 512 + kk) >> 1] = cvt_pk_bf16(v0, v1); }
        if (slice == 0 && tid < 64) ((f32x2*)(p.ws + OFF_A64))[g * 64 + tid] = Apow[64 * 64 + tid];
    }
}
__device__ __forceinline__ void phase_p0d(const P& p, char* lds) {
    const int tid = otid(), lane = tid & 63; const size_t gtid = (size_t)blockIdx.x * NTHR + tid, gstr = (size_t)gridDim.x * NTHR;
    {   unsigned* b1 = (unsigned*)(p.ws + OFF_BTO1); unsigned* b2 = (unsigned*)(p.ws + OFF_BTO2);
        for (size_t idx = gtid; idx < (size_t)1024 * 512 / 2; idx += gstr) { const int n = (int)(idx >> 8), k = (int)(idx & 255) * 2;
            b1[idx] = cvt_pk_bf16(p.gn_s5[k] * p.w_out[(size_t)k * 1024 + n], p.gn_s5[k + 1] * p.w_out[(size_t)(k + 1) * 1024 + n]);
            b2[idx] = cvt_pk_bf16(p.gn_mla[k] * p.w_out[(size_t)(512 + k) * 1024 + n], p.gn_mla[k + 1] * p.w_out[(size_t)(513 + k) * 1024 + n]); } }
    {
        float* Kt = (float*)lds; float* Wq = Kt + 64 * 129;
        for (int tile = blockIdx.x; tile < 32 * 16; tile += gridDim.x) { const int nb = tile >> 4, kb = tile & 15, n0 = nb * 64, k0 = kb * 64, hh = n0 >> 8, half = (n0 >> 7) & 1, key0 = n0 & 127;
            const float* keys = (half ? p.keys2 : p.keys1) + ((size_t)hh * 128 + key0) * 128;
            __syncthreads();
            for (int e = tid; e < 64 * 128; e += NTHR) { const int r = e >> 7, d = e & 127; Kt[r * 129 + d] = keys[(size_t)r * 128 + d]; Wq[e] = p.w_query[(size_t)(k0 + r) * 2048 + hh * 256 + half * 128 + d]; }
            __syncthreads();
            const int tn = tid & 63, tk = (tid >> 6) * 8; float acc[8];
#pragma unroll
            for (int i = 0; i < 8; ++i) acc[i] = 0.f;
            for (int d = 0; d < 128; ++d) { const float kv = Kt[tn * 129 + d];
#pragma unroll
                for (int i = 0; i < 8; ++i) acc[i] += kv * Wq[(tk + i) * 128 + d]; }
            u32x4 w; w.x = cvt_pk_bf16(acc[0], acc[1]); w.y = cvt_pk_bf16(acc[2], acc[3]); w.z = cvt_pk_bf16(acc[4], acc[5]); w.w = cvt_pk_bf16(acc[6], acc[7]);
            *(u32x4*)((bf16_t*)(p.ws + OFF_WST) + (size_t)(n0 + tn) * 1024 + k0 + tk) = w; }
    }
    {
        const int wv = (int)(gtid >> 6), nwv = (int)(gstr >> 6);
        for (int r = wv; r < 2 * 16384; r += nwv) { const int which = r >> 14, e = r & 16383; const float* src = (which ? p.pv : p.pu) + (size_t)e * 1024 + lane * 16;
            f32x4 v[4]; float am = 0.f;
#pragma unroll
            for (int i = 0; i < 4; ++i) { v[i] = *(const f32x4*)(src + 4 * i); am = fmaxf(am, fmaxf(fmaxf(fabsf(v[i][0]), fabsf(v[i][1])), fmaxf(fabsf(v[i][2]), fabsf(v[i][3])))); }
#pragma unroll
            for (int o = 32; o > 0; o >>= 1) am = fmaxf(am, __shfl_xor(am, o));
            if (which == 0) {
            const float sc = am > 0.f ? 7.5f / am : 1.0f; unsigned c[16];
#pragma unroll
            for (int i = 0; i < 16; ++i) { const float x = v[i >> 2][i & 3] * sc, ax = fabsf(x);
                float cf = ax < 1.0f ? rintf(ax * 8.0f) : ax < 2.0f ? 8.0f + rintf((ax - 1.0f) * 8.0f) : ax < 4.0f ? 16.0f + rintf((ax - 2.0f) * 4.0f) : 24.0f + rintf((ax - 4.0f) * 2.0f);
                cf = fminf(cf, 31.0f); c[i] = (unsigned)cf | (x < 0.f ? 32u : 0u); }
            u32x3 w;
            w.x = c[0] | (c[1] << 6) | (c[2] << 12) | (c[3] << 18) | (c[4] << 24) | ((c[5] & 3u) << 30);
            w.y = (c[5] >> 2) | (c[6] << 4) | (c[7] << 10) | (c[8] << 16) | (c[9] << 22) | ((c[10] & 15u) << 28);
            w.z = (c[10] >> 4) | (c[11] << 2) | (c[12] << 8) | (c[13] << 14) | (c[14] << 20) | (c[15] << 26);
            *(u32x3*)(p.ws + OFF_TU8 + (size_t)e * 768 + lane * 12) = w;
            if (lane == 0) ((float*)(p.ws + OFF_SCU))[e] = am > 0.f ? am / 7.5f : 1.0f;
            {
                const float sc4 = am > 0.f ? 6.0f / am : 1.0f; unsigned lo = 0u, hi = 0u;
#pragma unroll
                for (int i = 0; i < 16; ++i) { const float x = v[i >> 2][i & 3] * sc4, ax = fabsf(x);
                    const unsigned c4 = (unsigned)(ax > 0.25f) + (unsigned)(ax > 0.75f) + (unsigned)(ax > 1.25f) + (unsigned)(ax > 1.75f) + (unsigned)(ax > 2.5f) + (unsigned)(ax > 3.5f) + (unsigned)(ax > 5.0f);
                    const unsigned cd = c4 | (x < 0.f ? 8u : 0u);
                    if (i < 8) lo |= cd << (4 * i); else hi |= cd << (4 * (i - 8)); }
                u32x2 w4; w4.x = lo; w4.y = hi;
                *(u32x2*)(p.ws + OFF_TU4 + (size_t)e * 512 + lane * 8) = w4;
                if (lane == 0) ((float*)(p.ws + OFF_SCU4))[e] = am > 0.f ? am / 6.0f : 1.0f; }
            } else {
            const float sc = am > 0.f ? 6.0f / am : 1.0f; unsigned lo = 0u, hi = 0u;
#pragma unroll
            for (int i = 0; i < 16; ++i) { const float x = v[i >> 2][i & 3] * sc, ax = fabsf(x);
                const unsigned c = (unsigned)(ax > 0.25f) + (unsigned)(ax > 0.75f) + (unsigned)(ax > 1.25f) + (unsigned)(ax > 1.75f) + (unsigned)(ax > 2.5f) + (unsigned)(ax > 3.5f) + (unsigned)(ax > 5.0f);
                const unsigned cd = c | (x < 0.f ? 8u : 0u);
                if (i < 8) lo |= cd << (4 * i); else hi |= cd << (4 * (i - 8)); }
            u32x2 w; w.x = lo; w.y = hi;
            *(u32x2*)(p.ws + OFF_TV8 + (size_t)e * 512 + lane * 8) = w;
            if (lane == 0) ((float*)(p.ws + OFF_SCV))[e] = am > 0.f ? am / 6.0f : 1.0f;
            }
            }
    }
}
__device__ __forceinline__ void phase_p0b(const P& p, char* lds) {
    const size_t gtid = (size_t)blockIdx.x * NTHR + otid(), gstr = (size_t)gridDim.x * NTHR;
    const float* mod = (const float*)(p.ws + OFF_MOD); bf16_t* h1 = (bf16_t*)(p.ws + OFF_H1);
    for (size_t i8 = gtid; i8 < (size_t)T * DM / 8; i8 += gstr) { const size_t e = i8 * 8; const int t = (int)(e >> 10), d = (int)(e & 1023), b = t >> 13;
        const f32x4 x0 = *(const f32x4*)(p.x + e), x1 = *(const f32x4*)(p.x + e + 4);
        const float* mb = mod + b * 6144;
        const f32x4 sh0 = *(const f32x4*)(mb + d), sh1 = *(const f32x4*)(mb + d + 4), sc0 = *(const f32x4*)(mb + 1024 + d), sc1 = *(const f32x4*)(mb + 1024 + d + 4);
        *(u32x4*)(h1 + e) = pack8(x0 * (sc0 + 1.0f) + sh0, x1 * (sc1 + 1.0f) + sh1); }
}

__device__ __forceinline__ void phase_g1(const P& p, char* lds) {
    const int tid = otid(); const size_t gtid = (size_t)blockIdx.x * NTHR + tid, gstr = (size_t)gridDim.x * NTHR;
    float* mod = (float*)(p.ws + OFF_MOD);
    {
        float* sl = (float*)lds; float* red = sl + 8192;
        for (int i = tid; i < 8192; i += NTHR) { const float cv = p.c[i]; sl[i] = cv / (1.0f + expf(-cv)); }
        __syncthreads();
        for (int cb = blockIdx.x; cb < 256; cb += gridDim.x) {
            if (tid < 510) { const int ks = tid / 6, c4 = tid - ks * 6; const float* wp = p.w_ada + (size_t)ks * 6144 + cb * 24 + c4 * 4;
                f32x4 w[13];
#pragma unroll
                for (int i = 0; i < 13; ++i) w[i] = (i < 12 || ks < 4) ? *(const f32x4*)(wp + (size_t)i * 85 * 6144) : (f32x4){0.f, 0.f, 0.f, 0.f};
                f32x4 a[8];
#pragma unroll
                for (int b = 0; b < 8; ++b) a[b] = (f32x4){0.f, 0.f, 0.f, 0.f};
#pragma unroll
                for (int i = 0; i < 13; ++i) { const int k = min(ks + 85 * i, 1023);
#pragma unroll
                    for (int b = 0; b < 8; ++b) a[b] += w[i] * sl[b * 1024 + k]; }
#pragma unroll
                for (int b = 0; b < 8; ++b) *(f32x4*)(red + (ks * 8 + b) * 24 + c4 * 4) = a[b]; }
            __syncthreads();
            if (tid < 192) { const int b = tid / 24, col = tid % 24, n = cb * 24 + col; float s = p.b_ada[n];
#pragma unroll 5
                for (int ks = 0; ks < 85; ++ks) s += red[(ks * 8 + b) * 24 + col];
                mod[b * 6144 + n] = s; }
            __syncthreads();
        }
    }
    {
        typedef float f32x2 __attribute__((ext_vector_type(2)));
        f32x2* cs = (f32x2*)(p.ws + OFF_CS);
        const double invf = exp(-9.210340371976184 * (double)(int)(gtid & 15) / 16.0);
        for (size_t idx = gtid; idx < (size_t)T * 16; idx += gstr) { const int t = (int)(idx >> 4);
            const double ang = (double)p.pos[t] * invf; const float r = (float)(ang - 6.283185307179586 * rint(ang * 0.15915494309189535));
            cs[idx] = (f32x2){cosf(r), sinf(r)}; }
    }
    __syncthreads();
    typedef float f32x2 __attribute__((ext_vector_type(2)));
    f32x2* Apl = (f32x2*)lds;
    f32x2* BB = Apl + 9 * 64;
    f32x2* CC = BB + 64 * 16;
    for (int wi = blockIdx.x; wi < 256; wi += gridDim.x) {
        const int g = wi & 31, slice = wi >> 5;
        __syncthreads();
        const double dt = exp((double)p.log_dt[g]);
        for (int idx = tid; idx < 9 * 64; idx += NTHR) { const int kl = idx >> 6, pp = idx & 63, k = (kl < 8) ? slice * 8 + kl : 64; const double lr = p.lam_re[g * 64 + pp], li = p.lam_im[g * 64 + pp];
            const double mag = exp((double)k * lr * dt), ang = (double)k * li * dt; const f32x2 v = (f32x2){(float)(mag * cos(ang)), (float)(mag * sin(ang))};
            Apl[idx] = v; if (kl < 8 || slice == 7) ((f32x2*)(p.ws + OFF_APOW))[((size_t)g * 65 + k) * 64 + pp] = v; }
        for (int idx = tid; idx < 1024; idx += NTHR) { const int pp = idx >> 4, h = idx & 15; const double lr = p.lam_re[g * 64 + pp], li = p.lam_im[g * 64 + pp];
            const double mag = exp(lr * dt), abr = mag * cos(li * dt), abi = mag * sin(li * dt), den = lr * lr + li * li, nr = abr - 1.0;
            const double cr = (nr * lr + abi * li) / den, ci = (abi * lr - nr * li) / den, br = p.b_re[(g * 64 + pp) * 16 + h], bi = p.b_im[(g * 64 + pp) * 16 + h];
            const f32x2 bv = (f32x2){(float)(cr * br - ci * bi), (float)(cr * bi + ci * br)}; BB[idx] = bv;
            const int hh = idx >> 6, p2 = idx & 63; const f32x2 cv = (f32x2){p.c_re[(g * 16 + hh) * 64 + p2], p.c_im[(g * 16 + hh) * 64 + p2]}; CC[idx] = cv;
            if (slice == 0) { ((f32x2*)(p.ws + OFF_BBCC))[(size_t)g * 2048 + idx] = bv; ((f32x2*)(p.ws + OFF_BBCC))[(size_t)g * 2048 + 1024 + idx] = cv; } }
        __syncthreads();
        for (int e = tid; e < 8 * 256; e += NTHR) { const int kl = e >> 8, h = (e >> 4) & 15, h2 = e & 15, k = slice * 8 + kl; float acc = 0.f;
            for (int pp = 0; pp < 64; ++pp) { const f32x2 c = CC[h * 64 + pp], a = Apl[kl * 64 + pp], b = BB[pp * 16 + h2];
                const float xr = c.x * a.x - c.y * a.y, xi = c.x * a.y + c.y * a.x; acc += xr * b.x - xi * b.y; }
            if (k == 0 && h == h2) acc += p.s5_d[g * 16 + h];
            ((float*)(p.ws + OFF_KTAB))[(size_t)g * 16384 + k * 256 + (e & 255)] = acc; }
    }
}
__device__ __forceinline__ void phase_g2(const P& p, char* lds) {
    const int tid = otid(), lane = tid & 63; const size_t gtid = (size_t)blockIdx.x * NTHR + tid, gstr = (size_t)gridDim.x * NTHR;
    const bool rev = (blockIdx.x >> 3) & 1;
#pragma unroll 1
    for (int step = 0; step < 5; ++step) {
        const int task = rev ? 4 - step : step;
        if (task == 0) {


    const float* mod = (const float*)(p.ws + OFF_MOD); bf16_t* h1 = (bf16_t*)(p.ws + OFF_H1);
    if (gstr == (size_t)131072) {
        const size_t e0 = gtid * 8; const int d = (int)(e0 & 1023);
#pragma unroll 1
        for (int b = 0; b < 8; ++b) { const float* mb = mod + b * 6144;
            const f32x4 sh0 = *(const f32x4*)(mb + d), sh1 = *(const f32x4*)(mb + d + 4), sc0 = *(const f32x4*)(mb + 1024 + d) + 1.0f, sc1 = *(const f32x4*)(mb + 1024 + d + 4) + 1.0f;
#pragma unroll
            for (int k = 0; k < 8; ++k) { const size_t e = e0 + ((size_t)(b * 8 + k) << 20);
                const f32x4 x0 = *(const f32x4*)(p.x + e), x1 = *(const f32x4*)(p.x + e + 4);
                *(u32x4*)(h1 + e) = pack8(x0 * sc0 + sh0, x1 * sc1 + sh1); } }
    } else {
#pragma unroll 4
    for (size_t i8 = gtid; i8 < (size_t)T * DM / 8; i8 += gstr) { const size_t e = i8 * 8; const int t = (int)(e >> 10), d = (int)(e & 1023), b = t >> 13;
        const f32x4 x0 = *(const f32x4*)(p.x + e), x1 = *(const f32x4*)(p.x + e + 4);
        const float* mb = mod + b * 6144;
        const f32x4 sh0 = *(const f32x4*)(mb + d), sh1 = *(const f32x4*)(mb + d + 4), sc0 = *(const f32x4*)(mb + 1024 + d), sc1 = *(const f32x4*)(mb + 1024 + d + 4);
        *(u32x4*)(h1 + e) = pack8(x0 * (sc0 + 1.0f) + sh0, x1 * (sc1 + 1.0f) + sh1); }
    }
        } else if (task == 1) {
    {
        const int wv = (int)(gtid >> 6), nwv = (int)(gstr >> 6);
#pragma unroll 2
        for (int r = wv; r < 2 * 16384; r += nwv) { const int which = r >> 14, e = r & 16383; const float* src = (which ? p.pv : p.pu) + (size_t)e * 1024 + lane * 16;
            f32x4 v[4]; float am = 0.f;
#pragma unroll
            for (int i = 0; i < 4; ++i) { v[i] = *(const f32x4*)(src + 4 * i); am = fmaxf(am, fmaxf(fmaxf(fabsf(v[i][0]), fabsf(v[i][1])), fmaxf(fabsf(v[i][2]), fabsf(v[i][3])))); }
#pragma unroll
            for (int o = 32; o > 0; o >>= 1) am = fmaxf(am, __shfl_xor(am, o));
            if (which == 0) {
                const float sc4 = am > 0.f ? 6.0f / am : 1.0f; unsigned lo = 0u, hi = 0u;
#define FK_E4(W, I, B4) W = __builtin_amdgcn_cvt_scalef32_pk_fp4_f32(W, v[(I) >> 2][(I) & 3] * sc4, v[((I) + 1) >> 2][((I) + 1) & 3] * sc4, 1.0f, B4);
                FK_E4(lo, 0, 0) FK_E4(lo, 2, 1) FK_E4(lo, 4, 2) FK_E4(lo, 6, 3) FK_E4(hi, 8, 0) FK_E4(hi, 10, 1) FK_E4(hi, 12, 2) FK_E4(hi, 14, 3)
#undef FK_E4
                u32x2 w4; w4.x = lo; w4.y = hi;
                *(u32x2*)(p.ws + OFF_TU4 + (size_t)e * 512 + lane * 8) = w4;
                if (lane == 0) ((float*)(p.ws + OFF_SCU4))[e] = am > 0.f ? am / 6.0f : 1.0f;
            } else {
            const float sc = am > 0.f ? 6.0f / am : 1.0f; unsigned lo = 0u, hi = 0u;
#define FK_E4(W, I, B4) W = __builtin_amdgcn_cvt_scalef32_pk_fp4_f32(W, v[(I) >> 2][(I) & 3] * sc, v[((I) + 1) >> 2][((I) + 1) & 3] * sc, 1.0f, B4);
            FK_E4(lo, 0, 0) FK_E4(lo, 2, 1) FK_E4(lo, 4, 2) FK_E4(lo, 6, 3) FK_E4(hi, 8, 0) FK_E4(hi, 10, 1) FK_E4(hi, 12, 2) FK_E4(hi, 14, 3)
#undef FK_E4
            u32x2 w; w.x = lo; w.y = hi;
            *(u32x2*)(p.ws + OFF_TV8 + (size_t)e * 512 + lane * 8) = w;
            if (lane == 0) ((float*)(p.ws + OFF_SCV))[e] = am > 0.f ? am / 6.0f : 1.0f;
            }
            }
    }
        } else if (task == 2) {
    {
        float* tl = (float*)lds;
        for (int tile = blockIdx.x; tile < 776; tile += gridDim.x) {
            const float* W; const float* sc; bf16_t* Bt; int ldw, ldb, kT, krow0 = 0, coladd = 0, colmul = 64, nreal = 1 << 30, tt = tile;
            if (tt < 320) { W = p.w_in; sc = nullptr; Bt = (bf16_t*)(p.ws + OFF_BT1); ldw = 1184; ldb = 1024; kT = 16; nreal = 1184; }
            else if ((tt -= 320) < 72) { W = p.w_uq; sc = p.q_norm; Bt = (bf16_t*)(p.ws + OFF_BTQ); ldw = 768; ldb = 384; kT = 6; }
            else if ((tt -= 72) < 32) { W = p.w_ukv; sc = p.kv_norm; Bt = (bf16_t*)(p.ws + OFF_BTK); ldw = 1024; ldb = 256; kT = 4; colmul = 128; }
            else if ((tt -= 32) < 32) { W = p.w_ukv; sc = p.kv_norm; Bt = (bf16_t*)(p.ws + OFF_ATV); ldw = 1024; ldb = 256; kT = 4; colmul = 128; coladd = 64; }
            else if ((tt -= 32) < 64) { W = p.w_glu; sc = nullptr; Bt = (bf16_t*)(p.ws + OFF_BTG); ldw = 512; ldb = 512; kT = 8; }
            else if ((tt -= 64) < 128) { W = p.w_out; sc = p.gn_s5; Bt = (bf16_t*)(p.ws + OFF_BTO1); ldw = 1024; ldb = 512; kT = 8; }
            else { tt -= 128; W = p.w_out; sc = p.gn_mla; Bt = (bf16_t*)(p.ws + OFF_BTO2); ldw = 1024; ldb = 512; kT = 8; krow0 = 512; }
            const int nt_ = tt / kT, k0 = (tt - nt_ * kT) * 64, n0 = nt_ * 64, col0 = nt_ * colmul + coladd, nval = nreal - n0;
            __syncthreads();
            {   const int r = tid >> 3, c8 = (tid & 7) * 8; const float g = sc ? sc[k0 + r] : 1.0f; const float* src = W + (size_t)(krow0 + k0 + r) * ldw + col0 + c8;
                const f32x4 z4 = {0.f, 0.f, 0.f, 0.f}; const f32x4 v0 = (c8 < nval) ? *(const f32x4*)src : z4, v1 = (c8 + 4 < nval) ? *(const f32x4*)(src + 4) : z4;
#pragma unroll
                for (int i = 0; i < 4; ++i) { tl[r * 65 + c8 + i] = v0[i] * g; tl[r * 65 + c8 + 4 + i] = v1[i] * g; } }
            __syncthreads();
            {   const int n = tid >> 3, kq = (tid & 7) * 8; f32x4 o0, o1;
#pragma unroll
                for (int i = 0; i < 4; ++i) { o0[i] = tl[(kq + i) * 65 + n]; o1[i] = tl[(kq + 4 + i) * 65 + n]; }
                *(u32x4*)(Bt + (size_t)(n0 + n) * ldb + k0 + kq) = pack8(o0, o1); }
        }
    }
        } else if (task == 3) {
    {
        float* Kt = (float*)lds; float* Wq = Kt + 64 * 129;
        for (int tile = blockIdx.x; tile < 32 * 16; tile += gridDim.x) { const int nb = tile >> 4, kb = tile & 15, n0 = nb * 64, k0 = kb * 64, hh = n0 >> 8, half = (n0 >> 7) & 1, key0 = n0 & 127;
            const float* keys = (half ? p.keys2 : p.keys1) + ((size_t)hh * 128 + key0) * 128;
            __syncthreads();
            for (int e = tid; e < 64 * 128; e += NTHR) { const int r = e >> 7, d = e & 127; Kt[r * 129 + d] = keys[(size_t)r * 128 + d]; Wq[e] = p.w_query[(size_t)(k0 + r) * 2048 + hh * 256 + half * 128 + d]; }
            __syncthreads();
            const int tn = tid & 63, tk = (tid >> 6) * 8; float acc[8];
#pragma unroll
            for (int i = 0; i < 8; ++i) acc[i] = 0.f;
            for (int d = 0; d < 128; d += 4) { const float k0 = Kt[tn * 129 + d], k1 = Kt[tn * 129 + d + 1], k2 = Kt[tn * 129 + d + 2], k3 = Kt[tn * 129 + d + 3];
#pragma unroll
                for (int i = 0; i < 8; ++i) { const f32x4 wq = *(const f32x4*)(Wq + (tk + i) * 128 + d); acc[i] += (k0 * wq[0] + k1 * wq[1]) + (k2 * wq[2] + k3 * wq[3]); } }
            u32x4 w; w.x = cvt_pk_bf16(acc[0], acc[1]); w.y = cvt_pk_bf16(acc[2], acc[3]); w.z = cvt_pk_bf16(acc[4], acc[5]); w.w = cvt_pk_bf16(acc[6], acc[7]);
            *(u32x4*)((bf16_t*)(p.ws + OFF_WST) + (size_t)(n0 + tn) * 1024 + k0 + tk) = w; }
    }
        } else {


    typedef float f32x2 __attribute__((ext_vector_type(2)));
    f32x2* Apow = (f32x2*)lds;
    f32x2* BB = Apow + 65 * 64;
    f32x2* CC = BB + 64 * 16;
    float* Ktab = (float*)(CC + 16 * 64);
    for (int wi = blockIdx.x; wi < 256; wi += gridDim.x) {
        const int g = wi & 31, slice = wi >> 5;
        __syncthreads();
        for (int idx = tid; idx < 65 * 64; idx += NTHR) Apow[idx] = ((const f32x2*)(p.ws + OFF_APOW))[(size_t)g * 65 * 64 + idx];
        for (int idx = tid; idx < 2048; idx += NTHR) BB[idx] = ((const f32x2*)(p.ws + OFF_BBCC))[(size_t)g * 2048 + idx];
        for (int idx = tid; idx < 16384 / 4; idx += NTHR) ((f32x4*)Ktab)[idx] = ((const f32x4*)(p.ws + OFF_KTAB))[(size_t)g * 4096 + idx];
        __syncthreads();
        unsigned* wt = (unsigned*)(p.ws + OFF_WT) + ((size_t)g * 1024 + slice * 128) * 576;
        for (int e = tid; e < 128 * 576; e += NTHR) { const int nl = e / 576, k = (e - nl * 576) * 2, n = slice * 128 + nl, i = n >> 4, h = n & 15; float v0, v1;
            if (k >= 128 + 256 * ((i >> 4) + 1)) continue;
            if (k >= 128) { const int kk = k - 128, j = kk >> 4, h2 = kk & 15; v0 = (j <= i) ? Ktab[((i - j) * 16 + h) * 16 + h2] : 0.f; v1 = (j <= i) ? Ktab[((i - j) * 16 + h) * 16 + h2 + 1] : 0.f; }
            else { const int q = k, pp = q & 63; const f32x2 c0 = CC[h * 64 + pp], a0 = Apow[(i + 1) * 64 + pp], c1 = CC[h * 64 + pp + 1], a1 = Apow[(i + 1) * 64 + pp + 1];
                if (q < 64) { v0 = c0.x * a0.x - c0.y * a0.y; v1 = c1.x * a1.x - c1.y * a1.y; } else { v0 = -(c0.x * a0.y + c0.y * a0.x); v1 = -(c1.x * a1.y + c1.y * a1.x); } }
            wt[e] = cvt_pk_bf16(v0, v1); }
        for (int e = tid; e < 2 * 32 * 256; e += NTHR) { const int kh = e >> 13, rl = (e >> 8) & 31, kk = (e & 255) * 2, row = slice * 32 + rl; float v0 = 0.f, v1 = 0.f;
            if (row < 128) { const int pp = row & 63, j = kh * 32 + (kk >> 4), h2 = kk & 15; const f32x2 a = Apow[(63 - j) * 64 + pp], b0 = BB[pp * 16 + h2], b1 = BB[pp * 16 + h2 + 1];
                if (row < 64) { v0 = a.x * b0.x - a.y * b0.y; v1 = a.x * b1.x - a.y * b1.y; } else { v0 = a.x * b0.y + a.y * b0.x; v1 = a.x * b1.y + a.y * b1.x; } }
            ((unsigned*)(p.ws + OFF_WSS))[(((size_t)(g * 2 + kh) * 256 + row) * 512 + kk) >> 1] = cvt_pk_bf16(v0, v1); }
        if (slice == 0 && tid < 64) ((f32x2*)(p.ws + OFF_A64))[g * 64 + tid] = Apow[64 * 64 + tid];
    }
        }
        __syncthreads();
    }
}
struct PtrP1 { const char* A; const char* B; __device__ void fill(Unit& u, int PM, int pn) const { u.pm = PM; u.pn = pn; u.pz = 0; u.a = A + (size_t)PM * 256 * 1024 * 2; u.b = B + (size_t)pn * 256 * 1024 * 2; } };
struct EpiP1 {
    static constexpr bool PERM = true, AFTER_DRAIN = false;
    bf16_t* UG; bf16_t* cq; bf16_t* ckv; float* partq; float* partkv; bf16_t* Kimg; const float* cs;
    __device__ __forceinline__ void operator()(const f32x4 (&acc)[2][2][4][2], const Unit& u, int wr, int wc, int fr_, int fq_) const {
        int fr = fr_, fq = fq_; asm volatile("" : "+v"(fr), "+v"(fq));
#pragma unroll
        for (int bj = 0; bj < 2; ++bj) {
            const int c32 = u.pn * 256 + bj * 128 + wc * 32, c8 = c32 + 8 * fq;
#pragma unroll
            for (int ai = 0; ai < 2; ++ai)
#pragma unroll
                for (int m = 0; m < 4; ++m) {
                    const int t = u.pm * 256 + ai * 128 + wr * 64 + m * 16 + fr;
                    const f32x4 v0 = acc[ai][bj][m][0], v1 = acc[ai][bj][m][1];
                    if (c32 < 512) {
                        *(u32x4*)(UG + ((size_t)(c8 >> 4) * 1024 + (t >> 6)) * 1152 + 128 + (t & 63) * 16 + (c8 & 15)) = pack8(v0, v1);
                    } else if (c32 < 1152) {
                        float s = (v0[0] * v0[0] + v0[1] * v0[1]) + (v0[2] * v0[2] + v0[3] * v0[3]) + (v1[0] * v1[0] + v1[1] * v1[1]) + (v1[2] * v1[2] + v1[3] * v1[3]);
                        s += __shfl_xor(s, 16); s += __shfl_xor(s, 32);
                        if (c32 < 896) { *(u32x4*)(cq + (size_t)t * 384 + (c8 - 512)) = pack8(v0, v1); if (fq == 0) partq[(size_t)t * 12 + ((c32 - 512) >> 5)] = s; }
                        else { *(u32x4*)(ckv + (size_t)t * 256 + (c8 - 896)) = pack8(v0, v1); if (fq == 0) partkv[(size_t)t * 8 + ((c32 - 896) >> 5)] = s; }
                    } else if (c32 < 1184) {
                        const float* csr = cs + ((size_t)t * 16 + (fq & 1) * 8) * 2;
                        f32x4 o0, o1;
#pragma unroll
                        for (int e = 0; e < 4; ++e) {
                            const float a0 = v0[e], a1 = v1[e], b0 = __shfl_xor(a0, 32), b1 = __shfl_xor(a1, 32);
                            const float c0 = csr[e * 2], s0 = csr[e * 2 + 1], c1 = csr[(4 + e) * 2], s1 = csr[(4 + e) * 2 + 1];
                            o0[e] = (fq < 2) ? a0 * c0 - b0 * s0 : a0 * c0 + b0 * s0;
                            o1[e] = (fq < 2) ? a1 * c1 - b1 * s1 : a1 * c1 + b1 * s1; }
                        const u32x4 w = pack8(o0, o1);
                        const int b = t >> 13, tile = (t & 8191) >> 6, key = t & 63;
#pragma unroll
                        for (int h = 0; h < 8; ++h) *(u32x4*)(Kimg + ((((size_t)(b * 8 + h) * 128 + tile) * 12 + 8 + fq) * 64 + key) * 8) = w;
                    }
                }
        }
    }
};
__device__ __forceinline__ void phase_p1(const P& p, char* lds) {
    OrderT<PtrP1> S; PtrP1 pt; pt.A = p.ws + OFF_H1; pt.B = p.ws + OFF_BT1; S.init(T / 256, 5, (int)gridDim.x, (int)blockIdx.x, pt);
    EpiP1 E; E.UG = (bf16_t*)(p.ws + OFF_UG); E.cq = (bf16_t*)(p.ws + OFF_CQ); E.ckv = (bf16_t*)(p.ws + OFF_CKV); E.partq = (float*)(p.ws + OFF_PQ); E.partkv = (float*)(p.ws + OFF_PKV);
    E.Kimg = (bf16_t*)(p.ws + OFF_KIMG); E.cs = (const float*)(p.ws + OFF_CS);
    Gemm g; g.K = 1024; g.lda = 1024; g.ldb = 1024;
    pg8::gemm_phase<EpiP1, OrderT<PtrP1>, false>((PG8_LAS unsigned char*)lds, g, S, E, nullptr);
}


constexpr size_t OFF_QB = OFF_R1;
constexpr size_t OFF_E = OFF_R1 + (size_t)T * 8 * 96 * 2;
constexpr size_t OFF_YMLA = OFF_R2;
constexpr float QSCALE = 0.10206207261596577f * 1.4426950408889634f;
struct PtrAB { const char* A; const char* B; size_t sa, sb; __device__ void fill(Unit& u, int PM, int pn) const { u.pm = PM; u.pn = pn; u.pz = 0; u.a = A + (size_t)PM * sa; u.b = B + (size_t)pn * sb; } };
struct EpiQ {
    static constexpr bool PERM = true, AFTER_DRAIN = false;
    bf16_t* Qb; const float* rqa; const float* cs;
    __device__ __forceinline__ void operator()(const f32x4 (&acc)[2][2][4][2], const Unit& u, int wr, int wc, int fr_, int fq_) const {
        int fr = fr_, fq = fq_; asm volatile("" : "+v"(fr), "+v"(fq));
        float rq[8];
#pragma unroll
        for (int r8 = 0; r8 < 8; ++r8) rq[r8] = rqa[u.pm * 256 + (r8 >> 2) * 128 + wr * 64 + (r8 & 3) * 16 + fr];
        const int g0 = (u.pn * 256 + wc * 32) >> 5, j0 = g0 % 3, j1 = (g0 + 4) % 3;
        const bool rope = (j0 == 2) || (j1 == 2);
#pragma unroll
        for (int rp = 0; rp < 4; ++rp) { const int ai = rp >> 1, mb = (rp & 1) * 2;
            f32x4 csv[2][4];
            if (rope) {
#pragma unroll
                for (int mm = 0; mm < 2; ++mm) { const int t = u.pm * 256 + ai * 128 + wr * 64 + (mb + mm) * 16 + fr; const f32x4* csr = (const f32x4*)(cs + ((size_t)t * 16 + (fq & 1) * 8) * 2);
#pragma unroll
                    for (int q = 0; q < 4; ++q) csv[mm][q] = csr[q]; } }
#pragma unroll
            for (int mm = 0; mm < 2; ++mm) { const int m = mb + mm; const int t = u.pm * 256 + ai * 128 + wr * 64 + m * 16 + fr; const float rqv = rq[ai * 4 + m];
#pragma unroll
                for (int bj = 0; bj < 2; ++bj) {
                    const int c32 = u.pn * 256 + bj * 128 + wc * 32, g32 = c32 >> 5, h = g32 / 3, j = g32 - 3 * h;
                    f32x4 v0 = acc[ai][bj][m][0] * rqv, v1 = acc[ai][bj][m][1] * rqv;
                    if (j == 2) {
                        f32x4 o0, o1;
#pragma unroll
                        for (int e = 0; e < 4; ++e) {
                            const float a0 = v0[e], a1 = v1[e], b0 = __shfl_xor(a0, 32), b1 = __shfl_xor(a1, 32);
                            const float c0 = csv[mm][e >> 1][(e & 1) * 2], s0 = csv[mm][e >> 1][(e & 1) * 2 + 1], c1 = csv[mm][2 + (e >> 1)][(e & 1) * 2], s1 = csv[mm][2 + (e >> 1)][(e & 1) * 2 + 1];
                            o0[e] = (fq < 2) ? a0 * c0 - b0 * s0 : a0 * c0 + b0 * s0;
                            o1[e] = (fq < 2) ? a1 * c1 - b1 * s1 : a1 * c1 + b1 * s1; }
                        v0 = o0; v1 = o1;
                    }
                    *(u32x4*)(Qb + ((size_t)((t >> 13) * 8 + h) * SEQ + (t & 8191)) * 96 + j * 32 + 8 * fq) = pack8(v0, v1);
                }
            }
            asm volatile("" ::: "memory");
        }
    }
};
struct EpiK {
    static constexpr bool PERM = true, AFTER_DRAIN = false;
    bf16_t* Kimg; const float* partkv;
    __device__ __forceinline__ void operator()(const f32x4 (&acc)[2][2][4][2], const Unit& u, int wr, int wc, int fr_, int fq_) const {
        int fr = fr_, fq = fq_; asm volatile("" : "+v"(fr), "+v"(fq));
#pragma unroll
        for (int ai = 0; ai < 2; ++ai)
#pragma unroll
            for (int m = 0; m < 4; ++m) { const int t = u.pm * 256 + ai * 128 + wr * 64 + m * 16 + fr;
                const float rk = partkv[t];
                const int bb = t >> 13, tile = (t & 8191) >> 6, key = t & 63;
#pragma unroll
                for (int bj = 0; bj < 2; ++bj) { const int c8 = u.pn * 256 + bj * 128 + wc * 32 + 8 * fq, h = c8 >> 6, chunk = (c8 & 63) >> 3;
                    *(u32x4*)(Kimg + ((((size_t)(bb * 8 + h) * 128 + tile) * 12 + chunk) * 64 + key) * 8) = pack8(acc[ai][bj][m][0] * rk, acc[ai][bj][m][1] * rk); }
                }
    }
};
struct EpiV {
    static constexpr bool PERM = false, AFTER_DRAIN = false;
    bf16_t* Vimg; const float* partkv;
    __device__ __forceinline__ void operator()(const f32x4 (&acc)[2][2][4][2], const Unit& u, int wr, int wc, int fr_, int fq_) const {
        int fr = fr_, fq = fq_; asm volatile("" : "+v"(fr), "+v"(fq));
#pragma unroll
        for (int bj = 0; bj < 2; ++bj)
#pragma unroll
            for (int n = 0; n < 2; ++n) {
                const int tk = u.pn * 256 + bj * 128 + wc * 32 + 16 * n + 4 * fq;
                const f32x4 rk = *(const f32x4*)(partkv + tk);
                const int bb = tk >> 13, tile = (tk & 8191) >> 6, key = tk & 63, pos = ((fq & 1) << 3) | ((fq >> 1) << 2), g = (key >> 4) * 2 + (pos >> 3);
#pragma unroll
                for (int ai = 0; ai < 2; ++ai)
#pragma unroll
                    for (int m = 0; m < 4; ++m) { const int r = u.pm * 256 + ai * 128 + wr * 64 + m * 16 + fr, h = r >> 6, d = r & 63;
                        const f32x4 v = acc[ai][bj][m][n] * rk; u32x2 w; w.x = cvt_pk_bf16(v[0], v[1]); w.y = cvt_pk_bf16(v[2], v[3]);
                        *(u32x2*)(Vimg + ((size_t)(bb * 8 + h) * 128 + tile) * 4096 + d * 64 + ((g ^ ((d >> 1) & 7)) * 8) + (pos & 7)) = w; }
                asm volatile("" ::: "memory");
            }
    }
};

struct PtrState { const char* UG; const char* W; __device__ void fill(Unit& u, int PM, int pn) const { u.pm = PM; u.pn = pn; u.pz = 0; const int g = PM >> 2, rt = PM & 3;
    u.a = UG + ((size_t)(g * 1024 + rt * 256) * 1152 + 128 + pn * 512) * 2; u.b = W + (size_t)(g * 2 + pn) * 256 * 512 * 2; } };
struct EpiE {
    static constexpr bool PERM = false, AFTER_DRAIN = false;
    float* E;
    __device__ __forceinline__ void operator()(const f32x4 (&acc)[2][2][4][2], const Unit& u, int wr, int wc, int fr_, int fq_) const {
        int fr = fr_, fq = fq_; asm volatile("" : "+v"(fr), "+v"(fq));
        const int g = u.pm >> 2, rt = u.pm & 3;
#pragma unroll
        for (int ai = 0; ai < 2; ++ai)
#pragma unroll
            for (int m = 0; m < 4; ++m) { const int c = rt * 256 + ai * 128 + wr * 64 + m * 16 + fr;
#pragma unroll
                for (int n = 0; n < 2; ++n) *(f32x4*)(E + ((size_t)(g * 2 + u.pn) * 1024 + c) * 128 + wc * 32 + 16 * n + 4 * fq) = acc[ai][0][m][n]; }
    }
};
__device__ __forceinline__ void phase_p2(const P& p, char* lds) {
    {
        const int tid = otid(); float* rqa = (float*)(p.ws + OFF_RQ); float* rka = (float*)(p.ws + OFF_RK); const float* partq = (const float*)(p.ws + OFF_PQ); const float* partkv = (const float*)(p.ws + OFF_PKV);
        PtrAB pt0; pt0.A = nullptr; pt0.B = nullptr; pt0.sa = 0; pt0.sb = 0; Unit u;
        {   OrderT<PtrAB> S; S.init(T / 256, 3, (int)gridDim.x, (int)blockIdx.x, pt0);
            for (int i = 0; S.next(i, u); ++i) if (tid < 256) { const int t = u.pm * 256 + tid; const f32x4* pp = (const f32x4*)(partq + (size_t)t * 12);
                const f32x4 a = pp[0], b = pp[1], c = pp[2]; const float s = ((a[0] + a[1]) + (a[2] + a[3])) + ((b[0] + b[1]) + (b[2] + b[3])) + ((c[0] + c[1]) + (c[2] + c[3]));
                rqa[t] = QSCALE / sqrtf(s * (1.0f / 384.0f) + 1e-6f); } }
#define FK_RKROW(T_) { const int t = (T_); const f32x4* pp = (const f32x4*)(partkv + (size_t)t * 8); const f32x4 a = pp[0], b = pp[1]; \
            rka[t] = 1.0f / sqrtf((((a[0] + a[1]) + (a[2] + a[3])) + ((b[0] + b[1]) + (b[2] + b[3]))) * (1.0f / 256.0f) + 1e-6f); }
        {   OrderT<PtrAB> S; S.init(T / 256, 2, (int)gridDim.x, (int)blockIdx.x, pt0);
            for (int i = 0; S.next(i, u); ++i) if (tid < 256) FK_RKROW(u.pm * 256 + tid) }
        {   OrderT<PtrAB> S; S.init(2, T / 256, (int)gridDim.x, (int)blockIdx.x, pt0);
            for (int i = 0; S.next(i, u); ++i) if (tid < 256) FK_RKROW(u.pn * 256 + tid) }
#undef FK_RKROW
        asm volatile("s_waitcnt vmcnt(0)" ::: "memory"); __syncthreads();
    }
    {   OrderT<PtrAB> S; PtrAB pt; pt.A = p.ws + OFF_CQ; pt.B = p.ws + OFF_BTQ; pt.sa = (size_t)256 * 384 * 2; pt.sb = (size_t)256 * 384 * 2; S.init(T / 256, 3, (int)gridDim.x, (int)blockIdx.x, pt);
        EpiQ E; E.Qb = (bf16_t*)(p.ws + OFF_QB); E.rqa = (const float*)(p.ws + OFF_RQ); E.cs = (const float*)(p.ws + OFF_CS);
        Gemm g; g.K = 384; g.lda = 384; g.ldb = 384;
        pg8::gemm_phase<EpiQ, OrderT<PtrAB>, false>((PG8_LAS unsigned char*)lds, g, S, E, nullptr); }
    __syncthreads();
    {   OrderT<PtrAB> S; PtrAB pt; pt.A = p.ws + OFF_CKV; pt.B = p.ws + OFF_BTK; pt.sa = (size_t)256 * 256 * 2; pt.sb = (size_t)256 * 256 * 2; S.init(T / 256, 2, (int)gridDim.x, (int)blockIdx.x, pt);
        EpiK E; E.Kimg = (bf16_t*)(p.ws + OFF_KIMG); E.partkv = (const float*)(p.ws + OFF_RK);
        Gemm g; g.K = 256; g.lda = 256; g.ldb = 256;
        pg8::gemm_phase<EpiK, OrderT<PtrAB>, false>((PG8_LAS unsigned char*)lds, g, S, E, nullptr); }
    __syncthreads();
    {   OrderT<PtrAB> S; PtrAB pt; pt.A = p.ws + OFF_ATV; pt.B = p.ws + OFF_CKV; pt.sa = (size_t)256 * 256 * 2; pt.sb = (size_t)256 * 256 * 2; S.init(2, T / 256, (int)gridDim.x, (int)blockIdx.x, pt);
        EpiV E; E.Vimg = (bf16_t*)(p.ws + OFF_VIMG); E.partkv = (const float*)(p.ws + OFF_RK);
        Gemm g; g.K = 256; g.lda = 256; g.ldb = 256;
        pg8::gemm_phase<EpiV, OrderT<PtrAB>, false>((PG8_LAS unsigned char*)lds, g, S, E, nullptr); }
    __syncthreads();
    {   OrderT<PtrState> S; PtrState pt; pt.UG = p.ws + OFF_UG; pt.W = p.ws + OFF_WSS; S.init(128, 2, (int)gridDim.x, (int)blockIdx.x, pt);
        EpiE E; E.E = (float*)(p.ws + OFF_E);
        Gemm g; g.K = 512; g.lda = 1152; g.ldb = 512;
        pg8::gemm_phase<EpiE, OrderT<PtrState>, false>((PG8_LAS unsigned char*)lds, g, S, E, nullptr); }
}
typedef short bf16x8 __attribute__((ext_vector_type(8)));
typedef float f32x16 __attribute__((ext_vector_type(16)));
#define FK_MFMA32(a, b, c) __builtin_amdgcn_mfma_f32_32x32x16_bf16(a, b, c, 0, 0, 0)
constexpr int ATT_TILE_BYTES = 20480;
__device__ __forceinline__ void attn_stage(const bf16_t* kt, const bf16_t* vt, PG8_LAS unsigned char* buf, int w, int lane) {
    const bf16_t* s0 = kt + w * 512 + lane * 8;
    const bf16_t* s1 = (w < 4) ? kt + (w + 8) * 512 + lane * 8 : vt + (w - 4) * 512 + lane * 8;
    __builtin_amdgcn_global_load_lds((const unsigned*)s0, (PG8_LAS unsigned*)(buf + w * 1024), 16, 0, 0);
    __builtin_amdgcn_global_load_lds((const unsigned*)s1, (PG8_LAS unsigned*)(buf + (w + 8) * 1024), 16, 0, 0);
    if (w < 4) __builtin_amdgcn_global_load_lds((const unsigned*)(vt + (w + 4) * 512 + lane * 8), (PG8_LAS unsigned*)(buf + (w + 16) * 1024), 16, 0, 0);
}
__device__ __forceinline__ void attn_unit(const P& p, PG8_LAS unsigned char* lds, int b, int h, int qb) {
    const int tid = otid(), lane = tid & 63, r32 = lane & 31, hi = lane >> 5; const int w = __builtin_amdgcn_readfirstlane(tid >> 6);
    const bf16_t* kimg = (const bf16_t*)(p.ws + OFF_KIMG) + (size_t)(b * 8 + h) * 128 * 6144;
    const bf16_t* vimg = (const bf16_t*)(p.ws + OFF_VIMG) + (size_t)(b * 8 + h) * 128 * 4096;
    const int q0 = qb * 256 + w * 32, NT = 4 * qb + 4, my_nt = 4 * qb + (w >> 1) + 1;
    const bf16_t* qrow = (const bf16_t*)(p.ws + OFF_QB) + ((size_t)(b * 8 + h) * SEQ + q0 + r32) * 96;
    bf16x8 qf[6];
#pragma unroll
    for (int d0 = 0; d0 < 6; ++d0) qf[d0] = *(const bf16x8*)(qrow + d0 * 16 + hi * 8);
    f32x16 o0, o1;
#pragma unroll
    for (int r = 0; r < 16; ++r) { o0[r] = 0.f; o1[r] = 0.f; }
    float m_ref = 0.f, l_run = 0.f; f32x16 negm, s0, s1;
#pragma unroll
    for (int r = 0; r < 16; ++r) negm[r] = 0.f;
#define FK_QK(dst0, dst1, kb_) { _Pragma("unroll") for (int d0 = 0; d0 < 6; ++d0) { \
        const bf16x8 k0_ = *(const PG8_LAS bf16x8*)((kb_) + ((2 * d0 + hi) * 64 + r32) * 16), k1_ = *(const PG8_LAS bf16x8*)((kb_) + ((2 * d0 + hi) * 64 + 32 + r32) * 16); \
        dst0 = FK_MFMA32(k0_, qf[d0], d0 == 0 ? negm : dst0); dst1 = FK_MFMA32(k1_, qf[d0], d0 == 0 ? negm : dst1); } }
#define FK_WAIT_OLDER() { if (w < 4) asm volatile("s_waitcnt vmcnt(3)" ::: "memory"); else asm volatile("s_waitcnt vmcnt(2)" ::: "memory"); }
    asm volatile("s_waitcnt vmcnt(0)" ::: "memory");
    attn_stage(kimg, vimg, lds, w, lane);
    attn_stage(kimg + 6144, vimg + 4096, lds + ATT_TILE_BYTES, w, lane);
    attn_stage(kimg + 2 * 6144, vimg + 2 * 4096, lds + 2 * ATT_TILE_BYTES, w, lane);
    asm volatile("s_waitcnt vmcnt(0)" ::: "memory");
    __syncthreads();
#define FK_SOFTMAX(first_) { \
            float mx = fmaxf(fmaxf(s0[0], s0[1]), s1[0]); \
            _Pragma("unroll") for (int r = 2; r < 16; r += 2) mx = fmaxf(fmaxf(mx, s0[r]), s0[r + 1]); \
            _Pragma("unroll") for (int r = 1; r < 15; r += 2) mx = fmaxf(fmaxf(mx, s1[r]), s1[r + 1]); \
            mx = fmaxf(mx, s1[15]); \
            mx = fmaxf(mx, __shfl_xor(mx, 32)); \
            if ((first_) || __builtin_amdgcn_ballot_w64(mx > 8.0f) != 0ull) { \
                const float delta = (first_) ? mx : fmaxf(mx, 0.f), sc = __builtin_amdgcn_exp2f(-delta); \
                m_ref += delta; l_run *= sc; \
                _Pragma("unroll") for (int r = 0; r < 16; ++r) { s0[r] -= delta; s1[r] -= delta; o0[r] *= sc; o1[r] *= sc; negm[r] = -m_ref; } \
            } \
            float ls0 = 0.f, ls1 = 0.f; \
            _Pragma("unroll") for (int r = 0; r < 8; ++r) { const float a0 = __builtin_amdgcn_exp2f(s0[2 * r]), a1 = __builtin_amdgcn_exp2f(s0[2 * r + 1]), b0 = __builtin_amdgcn_exp2f(s1[2 * r]), b1 = __builtin_amdgcn_exp2f(s1[2 * r + 1]); \
                ls0 += a0 + a1; ls1 += b0 + b1; pw[r] = cvt_pk_bf16(a0, a1); pw[8 + r] = cvt_pk_bf16(b0, b1); } \
            l_run += ls0 + ls1; }
#define FK_RDV(vb_) { _Pragma("unroll") for (int ks = 0; ks < 4; ++ks) { const int g = 2 * ks + hi; \
                vf0[ks] = *(const PG8_LAS bf16x8*)((vb_) + r32 * 128 + ((g ^ ((r32 >> 1) & 7)) * 16)); \
                vf1[ks] = *(const PG8_LAS bf16x8*)((vb_) + (32 + r32) * 128 + ((g ^ (((32 + r32) >> 1) & 7)) * 16)); } }
#define FK_RDK(kb_) { _Pragma("unroll") for (int d0 = 0; d0 < 6; ++d0) { kf0[d0] = *(const PG8_LAS bf16x8*)((kb_) + ((2 * d0 + hi) * 64 + r32) * 16); kf1[d0] = *(const PG8_LAS bf16x8*)((kb_) + ((2 * d0 + hi) * 64 + 32 + r32) * 16); } }
#define FK_PV() { _Pragma("unroll") for (int ks = 0; ks < 4; ++ks) { union { bf16x8 v; unsigned u[4]; } pf; \
                _Pragma("unroll") for (int jj = 0; jj < 4; ++jj) pf.u[jj] = pw[ks * 4 + jj]; \
                o0 = FK_MFMA32(vf0[ks], pf.v, o0); o1 = FK_MFMA32(vf1[ks], pf.v, o1); } }
#define FK_QKF() { s0 = FK_MFMA32(kf0[0], qf[0], negm); s1 = FK_MFMA32(kf1[0], qf[0], negm); \
                _Pragma("unroll") for (int d0 = 1; d0 < 6; ++d0) { s0 = FK_MFMA32(kf0[d0], qf[d0], s0); s1 = FK_MFMA32(kf1[d0], qf[d0], s1); } }
    if (w < 4) {
    FK_QK(s0, s1, lds)
    int slot = 0;
    for (int t = 0; t < NT; ++t) {
        const int slot1 = slot == 5 ? 0 : slot + 1, slot3 = slot >= 3 ? slot - 3 : slot + 3, slot4 = slot >= 2 ? slot - 2 : slot + 4;
        if ((t & 1) == 0) {
            if (t > 0) { asm volatile("s_waitcnt vmcnt(0)" ::: "memory"); __syncthreads(); }
            if (t + 3 < NT) attn_stage(kimg + (size_t)(t + 3) * 6144, vimg + (size_t)(t + 3) * 4096, lds + slot3 * ATT_TILE_BYTES, w, lane);
            if (t + 4 < NT) attn_stage(kimg + (size_t)(t + 4) * 6144, vimg + (size_t)(t + 4) * 4096, lds + slot4 * ATT_TILE_BYTES, w, lane); }
        if (t < my_nt) {
            const bool more = (t + 1 < my_nt);
            const PG8_LAS unsigned char* kb1 = lds + slot1 * ATT_TILE_BYTES; const PG8_LAS unsigned char* vb = lds + slot * ATT_TILE_BYTES + 12288;
            bf16x8 kf0[6], kf1[6], vf0[4], vf1[4]; unsigned pw[16];
            FK_RDV(vb)
            __builtin_amdgcn_sched_barrier(0);
            FK_SOFTMAX(t == 0)
            __builtin_amdgcn_sched_barrier(0);
            if (more) FK_RDK(kb1)
            FK_PV()
            if (more) FK_QKF()
        }
        slot = slot1;
    }
    } else {
    unsigned pw[16];
#pragma unroll
    for (int r = 0; r < 16; ++r) { pw[r] = 0u; s0[r] = 0.f; s1[r] = 0.f; }
    int slot = 0;
    for (int t = 0; t < NT; ++t) {
        const int slot1 = slot == 5 ? 0 : slot + 1, slot3 = slot >= 3 ? slot - 3 : slot + 3, slot4 = slot >= 2 ? slot - 2 : slot + 4, slotm = slot == 0 ? 5 : slot - 1;
        if ((t & 1) == 0) {
            if (t > 0) { asm volatile("s_waitcnt vmcnt(0)" ::: "memory"); __syncthreads(); }
            if (t + 3 < NT) attn_stage(kimg + (size_t)(t + 3) * 6144, vimg + (size_t)(t + 3) * 4096, lds + slot3 * ATT_TILE_BYTES, w, lane);
            if (t + 4 < NT) attn_stage(kimg + (size_t)(t + 4) * 6144, vimg + (size_t)(t + 4) * 4096, lds + slot4 * ATT_TILE_BYTES, w, lane); }
        const bool dopv = t >= 1 && t <= my_nt, doqk = t < my_nt;
        bf16x8 kf0[6], kf1[6], vf0[4], vf1[4];
        if (dopv) FK_RDV(lds + slotm * ATT_TILE_BYTES + 12288)
        if (doqk) FK_RDK(lds + slot * ATT_TILE_BYTES)
        if (dopv) FK_PV()
        if (doqk) { FK_QKF()
            __builtin_amdgcn_sched_barrier(0);
            __builtin_amdgcn_s_setprio(0);
            FK_SOFTMAX(t == 0)
            __builtin_amdgcn_s_setprio(2); }
        slot = slot1;
    }
    if (my_nt == NT) { bf16x8 vf0[4], vf1[4]; const int slotm = slot == 0 ? 5 : slot - 1;
        FK_RDV(lds + slotm * ATT_TILE_BYTES + 12288)
        FK_PV() }
    }
#undef FK_SOFTMAX
#undef FK_RDV
#undef FK_RDK
#undef FK_PV
#undef FK_QKF
    __syncthreads();
#undef FK_QK
#undef FK_WAIT_OLDER
    const float lt = l_run + __shfl_xor(l_run, 32), inv = 1.0f / lt;
    bf16_t* yrow = (bf16_t*)(p.ws + OFF_YMLA) + ((size_t)b * SEQ + q0 + r32) * 512 + h * 64;
    float ss = 0.f;
#pragma unroll
    for (int rg = 0; rg < 4; ++rg) {
        const float a0 = o0[4 * rg] * inv, a1 = o0[4 * rg + 1] * inv, a2 = o0[4 * rg + 2] * inv, a3 = o0[4 * rg + 3] * inv;
        const float b0 = o1[4 * rg] * inv, b1 = o1[4 * rg + 1] * inv, b2 = o1[4 * rg + 2] * inv, b3 = o1[4 * rg + 3] * inv;
        ss += (a0 * a0 + a1 * a1) + (a2 * a2 + a3 * a3) + (b0 * b0 + b1 * b1) + (b2 * b2 + b3 * b3);
        u32x2 wa, wb; wa.x = cvt_pk_bf16(a0, a1); wa.y = cvt_pk_bf16(a2, a3); wb.x = cvt_pk_bf16(b0, b1); wb.y = cvt_pk_bf16(b2, b3);
        *(u32x2*)(yrow + 8 * rg + 4 * hi) = wa; *(u32x2*)(yrow + 32 + 8 * rg + 4 * hi) = wb; }
    ss += __shfl_xor(ss, 32);
    if (hi == 0) ((float*)(p.ws + OFF_PMLA))[((size_t)b * SEQ + q0 + r32) * 8 + h] = ss;
}
__device__ __forceinline__ void s5_carry_scan(const P& p, char* lds) {
    typedef float f32x2 __attribute__((ext_vector_type(2)));
    const int tid_ = otid();
    float* el = (float*)lds;
    for (int cb = blockIdx.x; cb < 256; cb += gridDim.x) { const int g = cb & 31, b = cb >> 5;
        const float* e0 = (const float*)(p.ws + OFF_E) + ((size_t)(g * 2) * 1024 + b * 128) * 128; const float* e1 = e0 + (size_t)1024 * 128;
        __syncthreads();
#pragma unroll
        for (int i = 0; i < 8; ++i) { const int i4 = (i * NTHR + tid_) * 4; const f32x4 x0 = *(const f32x4*)(e0 + i4), x1 = *(const f32x4*)(e1 + i4); *(f32x4*)(el + i4) = x0 + x1; }
        __syncthreads();
        if (tid_ < 64) { const int pp = tid_; const f32x2 a = ((const f32x2*)(p.ws + OFF_A64))[g * 64 + pp];
            bf16_t* sp = (bf16_t*)(p.ws + OFF_UG) + ((size_t)g * 1024 + b * 128) * 1152 + pp;
            float sr = 0.f, si = 0.f;
#pragma unroll 8
            for (int cl = 0; cl < 128; ++cl) {
                sp[(size_t)cl * 1152] = (bf16_t)(cvt_pk_bf16(sr, 0.f) & 0xffffu); sp[(size_t)cl * 1152 + 64] = (bf16_t)(cvt_pk_bf16(si, 0.f) & 0xffffu);
                const float er = el[cl * 128 + pp], ei = el[cl * 128 + 64 + pp];
                const float nr = a.x * sr - a.y * si + er, ni = a.x * si + a.y * sr + ei; sr = nr; si = ni; } }
    }
    __syncthreads();
}
__device__ __forceinline__ void phase_p3(const P& p, char* lds) {
    s5_carry_scan(p, lds);
    const int xcd = blockIdx.x & 7, slot = blockIdx.x >> 3, nslot = gridDim.x >> 3;
    if (__builtin_amdgcn_readfirstlane(otid() >> 6) < 4) __builtin_amdgcn_s_setprio(1); else __builtin_amdgcn_s_setprio(2);
    for (int li = slot; li < 128; li += nslot) { const int bh = xcd + 8 * (li >> 4), pr = li & 15;
#pragma unroll 1
        for (int half = 0; half < 2; ++half) attn_unit(p, (PG8_LAS unsigned char*)lds, bh >> 3, bh & 7, half ? 31 - pr : pr); }
    __builtin_amdgcn_s_setprio(0);
}

constexpr size_t OFF_YG = OFF_R1, OFF_YS5 = OFF_R1 + (size_t)T * 512 * 2;
__device__ __forceinline__ float gelu_fast(float x) {
    const float z = x * (0.7978845608028654f + 0.035677408136300125f * x * x);
    return x * __builtin_amdgcn_rcpf(1.0f + __builtin_amdgcn_exp2f(-2.885390081777927f * z)); }
struct PtrToep { const char* UG; const char* W; __device__ void fill(Unit& u, int PM, int pn) const { u.pm = PM; u.pn = pn; u.pz = 0; const int g = PM >> 2, rt = PM & 3;
    u.a = UG + (size_t)(g * 1024 + rt * 256) * 1152 * 2; u.b = W + (size_t)(g * 1024 + pn * 256) * 1152 * 2; u.nt = 2 + 4 * (pn + 1); } };
struct OrderToep { int G, c; PtrToep pt;
    __device__ bool next(int i, Unit& u) const { const long L = (long)i * G + c; if (L >= 512) return false;
        const int half = (int)(L >> 8), idx = (int)(L & 255), x = idx & 7, slot = idx >> 3, g = x * 4 + (slot >> 3), rt = (slot >> 1) & 3, pnlow = slot & 1;
        pt.fill(u, g * 4 + rt, half ? 3 - pnlow : pnlow); return true; }
    __device__ __forceinline__ void a_ready(const Unit&) const {}
    __device__ __forceinline__ void done(const Unit&) const {}
};
struct EpiY {
    static constexpr bool PERM = true, AFTER_DRAIN = false;
    bf16_t* yg;
    __device__ __forceinline__ void operator()(const f32x4 (&acc)[2][2][4][2], const Unit& u, int wr, int wc, int fr_, int fq_) const {
        int fr = fr_, fq = fq_; asm volatile("" : "+v"(fr), "+v"(fq));
        const int g = u.pm >> 2, rt = u.pm & 3;
#pragma unroll
        for (int ai = 0; ai < 2; ++ai)
#pragma unroll
            for (int m = 0; m < 4; ++m) { const int c = rt * 256 + ai * 128 + wr * 64 + m * 16 + fr;
#pragma unroll
                for (int bj = 0; bj < 2; ++bj) { const int n8 = u.pn * 256 + bj * 128 + wc * 32 + 8 * fq, i = n8 >> 4, h0 = n8 & 15;
                    f32x4 v0 = acc[ai][bj][m][0], v1 = acc[ai][bj][m][1];
#pragma unroll
                    for (int e = 0; e < 4; ++e) { v0[e] = gelu_fast(v0[e]); v1[e] = gelu_fast(v1[e]); }
                    *(u32x4*)(yg + ((size_t)c * 64 + i) * 512 + g * 16 + h0) = pack8(v0, v1); } }
    }
};
__device__ __forceinline__ void phase_p4(const P& p, char* lds) {
    OrderToep S; S.pt.UG = p.ws + OFF_UG; S.pt.W = p.ws + OFF_WT; S.G = (int)gridDim.x; S.c = (int)blockIdx.x;
    EpiY E; E.yg = (bf16_t*)(p.ws + OFF_YG);
    Gemm g; g.K = 1152; g.lda = 1152; g.ldb = 1152;
    pg8::gemm_phase<EpiY, OrderToep, false>((PG8_LAS unsigned char*)lds, g, S, E, nullptr);
}
struct EpiG {
    static constexpr bool PERM = true, AFTER_DRAIN = false;
    const bf16_t* yg; bf16_t* ys5; float* parts5; const float* b_glu;
    __device__ __forceinline__ void operator()(const f32x4 (&acc)[2][2][4][2], const Unit& u, int wr, int wc, int fr_, int fq_) const {
        int fr = fr_, fq = fq_; asm volatile("" : "+v"(fr), "+v"(fq));
#pragma unroll
        for (int bj = 0; bj < 2; ++bj) { const int c32 = u.pn * 256 + bj * 128 + wc * 32, c8 = c32 + 8 * fq;
            const f32x4 bg0 = *(const f32x4*)(b_glu + c8), bg1 = *(const f32x4*)(b_glu + c8 + 4);
#pragma unroll
            for (int ai = 0; ai < 2; ++ai)
#pragma unroll
                for (int m = 0; m < 4; ++m) { const int t = u.pm * 256 + ai * 128 + wr * 64 + m * 16 + fr;
                    const u32x4 yw = *(const u32x4*)(yg + (size_t)t * 512 + c8);
                    const f32x4 z0 = acc[ai][bj][m][0] + bg0, z1 = acc[ai][bj][m][1] + bg1; f32x4 o0, o1;
#pragma unroll
                    for (int e = 0; e < 4; ++e) { const unsigned w0 = yw[e >> 1], w1 = yw[2 + (e >> 1)];
                        const float y0 = (e & 1) ? __uint_as_float(w0 & 0xffff0000u) : __uint_as_float(w0 << 16), y1 = (e & 1) ? __uint_as_float(w1 & 0xffff0000u) : __uint_as_float(w1 << 16);
                        o0[e] = y0 * __builtin_amdgcn_rcpf(1.0f + __builtin_amdgcn_exp2f(-1.4426950408889634f * z0[e])); o1[e] = y1 * __builtin_amdgcn_rcpf(1.0f + __builtin_amdgcn_exp2f(-1.4426950408889634f * z1[e])); }
                    float sq = (o0[0] * o0[0] + o0[1] * o0[1]) + (o0[2] * o0[2] + o0[3] * o0[3]) + (o1[0] * o1[0] + o1[1] * o1[1]) + (o1[2] * o1[2] + o1[3] * o1[3]);
                    sq += __shfl_xor(sq, 16); sq += __shfl_xor(sq, 32);
                    *(u32x4*)(ys5 + (size_t)t * 512 + c8) = pack8(o0, o1);
                    if (fq == 0) parts5[(size_t)t * 16 + (c32 >> 5)] = sq; }
            asm volatile("" ::: "memory"); }
    }
};
__device__ __forceinline__ void phase_p5(const P& p, char* lds) {
    OrderT<PtrAB> S; PtrAB pt; pt.A = p.ws + OFF_YG; pt.B = p.ws + OFF_BTG; pt.sa = (size_t)256 * 512 * 2; pt.sb = (size_t)256 * 512 * 2; S.init(T / 256, 2, (int)gridDim.x, (int)blockIdx.x, pt);
    EpiG E; E.yg = (const bf16_t*)(p.ws + OFF_YG); E.ys5 = (bf16_t*)(p.ws + OFF_YS5); E.parts5 = (float*)(p.ws + OFF_PS5); E.b_glu = p.b_glu;
    Gemm g; g.K = 512; g.lda = 512; g.ldb = 512;
    pg8::gemm_phase<EpiG, OrderT<PtrAB>, false>((PG8_LAS unsigned char*)lds, g, S, E, nullptr);
}

struct EpiPlain {
    static constexpr bool PERM = true, AFTER_DRAIN = false;
    bf16_t* O; int ldc, coff;
    __device__ __forceinline__ void operator()(const f32x4 (&acc)[2][2][4][2], const Unit& u, int wr, int wc, int fr_, int fq_) const {
        int fr = fr_, fq = fq_; asm volatile("" : "+v"(fr), "+v"(fq));
#pragma unroll
        for (int ai = 0; ai < 2; ++ai)
#pragma unroll
            for (int m = 0; m < 4; ++m) { bf16_t* rowp = O + (size_t)(u.pm * 256 + ai * 128 + wr * 64 + m * 16 + fr) * ldc + coff + u.pn * 256 + wc * 32 + 8 * fq;
#pragma unroll
                for (int bj = 0; bj < 2; ++bj) *(u32x4*)(rowp + bj * 128) = pack8(acc[ai][bj][m][0], acc[ai][bj][m][1]); }
    }
};
struct PtrP6 { const char* A1; const char* A2; const char* B1; const char* B2;
    __device__ void fill(Unit& u, int PM, int pn) const { u.pm = PM; u.pn = pn; u.pz = 0; const size_t st = (size_t)256 * 512 * 2;
        u.a = (pn < 4 ? A1 : A2) + (size_t)PM * st; u.b = pn < 4 ? B1 + (size_t)pn * st : B2 + (size_t)(pn - 4) * st; } };
__device__ __forceinline__ void phase_p6(const P& p, char* lds) {
    bf16_t* Y12 = (bf16_t*)p.out;
    OrderT<PtrP6> S; PtrP6 pt; pt.A1 = p.ws + OFF_YS5; pt.A2 = p.ws + OFF_YMLA; pt.B1 = p.ws + OFF_BTO1; pt.B2 = p.ws + OFF_BTO2; S.init(T / 256, 8, (int)gridDim.x, (int)blockIdx.x, pt);
    EpiPlain E; E.O = Y12; E.ldc = 2048; E.coff = 0; Gemm g; g.K = 512; g.lda = 512; g.ldb = 512;
    pg8::gemm_phase<EpiPlain, OrderT<PtrP6>, false>((PG8_LAS unsigned char*)lds, g, S, E, nullptr);
}
constexpr size_t OFF_X1 = OFF_R1, OFF_H2 = OFF_R6;
constexpr float DN_ALPHA = 1.189207115002721f;
__device__ __forceinline__ void unpack8(const u32x4 w, float (&o)[8]) {
#pragma unroll
    for (int i = 0; i < 4; ++i) { o[2 * i] = __uint_as_float(w[i] << 16); o[2 * i + 1] = __uint_as_float(w[i] & 0xffff0000u); } }
__device__ __forceinline__ void phase_p7(const P& p, char* lds) {
    const int tid = otid(), lane = tid & 63, w = tid >> 6, c0 = lane * 16;
    const bf16_t* Y12 = (const bf16_t*)p.out; const float* mod = (const float*)(p.ws + OFF_MOD);
    for (int tb = blockIdx.x; tb < T / 256; tb += gridDim.x) {
        const int b = (tb * 256) >> 13; const float* mb = mod + b * 6144;
        float g1[16], sc2[16], sh2[16], lg[16], lb[16];
#pragma unroll
        for (int i = 0; i < 16; ++i) { g1[i] = 1.0f + mb[2048 + c0 + i]; sc2[i] = 1.0f + mb[4096 + c0 + i]; sh2[i] = mb[3072 + c0 + i]; lg[i] = p.ln1_g[c0 + i]; lb[i] = p.ln1_b[c0 + i]; }
        for (int it = 0; it < 32; ++it) { const int t = tb * 256 + it * 8 + w;
            const float* ps = (const float*)(p.ws + OFF_PS5) + (size_t)t * 16; const float* pm = (const float*)(p.ws + OFF_PMLA) + (size_t)t * 8;
            float s5 = 0.f, sm = 0.f;
#pragma unroll
            for (int i = 0; i < 16; ++i) s5 += ps[i];
#pragma unroll
            for (int i = 0; i < 8; ++i) sm += pm[i];
            const float r5 = 1.0f / sqrtf(s5 * (1.0f / 512.0f) + 1e-6f), rm = 1.0f / sqrtf(sm * (1.0f / 512.0f) + 1e-6f);
            float y1[16], y2[16], v[16];
            unpack8(*(const u32x4*)(Y12 + (size_t)t * 2048 + c0), *(float(*)[8])&y1[0]); unpack8(*(const u32x4*)(Y12 + (size_t)t * 2048 + c0 + 8), *(float(*)[8])&y1[8]);
            unpack8(*(const u32x4*)(Y12 + (size_t)t * 2048 + 1024 + c0), *(float(*)[8])&y2[0]); unpack8(*(const u32x4*)(Y12 + (size_t)t * 2048 + 1024 + c0 + 8), *(float(*)[8])&y2[8]);
            float sum = 0.f;
#pragma unroll
            for (int i = 0; i < 4; ++i) { const f32x4 xv = *(const f32x4*)(p.x + (size_t)t * 1024 + c0 + 4 * i);
#pragma unroll
                for (int e = 0; e < 4; ++e) { const int k = 4 * i + e; v[k] = DN_ALPHA * xv[e] + g1[k] * (r5 * y1[k] + rm * y2[k]); sum += v[k]; } }
#pragma unroll
            for (int o = 32; o > 0; o >>= 1) sum += __shfl_xor(sum, o);
            const float mu = sum * (1.0f / 1024.0f); float q = 0.f;
#pragma unroll
            for (int k = 0; k < 16; ++k) { const float d = v[k] - mu; q += d * d; }
#pragma unroll
            for (int o = 32; o > 0; o >>= 1) q += __shfl_xor(q, o);
            const float rstd = 1.0f / sqrtf(q * (1.0f / 1024.0f) + 1e-6f);
            f32x4 a[4], hh[4];
#pragma unroll
            for (int k = 0; k < 16; ++k) { const float x1 = (v[k] - mu) * rstd * lg[k] + lb[k]; a[k >> 2][k & 3] = x1; hh[k >> 2][k & 3] = x1 * sc2[k] + sh2[k]; }
            *(u32x4*)((bf16_t*)(p.ws + OFF_X1) + (size_t)t * 1024 + c0) = pack8(a[0], a[1]); *(u32x4*)((bf16_t*)(p.ws + OFF_X1) + (size_t)t * 1024 + c0 + 8) = pack8(a[2], a[3]);
            *(u32x4*)((bf16_t*)(p.ws + OFF_H2) + (size_t)t * 1024 + c0) = pack8(hh[0], hh[1]); *(u32x4*)((bf16_t*)(p.ws + OFF_H2) + (size_t)t * 1024 + c0 + 8) = pack8(hh[2], hh[3]);
        }
    }
}
struct EpiS {
    static constexpr bool PERM = true, AFTER_DRAIN = false;
    bf16_t* S;
    __device__ __forceinline__ void operator()(const f32x4 (&acc)[2][2][4][2], const Unit& u, int wr, int wc, int fr_, int fq_) const {
        int fr = fr_, fq = fq_; asm volatile("" : "+v"(fr), "+v"(fq));
#pragma unroll
        for (int ai = 0; ai < 2; ++ai)
#pragma unroll
            for (int m = 0; m < 4; ++m) { const int t = u.pm * 256 + ai * 128 + wr * 64 + m * 16 + fr;
#pragma unroll
                for (int bj = 0; bj < 2; ++bj) { const int c8 = bj * 128 + wc * 32 + 8 * fq;
                    *(u32x4*)(S + ((((size_t)(t >> 6) * 8 + u.pn) * 32 + (c8 >> 3)) * 64 + (t & 63)) * 8) = pack8(acc[ai][bj][m][0], acc[ai][bj][m][1]); } }
    }
};
__device__ __forceinline__ void phase_p8(const P& p, char* lds) {
    OrderT<PtrAB> S; PtrAB pt; pt.A = p.ws + OFF_H2; pt.B = p.ws + OFF_WST; pt.sa = (size_t)256 * 1024 * 2; pt.sb = (size_t)256 * 1024 * 2; S.init(T / 256, 8, (int)gridDim.x, (int)blockIdx.x, pt);
    EpiS E; E.S = (bf16_t*)p.out; Gemm g; g.K = 1024; g.lda = 1024; g.ldb = 1024;
    pg8::gemm_phase<EpiS, OrderT<PtrAB>, false>((PG8_LAS unsigned char*)lds, g, S, E, nullptr);
}
constexpr size_t OFF_PK = OFF_R2;
#define FK_MED3(a, b, c) __builtin_amdgcn_fmed3f(a, b, c)
#define FK_INS16(L, x) { _Pragma("unroll") for (int j_ = 15; j_ >= 1; --j_) L[j_] = FK_MED3(L[j_ - 1], L[j_], (x)); L[0] = fmaxf(L[0], (x)); }
__device__ __forceinline__ void topk128(const bf16_t* sp, float (&L)[16]) {
#pragma unroll
    for (int j = 0; j < 16; ++j) L[j] = -INFINITY;
#pragma unroll 8
    for (int cg = 0; cg < 16; ++cg) { const u32x4 w = *(const u32x4*)(sp + (size_t)cg * 512);
#pragma unroll
        for (int i = 0; i < 4; ++i) { const float x0 = __uint_as_float((w[i] << 16) | (unsigned)(cg * 8 + 2 * i)), x1 = __uint_as_float((w[i] & 0xffff0000u) | (unsigned)(cg * 8 + 2 * i + 1));
            FK_INS16(L, x0) FK_INS16(L, x1) } }
}
__device__ __forceinline__ void phase_p9(const P& p, char* lds) {
    const int tid = otid(), lane = tid & 63, h = tid >> 6;
    const float* scu = (const float*)(p.ws + OFF_SCU); const float* scv = (const float*)(p.ws + OFF_SCV);
    for (int tb = blockIdx.x; tb < T / 64; tb += gridDim.x) {
        const bf16_t* sp = (const bf16_t*)p.out + (((size_t)tb * 8 + h) * 32 * 64 + lane) * 8;
        float A[16], B[16], TL[16];
        topk128(sp, A); topk128(sp + (size_t)16 * 512, B);
#pragma unroll
        for (int j = 0; j < 16; ++j) TL[j] = -INFINITY;
#pragma unroll
        for (int i = 0; i < 16; ++i)
#pragma unroll
            for (int j = 0; j < 16; ++j) if ((i + 1) * (j + 1) <= 16) {
                const unsigned ua = __float_as_uint(A[i]), ub = __float_as_uint(B[j]);
                const float sum = __uint_as_float(ua & 0xffffff80u) + __uint_as_float(ub & 0xffffff80u);
                const float key = __uint_as_float((__float_as_uint(sum) & 0xffffc000u) | ((ua & 127u) << 7) | (ub & 127u));
                FK_INS16(TL, key) }
        float e[16], den = 0.f; const float m0 = __uint_as_float(__float_as_uint(TL[0]) & 0xffffc000u);
#pragma unroll
        for (int j = 0; j < 16; ++j) { e[j] = __builtin_amdgcn_exp2f((__uint_as_float(__float_as_uint(TL[j]) & 0xffffc000u) - m0) * 1.4426950408889634f); den += e[j]; }
        const float rden = 1.0f / den;
        unsigned long long* pk = (unsigned long long*)(p.ws + OFF_PK) + ((size_t)(tb * 64 + lane) * 8 + h) * 16;
#pragma unroll
        for (int j = 0; j < 16; j += 2) { const unsigned id0 = __float_as_uint(TL[j]) & 0x3fffu, id1 = __float_as_uint(TL[j + 1]) & 0x3fffu;
            const float su0 = scu[id0], su1 = scu[id1], gv0 = e[j] * rden * scv[id0], gv1 = e[j + 1] * rden * scv[id1];
            u32x4 w; w.x = id0 | (cvt_pk_bf16(su0, 0.f) << 16); w.y = __float_as_uint(gv0); w.z = id1 | (cvt_pk_bf16(su1, 0.f) << 16); w.w = __float_as_uint(gv1);
            *(u32x4*)(pk + j) = w; }
    }
}
__device__ __forceinline__ f32x32 cvt32(const u32x3 a, const u32x3 b) { u32x6 w; w[0] = a.x; w[1] = a.y; w[2] = a.z; w[3] = b.x; w[4] = b.y; w[5] = b.z; return __builtin_amdgcn_cvt_scalef32_pk32_f32_fp6(w, 1.0f); }
__device__ __forceinline__ void phase_p10(const P& p, char* lds) {
    const int tid = otid(), lane = tid & 63; const int w = __builtin_amdgcn_readfirstlane(tid >> 6);
    const float* mod = (const float*)(p.ws + OFF_MOD); const unsigned l12 = (unsigned)lane * 12u;
    const __amdgpu_buffer_rsrc_t ru = __builtin_amdgcn_make_buffer_rsrc((void*)(p.ws + OFF_TU8), 0, 16384 * 768, 0x00020000), rv = __builtin_amdgcn_make_buffer_rsrc((void*)(p.ws + OFF_TV8), 0, 16384 * 768, 0x00020000);
    const int jl = ((lane >> 5) & 1) * 8 + ((lane >> 4) & 1) * 4 + ((lane >> 3) & 1) * 2 + ((lane >> 2) & 1);
    for (int t = blockIdx.x * 8 + w; t < T; t += gridDim.x * 8) {
        int c0 = lane * 16; asm volatile("" : "+v"(c0));
        float hv[16], acc[16];
        unpack8(*(const u32x4*)((const bf16_t*)(p.ws + OFF_H2) + (size_t)t * 1024 + c0), *(float(*)[8])&hv[0]); unpack8(*(const u32x4*)((const bf16_t*)(p.ws + OFF_H2) + (size_t)t * 1024 + c0 + 8), *(float(*)[8])&hv[8]);
#pragma unroll
        for (int i = 0; i < 16; ++i) acc[i] = 0.f;
        const unsigned long long* pk = (const unsigned long long*)(p.ws + OFF_PK) + (size_t)t * 128;
#pragma unroll 1
        for (int h = 0; h < 8; ++h) {
            unsigned ids[16];
#pragma unroll
            for (int j = 0; j < 16; ++j) ids[j] = (unsigned)__builtin_amdgcn_readfirstlane((int)(unsigned)pk[h * 16 + j]) & 0x3fffu;
            u32x3 ur[16], vr[16];
#pragma unroll
            for (int j = 0; j < 16; ++j) ur[j] = __builtin_amdgcn_raw_buffer_load_b96(ru, l12, ids[j] * 768u, 0);
#pragma unroll
            for (int j = 0; j < 8; ++j) vr[j] = __builtin_amdgcn_raw_buffer_load_b96(rv, l12, ids[j] * 768u, 0);
            const unsigned long long mine = pk[h * 16 + jl];
            float d[16];
#pragma unroll
            for (int j = 0; j < 16; j += 2) { const f32x32 uf = cvt32(ur[j], ur[j + 1]); f32x2 a0 = {0.f, 0.f}, a1 = {0.f, 0.f};
#pragma unroll
                for (int i = 0; i < 16; i += 2) { const f32x2 h2 = {hv[i], hv[i + 1]}; a0 += (f32x2){uf[i], uf[i + 1]} * h2; a1 += (f32x2){uf[16 + i], uf[17 + i]} * h2; }
                d[j] = a0[0] + a0[1]; d[j + 1] = a1[0] + a1[1]; }
            __builtin_amdgcn_sched_barrier(0);
#pragma unroll
            for (int j = 8; j < 16; ++j) vr[j] = __builtin_amdgcn_raw_buffer_load_b96(rv, l12, ids[j] * 768u, 0);
            { const bool b5 = lane & 32;
#pragma unroll
              for (int j = 0; j < 8; ++j) { const float keep = b5 ? d[j + 8] : d[j], give = b5 ? d[j] : d[j + 8]; d[j] = keep + __shfl_xor(give, 32); }
              const bool b4 = lane & 16;
#pragma unroll
              for (int j = 0; j < 4; ++j) { const float keep = b4 ? d[j + 4] : d[j], give = b4 ? d[j] : d[j + 4]; d[j] = keep + __shfl_xor(give, 16); }
              const bool b3 = lane & 8;
#pragma unroll
              for (int j = 0; j < 2; ++j) { const float keep = b3 ? d[j + 2] : d[j], give = b3 ? d[j] : d[j + 2]; d[j] = keep + __shfl_xor(give, 8); }
              const bool b2 = lane & 4;
              { const float keep = b2 ? d[1] : d[0], give = b2 ? d[0] : d[1]; d[0] = keep + __shfl_xor(give, 4); }
              d[0] += __shfl_xor(d[0], 2); d[0] += __shfl_xor(d[0], 1); }
            const float su = __uint_as_float(((unsigned)mine) & 0xffff0000u), gsv = __uint_as_float((unsigned)(mine >> 32));
            const float pre = d[0] * su; const float wgt = gsv * gelu_fast(pre);
#pragma unroll
            for (int j = 0; j < 16; j += 2) { const int src0 = ((j >> 3) & 1) * 32 + ((j >> 2) & 1) * 16 + ((j >> 1) & 1) * 8 + (j & 1) * 4, src1 = src0 + 4;
                const float w0 = __uint_as_float((unsigned)__builtin_amdgcn_readlane((int)__float_as_uint(wgt), src0)), w1 = __uint_as_float((unsigned)__builtin_amdgcn_readlane((int)__float_as_uint(wgt), src1));
                const f32x32 vf = cvt32(vr[j], vr[j + 1]);
#pragma unroll
                for (int i = 0; i < 16; ++i) acc[i] += w0 * vf[i] + w1 * vf[16 + i]; }
        }
        const float* mb = mod + (t >> 13) * 6144; float x1[16], v[16], sum = 0.f;
        unpack8(*(const u32x4*)((const bf16_t*)(p.ws + OFF_X1) + (size_t)t * 1024 + c0), *(float(*)[8])&x1[0]); unpack8(*(const u32x4*)((const bf16_t*)(p.ws + OFF_X1) + (size_t)t * 1024 + c0 + 8), *(float(*)[8])&x1[8]);
#pragma unroll
        for (int i = 0; i < 4; ++i) { const f32x4 g2 = *(const f32x4*)(mb + 5120 + c0 + 4 * i);
#pragma unroll
            for (int e = 0; e < 4; ++e) { const int k = 4 * i + e; v[k] = DN_ALPHA * x1[k] + (1.0f + g2[e]) * acc[k]; sum += v[k]; } }
#pragma unroll
        for (int o = 32; o > 0; o >>= 1) sum += __shfl_xor(sum, o);
        const float mu = sum * (1.0f / 1024.0f); float q = 0.f;
#pragma unroll
        for (int k = 0; k < 16; ++k) { const float dd = v[k] - mu; q += dd * dd; }
#pragma unroll
        for (int o = 32; o > 0; o >>= 1) q += __shfl_xor(q, o);
        const float rstd = 1.0f / sqrtf(q * (1.0f / 1024.0f) + 1e-6f);
#pragma unroll
        for (int i = 0; i < 4; ++i) { const f32x4 lg = *(const f32x4*)(p.ln2_g + c0 + 4 * i), lb = *(const f32x4*)(p.ln2_b + c0 + 4 * i); f32x4 o;
#pragma unroll
            for (int e = 0; e < 4; ++e) o[e] = (v[4 * i + e] - mu) * rstd * lg[e] + lb[e];
            *(f32x4*)(p.out + (size_t)t * 1024 + c0 + 4 * i) = o; }
    }
}

__device__ __forceinline__ void phase_p9p10(const P& p, char* lds) {
    const int tid = otid();
    const float* scu = (const float*)(p.ws + OFF_SCU); const float* scu4 = (const float*)(p.ws + OFF_SCU4); const float* scv = (const float*)(p.ws + OFF_SCV);

    const int w = __builtin_amdgcn_readfirstlane(tid >> 6);
    const float* mod = (const float*)(p.ws + OFF_MOD);
    const __amdgpu_buffer_rsrc_t ru = __builtin_amdgcn_make_buffer_rsrc((void*)(p.ws + OFF_TU8), 0, 16384 * 768, 0x00020000), rv = __builtin_amdgcn_make_buffer_rsrc((void*)(p.ws + OFF_TV8), 0, 16384 * 512, 0x00020000), ru4 = __builtin_amdgcn_make_buffer_rsrc((void*)(p.ws + OFF_TU4), 0, 16384 * 512, 0x00020000), ruv = __builtin_amdgcn_make_buffer_rsrc((void*)(p.ws + OFF_TV8), 0, 16384 * 1024, 0x00020000);
    const int nb = (T / 64 - (int)blockIdx.x + (int)gridDim.x - 1) / (int)gridDim.x;
    volatile PG8_LAS unsigned* qcnt = (volatile PG8_LAS unsigned*)(lds + 131072 + 64);
    if (tid == 0) { qcnt[0] = 0u; qcnt[1] = 0u; }
#pragma unroll 1
    for (int st = 0; st <= nb; ++st) {
      if (st == 0 || w == 7) {
        if (st >= 1 && (int)__builtin_amdgcn_mbcnt_hi(~0u, __builtin_amdgcn_mbcnt_lo(~0u, 0u)) == 0) qcnt[(st + 1) & 1] = 0u;
        if (st < nb) {
        const int tb = (int)blockIdx.x + st * (int)gridDim.x; char* ldb = lds + (st & 1) * 65536;
        const int h0 = st == 0 ? w : 0, h1 = st == 0 ? w + 1 : 8;
#pragma unroll 1
        for (int hh = h0; hh < h1; ++hh) {
        int lane_o = (int)__builtin_amdgcn_mbcnt_hi(~0u, __builtin_amdgcn_mbcnt_lo(~0u, 0u)); asm volatile("" : "+v"(lane_o));
        const bf16_t* sp = (const bf16_t*)p.out + (((size_t)tb * 8 + hh) * 32 * 64 + lane_o) * 8;
        float A[16], B[16], TL[16];
        topk128(sp, A); topk128(sp + (size_t)16 * 512, B);
#pragma unroll
        for (int j = 0; j < 16; ++j) TL[j] = -INFINITY;
#pragma unroll
        for (int i = 0; i < 16; ++i)
#pragma unroll
            for (int j = 0; j < 16; ++j) if ((i + 1) * (j + 1) <= 16) {
                const unsigned ua = __float_as_uint(A[i]), ub = __float_as_uint(B[j]);
                const float sum = __uint_as_float(ua & 0xffffff80u) + __uint_as_float(ub & 0xffffff80u);
                const float key = __uint_as_float((__float_as_uint(sum) & 0xffffc000u) | ((ua & 127u) << 7) | (ub & 127u));
                FK_INS16(TL, key) }
        float e[16], den = 0.f; const float m0 = __uint_as_float(__float_as_uint(TL[0]) & 0xffffc000u);
#pragma unroll
        for (int j = 0; j < 16; ++j) { e[j] = __builtin_amdgcn_exp2f((__uint_as_float(__float_as_uint(TL[j]) & 0xffffc000u) - m0) * 1.4426950408889634f); den += e[j]; }
        const float rden = 1.0f / den;
        PG8_LAS unsigned long long* pk = (PG8_LAS unsigned long long*)ldb + (lane_o * 8 + hh) * 16;
#pragma unroll
        for (int j = 0; j < 16; j += 2) { const unsigned id0 = __float_as_uint(TL[j]) & 0x3fffu, id1 = __float_as_uint(TL[j + 1]) & 0x3fffu;
            const float su0 = scu4[id0], su1 = scu4[id1], gv0 = e[j] * rden * scv[id0], gv1 = e[j + 1] * rden * scv[id1];
            u32x4 w; w.x = id0 | (cvt_pk_bf16(su0, 0.f) << 16); w.y = __float_as_uint(gv0); w.z = id1 | (cvt_pk_bf16(su1, 0.f) << 16); w.w = __float_as_uint(gv1);
            *(PG8_LAS u32x4*)(pk + j) = w; }
        }
            asm volatile("s_waitcnt lgkmcnt(0)" ::: "memory");
        }
      } else {
        const int tb = (int)blockIdx.x + (st - 1) * (int)gridDim.x; const char* ldb = lds + ((st - 1) & 1) * 65536;
        if (w & 1) __builtin_amdgcn_s_setprio(2); else __builtin_amdgcn_s_setprio(1);
        for (;;) { int c0 = (int)__builtin_amdgcn_mbcnt_hi(~0u, __builtin_amdgcn_mbcnt_lo(~0u, 0u)) * 16; asm volatile("" : "+v"(c0)); unsigned tk = 0u; if (c0 == 0) tk = __hip_atomic_fetch_add((PG8_LAS unsigned*)(lds + 131072 + 64) + (st & 1), 1u, __ATOMIC_RELAXED, __HIP_MEMORY_SCOPE_WORKGROUP);
            const int tl = __builtin_amdgcn_readfirstlane((int)tk); if (tl >= 64) break; const int t = tb * 64 + tl;
        const int jl = ((c0 >> 9) & 1) * 8 + ((c0 >> 8) & 1) * 4 + ((c0 >> 7) & 1) * 2 + ((c0 >> 6) & 1);
        typedef int i32x8 __attribute__((ext_vector_type(8)));
        const int ln = c0 >> 4, nn = ln & 15, cch = ln >> 4, jpar = nn & 1, e8 = nn >> 1;
        float acc[16]; float hinv; i32x8 Bq[4];
        {
            const bf16_t* hp = (const bf16_t*)(p.ws + OFF_H2) + (size_t)t * 1024 + 128 * jpar + 16 * cch;
            u32x4 hr[16];
#pragma unroll
            for (int q = 0; q < 4; ++q) { hr[4 * q] = *(const u32x4*)(hp + 256 * q); hr[4 * q + 1] = *(const u32x4*)(hp + 256 * q + 8); hr[4 * q + 2] = *(const u32x4*)(hp + 256 * q + 64); hr[4 * q + 3] = *(const u32x4*)(hp + 256 * q + 72); }
            unsigned mx = 0u;
#pragma unroll
            for (int i = 0; i < 16; ++i)
#pragma unroll
                for (int d = 0; d < 4; ++d) { const unsigned wv = hr[i][d]; mx = max(mx, (wv << 16) & 0x7fff0000u); mx = max(mx, wv & 0x7fff0000u); }
            float am = __uint_as_float(mx);
            am = fmaxf(am, __uint_as_float((unsigned)__builtin_amdgcn_ds_swizzle((int)__float_as_uint(am), (1 << 10) | 0x1f))); am = fmaxf(am, __uint_as_float((unsigned)__builtin_amdgcn_ds_swizzle((int)__float_as_uint(am), (16 << 10) | 0x1f)));
            { const auto r2 = __builtin_amdgcn_permlane32_swap(__float_as_uint(am), __float_as_uint(am), false, false); am = fmaxf(__uint_as_float(r2[0]), __uint_as_float(r2[1])); }
            const unsigned E = (__float_as_uint(am) >> 23) & 0xffu; const bool okE = E >= 8u && E <= 250u;
            const float hsc = okE ? __uint_as_float((261u - E) << 23) : 1.0f; hinv = okE ? __uint_as_float((E - 7u) << 23) : 1.0f;
#pragma unroll
            for (int q = 0; q < 4; ++q) { float hf[32];
                unpack8(hr[4 * q], *(float(*)[8])&hf[0]); unpack8(hr[4 * q + 1], *(float(*)[8])&hf[8]); unpack8(hr[4 * q + 2], *(float(*)[8])&hf[16]); unpack8(hr[4 * q + 3], *(float(*)[8])&hf[24]);
#pragma unroll
                for (int d4 = 0; d4 < 8; ++d4) { int p_ = __builtin_amdgcn_cvt_pk_fp8_f32(hf[4 * d4] * hsc, hf[4 * d4 + 1] * hsc, 0, false); p_ = __builtin_amdgcn_cvt_pk_fp8_f32(hf[4 * d4 + 2] * hsc, hf[4 * d4 + 3] * hsc, p_, true); Bq[q][d4] = p_; } } }
#pragma unroll
        for (int i = 0; i < 16; ++i) acc[i] = 0.f;
        const PG8_LAS unsigned long long* pk = (const PG8_LAS unsigned long long*)ldb + tl * 128;
#pragma unroll 1
        for (int h = 0; h < 8; ++h) {
            const unsigned idu0 = (unsigned)pk[h * 16 + e8] & 0x3fffu, idu1 = (unsigned)pk[h * 16 + 8 + e8] & 0x3fffu;
            const unsigned lo = (unsigned)((4 * jpar + cch) * 16);
            u32x4 ua[2][4];
#pragma unroll
            for (int q = 0; q < 4; ++q) { ua[0][q] = __builtin_amdgcn_raw_buffer_load_b128(ru4, idu0 * 512u + lo, (unsigned)q * 128u, 0); ua[1][q] = __builtin_amdgcn_raw_buffer_load_b128(ru4, idu1 * 512u + lo, (unsigned)q * 128u, 0); }
            unsigned ids[16];
#pragma unroll
            for (int j = 0; j < 16; ++j) ids[j] = (unsigned)__builtin_amdgcn_readfirstlane((int)(unsigned)pk[h * 16 + j]) & 0x3fffu;
            u32x2 vr[16];
#pragma unroll
            for (int j = 0; j < 16; ++j) vr[j] = __builtin_amdgcn_raw_buffer_load_b64(rv, (unsigned)c0 >> 1, ids[j] * 512u, 0);
            const u32x4 en0 = *(const PG8_LAS u32x4*)(pk + h * 16 + 2 * cch), en1 = *(const PG8_LAS u32x4*)(pk + h * 16 + 8 + 2 * cch);
            float wg[2][2];
#pragma unroll
            for (int G = 0; G < 2; ++G) { f32x4 cm = {0.f, 0.f, 0.f, 0.f};
#pragma unroll
                for (int q = 0; q < 4; ++q) { i32x8 A; A[0] = (int)ua[G][q].x; A[1] = (int)ua[G][q].y; A[2] = (int)ua[G][q].z; A[3] = (int)ua[G][q].w; A[4] = 0; A[5] = 0; A[6] = 0; A[7] = 0;
                    cm = __builtin_amdgcn_mfma_scale_f32_16x16x128_f8f6f4(A, Bq[q], cm, 4, 0, 0, 0x7f7f7f7f, 0, 0x7f7f7f7f); }
                const float x0 = jpar ? cm[1] : cm[0], x1 = jpar ? cm[3] : cm[2];
                const float t0 = x0 + __uint_as_float((unsigned)__builtin_amdgcn_ds_swizzle((int)__float_as_uint(x0), (1 << 10) | 0x1f)), t1 = x1 + __uint_as_float((unsigned)__builtin_amdgcn_ds_swizzle((int)__float_as_uint(x1), (1 << 10) | 0x1f));
                const u32x4 en = G ? en1 : en0;
                wg[G][0] = __uint_as_float(en.y) * gelu_fast(t0 * (__uint_as_float(en.x & 0xffff0000u) * hinv)); wg[G][1] = __uint_as_float(en.w) * gelu_fast(t1 * (__uint_as_float(en.z & 0xffff0000u) * hinv)); }
#pragma unroll
            for (int j = 0; j < 16; ++j) {
                const float wj = __uint_as_float((unsigned)__builtin_amdgcn_readlane((int)__float_as_uint(wg[j >> 3][j & 1]), ((j & 7) >> 1) * 16));
#define FK_AX4(B4) { const auto lo2 = __builtin_amdgcn_cvt_scalef32_pk_f32_fp4(vr[j].x, 1.0f, B4), hi2 = __builtin_amdgcn_cvt_scalef32_pk_f32_fp4(vr[j].y, 1.0f, B4); \
                    acc[2 * B4] += wj * lo2[0]; acc[2 * B4 + 1] += wj * lo2[1]; acc[8 + 2 * B4] += wj * hi2[0]; acc[8 + 2 * B4 + 1] += wj * hi2[1]; }
                FK_AX4(0) FK_AX4(1) FK_AX4(2) FK_AX4(3)
#undef FK_AX4
            }
        }
        const float* mb = mod + (t >> 13) * 6144; float x1[16], v[16], sum = 0.f;
        unpack8(*(const u32x4*)((const bf16_t*)(p.ws + OFF_X1) + (size_t)t * 1024 + c0), *(float(*)[8])&x1[0]); unpack8(*(const u32x4*)((const bf16_t*)(p.ws + OFF_X1) + (size_t)t * 1024 + c0 + 8), *(float(*)[8])&x1[8]);
#pragma unroll
        for (int i = 0; i < 4; ++i) { const f32x4 g2 = *(const f32x4*)(mb + 5120 + c0 + 4 * i);
#pragma unroll
            for (int e = 0; e < 4; ++e) { const int k = 4 * i + e; v[k] = DN_ALPHA * x1[k] + (1.0f + g2[e]) * acc[k]; sum += v[k]; } }
#pragma unroll
        for (int o = 32; o > 0; o >>= 1) sum += __shfl_xor(sum, o);
        const float mu = sum * (1.0f / 1024.0f); float q = 0.f;
#pragma unroll
        for (int k = 0; k < 16; ++k) { const float dd = v[k] - mu; q += dd * dd; }
#pragma unroll
        for (int o = 32; o > 0; o >>= 1) q += __shfl_xor(q, o);
        const float rstd = 1.0f / sqrtf(q * (1.0f / 1024.0f) + 1e-6f);
#pragma unroll
        for (int i = 0; i < 4; ++i) { const f32x4 lg = *(const f32x4*)(p.ln2_g + c0 + 4 * i), lb = *(const f32x4*)(p.ln2_b + c0 + 4 * i); f32x4 o;
#pragma unroll
            for (int e = 0; e < 4; ++e) o[e] = (v[4 * i + e] - mu) * rstd * lg[e] + lb[e];
            *(f32x4*)(p.out + (size_t)t * 1024 + c0 + 4 * i) = o; }
    }
        __builtin_amdgcn_s_setprio(0);
      }
      __syncthreads();
    }
}

template <int PH> __global__ __launch_bounds__(512, 2) void k_phase(P p) {
    extern __shared__ __attribute__((aligned(16))) char lds[];
    if constexpr (PH == 0) phase_p0a(p, lds);
    if constexpr (PH == 1) phase_p0b(p, lds);
    if constexpr (PH == 2) phase_p1(p, lds);
    if constexpr (PH == 3) phase_p2(p, lds);
    if constexpr (PH == 4) phase_p3(p, lds);
    if constexpr (PH == 5) phase_p0c(p, lds);
    if constexpr (PH == 6) phase_p4(p, lds);
    if constexpr (PH == 7) phase_p5(p, lds);
    if constexpr (PH == 8) phase_p0d(p, lds);
    if constexpr (PH == 9) phase_p6(p, lds);
    if constexpr (PH == 10) phase_p7(p, lds);
    if constexpr (PH == 11) phase_p8(p, lds);
    if constexpr (PH == 12) phase_p9(p, lds);
    if constexpr (PH == 13) phase_p10(p, lds);
}
template <int PH> static void launch_phase(const P& p, hipStream_t st) {
    static bool init = false;
    if (!init) { (void)hipFuncSetAttribute((const void*)k_phase<PH>, hipFuncAttributeMaxDynamicSharedMemorySize, LDS_BYTES); init = true; }
    hipLaunchKernelGGL(k_phase<PH>, dim3(256), dim3(NTHR), LDS_BYTES, st, p);
}
__global__ void k_adapt_proj(const char* ws, int b, float* proj) {
    const size_t idx = (size_t)blockIdx.x * 256 + threadIdx.x; if (idx >= (size_t)SEQ * 1184) return;
    const int tl = (int)(idx / 1184), c = (int)(idx % 1184), t = b * SEQ + tl;
    bf16_t v;
    if (c < 512) v = ((const bf16_t*)(ws + OFF_UG))[((size_t)(c >> 4) * 1024 + (t >> 6)) * 1152 + (t & 63) * 16 + (c & 15)];
    else if (c < 896) v = ((const bf16_t*)(ws + OFF_CQ))[(size_t)t * 384 + c - 512];
    else if (c < 1152) v = ((const bf16_t*)(ws + OFF_CKV))[(size_t)t * 256 + c - 896];
    else { const int i = c - 1152; v = ((const bf16_t*)(ws + OFF_KIMG))[((((size_t)(b * 8 + 0) * 128 + (tl >> 6)) * 12 + 8 + (i >> 3)) * 64 + (tl & 63)) * 8 + (i & 7)]; }
    proj[idx] = bf2f(v);
}
__global__ void k_adapt_ymla(const char* ws, int b, float* ymla) {
    const size_t idx = (size_t)blockIdx.x * 256 + threadIdx.x; if (idx >= (size_t)SEQ * 512) return;
    ymla[idx] = bf2f(((const bf16_t*)(ws + OFF_YMLA))[(size_t)b * SEQ * 512 + idx]);
}
__global__ void k_adapt_ys5(const char* ws, int b, float* ys5) {
    const size_t idx = (size_t)blockIdx.x * 256 + threadIdx.x; if (idx >= (size_t)SEQ * 512) return;
    ys5[idx] = bf2f(((const bf16_t*)(ws + OFF_YS5))[(size_t)b * SEQ * 512 + idx]);
}
__global__ void k_adapt_x1(const char* ws, int b, float* x1) {
    const size_t idx = (size_t)blockIdx.x * 256 + threadIdx.x; if (idx >= (size_t)SEQ * 1024) return;
    x1[idx] = bf2f(((const bf16_t*)(ws + OFF_X1))[(size_t)b * SEQ * 1024 + idx]);
}
}

namespace fk {
__global__ void __launch_bounds__(512, 2) mk_fwd(P p, unsigned* barw) {
    extern __shared__ __attribute__((aligned(16))) char lds[];
    if (threadIdx.x == 0) *(uint4*)(lds + 131072) = make_uint4(0u, 0u, 0u, 0u);
    if ((threadIdx.x & 63) == 0) wgt_file((int)(threadIdx.x >> 6));
    __syncthreads();
    XcdBarrier bar = xcd_barrier_post(barw, (volatile LAS unsigned*)(lds + 131072));
#define MK_PHASE(fn) { fn(p, lds); }
    MK_PHASE(phase_g1)
    xcd_barrier(bar);
    MK_PHASE(phase_g2)
    xcd_barrier(bar);
    MK_PHASE(phase_p1)
    xcd_barrier(bar);
    MK_PHASE(phase_p2)
    xcd_barrier(bar);
    MK_PHASE(phase_p3)
    xcd_barrier(bar);
    MK_PHASE(phase_p4)
    xcd_barrier(bar);
    MK_PHASE(phase_p5)
    xcd_barrier(bar);
    MK_PHASE(phase_p6)
    xcd_barrier(bar);
    MK_PHASE(phase_p7)
    xcd_barrier(bar);
    MK_PHASE(phase_p8)
    xcd_barrier(bar);
    MK_PHASE(phase_p9p10)
#undef MK_PHASE
}
}

extern "C" void kernel_launch(void* const* d_in, const int* in_sizes, int n_in, void* d_out, int out_size, void* d_ws, size_t ws_size, hipStream_t stream) {
    fk::P p{};
    p.x = (const float*)d_in[0]; p.c = (const float*)d_in[1]; p.pos = (const int*)d_in[2]; p.w_ada = (const float*)d_in[3]; p.b_ada = (const float*)d_in[4]; p.w_in = (const float*)d_in[5];
    p.lam_re = (const float*)d_in[6]; p.lam_im = (const float*)d_in[7]; p.log_dt = (const float*)d_in[8]; p.b_re = (const float*)d_in[9]; p.b_im = (const float*)d_in[10];
    p.c_re = (const float*)d_in[11]; p.c_im = (const float*)d_in[12]; p.s5_d = (const float*)d_in[13]; p.w_glu = (const float*)d_in[14]; p.b_glu = (const float*)d_in[15];
    p.q_norm = (const float*)d_in[16]; p.w_uq = (const float*)d_in[17]; p.kv_norm = (const float*)d_in[18]; p.w_ukv = (const float*)d_in[19]; p.gn_s5 = (const float*)d_in[20];
    p.gn_mla = (const float*)d_in[21]; p.w_out = (const float*)d_in[22]; p.ln1_g = (const float*)d_in[23]; p.ln1_b = (const float*)d_in[24]; p.w_query = (const float*)d_in[25];
    p.keys1 = (const float*)d_in[26]; p.keys2 = (const float*)d_in[27]; p.pu = (const float*)d_in[28]; p.pv = (const float*)d_in[29]; p.ln2_g = (const float*)d_in[30]; p.ln2_b = (const float*)d_in[31];
    p.out = (float*)d_out; p.ws = (char*)d_ws;
    static int grid = 0;
    if (!grid) {
        int dev = 0, cus = 0, per_cu = 0;
        (void)hipGetDevice(&dev);
        (void)hipDeviceGetAttribute(&cus, hipDeviceAttributeMultiprocessorCount, dev);
        (void)hipFuncSetAttribute((const void*)fk::mk_fwd, hipFuncAttributeMaxDynamicSharedMemorySize, fk::LDS_BYTES);
        (void)hipOccupancyMaxActiveBlocksPerMultiprocessor(&per_cu, fk::mk_fwd, fk::NTHR, fk::LDS_BYTES);
        grid = cus > 0 ? cus : 256;
        if (per_cu < 1) fprintf(stderr, "kernel_launch: occupancy query reports %d workgroups per CU\n", per_cu);
    }
    (void)hipMemsetAsync(d_ws, 0, fk::SZ_BAR, stream);
    hipLaunchKernelGGL(fk::mk_fwd, dim3(grid), dim3(fk::NTHR), fk::LDS_BYTES, stream, p, (unsigned*)d_ws);
}
```

```cpp
#include <hip/hip_runtime.h>
#include <hip/hip_bf16.h>
#include <stdint.h>
#include <stdio.h>
#define XB_TMO      128
#define XB_XCNT(j)  (256  + 64 * (j))
#define XB_XSUB(j)  (1280 + 64 * (j))
#define XB_XGEN(j)  (2304 + 64 * (j))
#define XB_TOP      3328
#define XB_TOPGEN   3392
#define XCD_BAR_WORDS 3456
#define XB_SPIN_CAP (1u << 22)
#define LAS __attribute__((address_space(3)))

__device__ __forceinline__ unsigned xb_ld(unsigned* p)              { return __hip_atomic_load(p, __ATOMIC_RELAXED, __HIP_MEMORY_SCOPE_AGENT); }
__device__ __forceinline__ unsigned xb_add(unsigned* p, unsigned v) { return __hip_atomic_fetch_add(p, v, __ATOMIC_RELAXED, __HIP_MEMORY_SCOPE_AGENT); }
#define WGT_LDS_OFF (131072 + 256)
__device__ __forceinline__ unsigned wgt_hw_slot() { return (unsigned)__builtin_amdgcn_s_getreg((5 << 11) | 4) & 63u; }
__device__ __forceinline__ void wgt_file(int wave_index) { ((volatile LAS int*)(unsigned)WGT_LDS_OFF)[wgt_hw_slot()] = wave_index; }
__device__ __forceinline__ int wgt_tid() {
    const int wv = __builtin_amdgcn_readfirstlane(((volatile LAS int*)(unsigned)WGT_LDS_OFF)[wgt_hw_slot()]);
    unsigned z = 0u; asm volatile("" : "+v"(z));
    return wv * 64 + (int)__builtin_amdgcn_mbcnt_hi(~0u, __builtin_amdgcn_mbcnt_lo(~0u, z));
}
__device__ __forceinline__ unsigned xb_xcc_id() { return (unsigned)__builtin_amdgcn_s_getreg((3 << 11) | 20) & 0xFu; }
#define XB_SPIN(cond, bar) do { unsigned _sp = 0; while (cond) { __builtin_amdgcn_s_sleep(1); \
    if ((++_sp & 255u) == 0u) { if (xb_ld(&(bar)[XB_TMO])) break; if (_sp > XB_SPIN_CAP) { atomicAdd(&(bar)[XB_TMO], 1u); break; } } } } while (0)

struct XcdBarrier {
    unsigned* bar; unsigned x;
    volatile LAS unsigned* st;
};

__device__ __forceinline__ XcdBarrier xcd_barrier_post(unsigned* bar, volatile LAS unsigned* st) {
    XcdBarrier b; b.bar = bar; b.x = xb_xcc_id(); b.st = st;
    if (wgt_tid() == 0) (void)xb_add(&bar[XB_XCNT(b.x)], 1u);
    return b;
}
__device__ __forceinline__ void xcd_barrier_complete(unsigned* bar, unsigned x, unsigned& nloc, unsigned& nx) {
    const unsigned G = gridDim.x * gridDim.y * gridDim.z;
    unsigned sum, cnt, mine, sp = 0u;
    for (;;) {
        sum = 0u; cnt = 0u; mine = 0u;
#pragma unroll
        for (unsigned j = 0; j < 16; ++j) { const unsigned c = xb_ld(&bar[XB_XCNT(j)]); sum += c; cnt += (c > 0u) ? 1u : 0u; mine = (j == x) ? c : mine; }
        if (sum == G) break;
        __builtin_amdgcn_s_sleep(1);
        if ((++sp & 255u) == 0u) { if (xb_ld(&bar[XB_TMO])) break; if (sp > XB_SPIN_CAP) { atomicAdd(&bar[XB_TMO], 1u); break; } }
    }
    nloc = mine > 0u ? mine : 1u; nx = cnt > 0u ? cnt : 1u;
}

__device__ __forceinline__ void xcd_barrier(const XcdBarrier& b) {
    asm volatile("s_waitcnt vmcnt(0)" ::: "memory");
    __syncthreads();
    if (wgt_tid() == 0) {
        unsigned* bar = b.bar;
        __builtin_amdgcn_s_waitcnt(0);
        unsigned nloc = b.st[0], nx = b.st[1];
        if (nloc == 0u) { xcd_barrier_complete(bar, b.x, nloc, nx); b.st[0] = nloc; b.st[1] = nx; }
        const unsigned old = xb_add(&bar[XB_XSUB(b.x)], 1u);
        const unsigned gen = old / nloc;
        if (old + 1u == (gen + 1u) * nloc) {
            __builtin_amdgcn_fence(__ATOMIC_RELEASE, "agent");
            asm volatile("s_waitcnt vmcnt(0)" ::: "memory");
            const unsigned og = xb_add(&bar[XB_TOP], 1u);
            const unsigned tg = og / nx;
            if (og + 1u == (tg + 1u) * nx) xb_add(&bar[XB_TOPGEN], 1u);
            else XB_SPIN(xb_ld(&bar[XB_TOPGEN]) == tg, bar);
            __builtin_amdgcn_fence(__ATOMIC_ACQUIRE, "agent");
            xb_add(&bar[XB_XGEN(b.x)], 1u);
            asm volatile("s_waitcnt vmcnt(0)" ::: "memory");
        } else {
            XB_SPIN(xb_ld(&bar[XB_XGEN(b.x)]) == gen, bar);
            __builtin_amdgcn_fence(__ATOMIC_ACQUIRE, "agent");
            asm volatile("s_waitcnt vmcnt(0)" ::: "memory");
        }
    }
    __syncthreads();
}


namespace pg8 {
#define PG8_LAS __attribute__((address_space(3)))
typedef unsigned short bf16_t;
typedef short bf16x8 __attribute__((ext_vector_type(8)));
typedef float f32x4 __attribute__((ext_vector_type(4)));
typedef unsigned u32x4 __attribute__((ext_vector_type(4)));
constexpr int BM = 256, BK = 64, HALF = 128, HTB = HALF * BK * 2  , STAGE_BYTES = 8 * HTB, NXCD = 8, WGM = 8;

__host__ __device__ __forceinline__ int lds_byte(int r, int c) { const int st = (r >> 4) * 2 + (c >> 5), rr = r & 15, cc = c & 31, ob = rr * 64 + cc * 2; return st * 1024 + (ob ^ (((ob >> 9) & 1) << 5)); }
__host__ __device__ __forceinline__ void stage_rc(int b, int& R, int& C) { const int st = b / 1024, sb = b % 1024, swz = sb ^ (((sb >> 9) & 1) << 5); R = (st >> 1) * 16 + swz / 64; C = (st & 1) * 32 + (swz % 64) / 2; }
__host__ __device__ __forceinline__ int perm32(int rho) { const int n = rho >> 4, i = rho & 15; return 8 * (i >> 2) + 4 * n + (i & 3); }

struct Unit { int pm, pn, pz; const char* a; const char* b; int nt; };
struct Gemm { int K, lda, ldb; };

struct StaticOrder {
    int nM, nN, nwg, G, c;
    __host__ __device__ void init(int M, int N, int G_, int c_) { nM = M / BM; nN = N / BM; nwg = nM * nN; G = G_; c = c_; }
    __host__ __device__ bool next(int i, Unit& u) const {
        const long L = (long)i * G + c; if (L >= nwg) return false;
        int wgid = (int)L; { const int q = nwg / NXCD, r = nwg % NXCD, xcd = wgid % NXCD, off = wgid / NXCD; wgid = (xcd < r ? xcd * (q + 1) : r * (q + 1) + (xcd - r) * q) + off; }
        const int nig = WGM * nN, gid = wgid / nig, fm = gid * WGM, gsz = (nM - fm) < WGM ? (nM - fm) : WGM;
        u.pm = fm + ((wgid % nig) % gsz); u.pn = (wgid % nig) / gsz; return true;
    }
    __device__ __forceinline__ void a_ready(const Unit&) const {}
    __device__ __forceinline__ void done(const Unit&) const {}
};
__device__ __forceinline__ unsigned cvt_pk_bf16(float lo, float hi) { unsigned r; asm volatile("v_cvt_pk_bf16_f32 %0, %1, %2" : "=v"(r) : "v"(lo), "v"(hi)); return r; }
typedef float f32x2 __attribute__((ext_vector_type(2)));
__device__ __forceinline__ f32x2 gelu_pk(f32x2 v) {
    const f32x2 av = __builtin_elementwise_abs(v), d = av * 0.2316418882f + 1.0f;
    f32x2 t; t.x = __builtin_amdgcn_rcpf(d.x); t.y = __builtin_amdgcn_rcpf(d.y);
    f32x2 q = t * 0.5307027145f + (-0.7265760135f); q = q * t + 0.7107068705f; q = q * t + (-0.142248368f); q = q * t + 0.127414796f; q = q * t;
    const f32x2 s = (v * v) * (-0.72134752044f);
    f32x2 e; e.x = __builtin_amdgcn_exp2f(s.x); e.y = __builtin_amdgcn_exp2f(s.y);
    const f32x2 m = v * (q * e), r = v - m;
    f32x2 o; o.x = v.x < 0.f ? m.x : r.x; o.y = v.y < 0.f ? m.y : r.y; return o;
}

struct EpiF32 {
    static constexpr bool PERM = false, AFTER_DRAIN = false;
    float* C; int ldc; const float* bias;
    __device__ __forceinline__ void operator()(const f32x4 (&acc)[2][2][4][2], const Unit& u, int wr, int wc, int fr, int fq) const {
        const int row0 = u.pm * BM + wr * 64 + fr, col0 = u.pn * BM + wc * 32 + 4 * fq;
        f32x4 bv[2][2];
#pragma unroll
        for (int bj = 0; bj < 2; ++bj)
#pragma unroll
            for (int n = 0; n < 2; ++n) bv[bj][n] = bias ? *(const f32x4*)(bias + col0 + bj * HALF + n * 16) : (f32x4){0.f, 0.f, 0.f, 0.f};
#pragma unroll
        for (int ai = 0; ai < 2; ++ai)
#pragma unroll
            for (int m = 0; m < 4; ++m) { float* rowp = C + (size_t)(row0 + ai * HALF + m * 16) * ldc + col0;
#pragma unroll
                for (int bj = 0; bj < 2; ++bj)
#pragma unroll
                    for (int n = 0; n < 2; ++n) *(f32x4*)(rowp + bj * HALF + n * 16) = acc[ai][bj][m][n] + bv[bj][n]; }
    }
};
template <int ACT  > struct EpiBf16 {
    static constexpr bool PERM = true, AFTER_DRAIN = false;
    bf16_t* O; int ldc; const float* bias; int split_cols; size_t split_stride;
    __device__ __forceinline__ void operator()(const f32x4 (&acc)[2][2][4][2], const Unit& u, int wr, int wc, int fr, int fq) const {
        const int row0 = u.pm * BM + wr * 64 + fr; int colt = u.pn * BM; bf16_t* base = O;
        if (split_cols) { const int t = colt / split_cols; base += (size_t)t * split_stride; colt -= t * split_cols; }
        const int col0 = colt + wc * 32 + 8 * fq, bcol0 = u.pn * BM + wc * 32 + 8 * fq;
        f32x4 bv[2][2];
#pragma unroll
        for (int bj = 0; bj < 2; ++bj)
#pragma unroll
            for (int n = 0; n < 2; ++n) bv[bj][n] = bias ? *(const f32x4*)(bias + bcol0 + bj * HALF + 4 * n) : (f32x4){0.f, 0.f, 0.f, 0.f};
#pragma unroll
        for (int ai = 0; ai < 2; ++ai)
#pragma unroll
            for (int m = 0; m < 4; ++m) { bf16_t* rowp = base + (size_t)(row0 + ai * HALF + m * 16) * ldc + col0;
#pragma unroll
                for (int bj = 0; bj < 2; ++bj) { f32x4 v0 = acc[ai][bj][m][0] + bv[bj][0], v1 = acc[ai][bj][m][1] + bv[bj][1];
                    if (ACT == 1) { f32x2 a = gelu_pk((f32x2){v0[0], v0[1]}), b = gelu_pk((f32x2){v0[2], v0[3]}), c = gelu_pk((f32x2){v1[0], v1[1]}), d = gelu_pk((f32x2){v1[2], v1[3]});
                        v0 = (f32x4){a.x, a.y, b.x, b.y}; v1 = (f32x4){c.x, c.y, d.x, d.y}; }
                    if (ACT == 2) {
#pragma unroll
                        for (int j = 0; j < 4; ++j) { v0[j] = 0.5f * v0[j] * (1.0f + erff(v0[j] * 0.70710678f)); v1[j] = 0.5f * v1[j] * (1.0f + erff(v1[j] * 0.70710678f)); } }
                    u32x4 w; w.x = cvt_pk_bf16(v0[0], v0[1]); w.y = cvt_pk_bf16(v0[2], v0[3]); w.z = cvt_pk_bf16(v1[0], v1[1]); w.w = cvt_pk_bf16(v1[2], v1[3]);
                    *(u32x4*)(rowp + bj * HALF) = w; } }
    }
};

template <class Epi, class Sched, bool STAMP = false>
__device__ __forceinline__ void gemm_phase(PG8_LAS unsigned char* lds, const Gemm g, const Sched& S, const Epi& E, unsigned long long* stamps) {
    int tid_op = wgt_tid(); asm volatile("" : "+v"(tid_op));
    const int tid = tid_op, wid = __builtin_amdgcn_readfirstlane(tid >> 6), lane = tid & 63, wr = wid >> 2, wc = wid & 3, fr = lane & 15, fq = lane >> 4;
    int Kop = g.K; asm volatile("" : "+s"(Kop));
    const int K = Kop, nt = K / BK;
    int ts_lo = 0, ts_hi = 0, nts = 0; const unsigned long long rt_entry = STAMP ? (unsigned long long)wall_clock64() : 0ull;
#define PG8_STAMP() do { if (STAMP && wid == 0 && nts < 64) { const unsigned long long _c = (unsigned long long)clock64(); \
        ts_lo = (lane == nts) ? (int)(unsigned)_c : ts_lo; ts_hi = (lane == nts) ? (int)(unsigned)(_c >> 32) : ts_hi; ++nts; } } while (0)
    PG8_STAMP();
    unsigned voffA[2], voffB[2];
#pragma unroll
    for (int i = 0; i < 2; ++i) { int R, C; stage_rc(tid * 16 + i * 8192, R, C); const int Rb = Epi::PERM ? ((R & ~31) + perm32(R & 31)) : R;
        voffA[i] = (unsigned)(R * g.lda + C) * 2u; voffB[i] = (unsigned)(Rb * g.ldb + C) * 2u; }
    const size_t kstep = (size_t)(BK * 2);
    const size_t hstepA = (size_t)HALF * g.lda * 2, hstepB = (size_t)HALF * g.ldb * 2;
    const unsigned ldsw = (unsigned)wid * 1024u;
    const int aoff = lds_byte(wr * 64 + fr, fq * 8), boff = lds_byte(wc * 32 + fr, fq * 8);
#define PG8_SA(b, h) (((b) * 2 + (h)) * HTB)
#define PG8_SB(b, h) ((4 + (b) * 2 + (h)) * HTB)
#define PG8_STAGE(bufoff, gbase, voff) do { _Pragma("unroll") for (int _i = 0; _i < 2; ++_i) \
        __builtin_amdgcn_global_load_lds((const unsigned*)((const char*)(gbase) + (voff)[_i]), (PG8_LAS unsigned*)(lds + (bufoff) + ldsw + _i * 8192), 16, 0, 0); } while (0)
#define PG8_LDA(dst, b, h) do { _Pragma("unroll") for (int m = 0; m < 4; ++m) _Pragma("unroll") for (int k = 0; k < 2; ++k) dst[m][k] = *(const PG8_LAS bf16x8*)(lds + PG8_SA(b, h) + aoff + m * 2048 + k * 1024); } while (0)
#define PG8_LDB(dst, b, h) do { _Pragma("unroll") for (int n = 0; n < 2; ++n) _Pragma("unroll") for (int k = 0; k < 2; ++k) dst[n][k] = *(const PG8_LAS bf16x8*)(lds + PG8_SB(b, h) + boff + n * 2048 + k * 1024); } while (0)
#define PG8_MMA(ai, bj, At, Bt) do { __builtin_amdgcn_s_setprio(1); _Pragma("unroll") for (int m = 0; m < 4; ++m) _Pragma("unroll") for (int n = 0; n < 2; ++n) _Pragma("unroll") for (int k = 0; k < 2; ++k) \
        acc[ai][bj][m][n] = __builtin_amdgcn_mfma_f32_16x16x32_bf16(Bt[n][k], At[m][k], acc[ai][bj][m][n], 0, 0, 0); __builtin_amdgcn_s_setprio(0); } while (0)
#define PG8_WAIT_V(n) asm volatile("s_waitcnt vmcnt(" #n ")" ::: "memory")
#define PG8_WAIT_L(n) asm volatile("s_waitcnt lgkmcnt(" #n ")" ::: "memory")
#define PG8_BAR __builtin_amdgcn_s_barrier()
#define PG8_SCHED __builtin_amdgcn_sched_barrier(0)
    Unit cur, nxt; int ui = 0;
    if (!S.next(0, cur)) return;
    f32x4 acc[2][2][4][2];
#pragma unroll
    for (int a = 0; a < 2; ++a)
#pragma unroll
        for (int b = 0; b < 2; ++b)
#pragma unroll
            for (int m = 0; m < 4; ++m)
#pragma unroll
                for (int n = 0; n < 2; ++n) acc[a][b][m][n] = (f32x4){0.f, 0.f, 0.f, 0.f};
    bf16x8 At[4][2], B0[2][2], B1[2][2];
    const char* cA = cur.a; const char* cB = cur.b;
    S.a_ready(cur);
    PG8_STAGE(PG8_SB(0, 0), cB, voffB); PG8_STAGE(PG8_SA(0, 0), cA, voffA); PG8_STAGE(PG8_SB(0, 1), cB + hstepB, voffB); PG8_STAGE(PG8_SA(0, 1), cA + hstepA, voffA);
    if (wr == 1) PG8_BAR;
    PG8_WAIT_V(4); PG8_BAR;
    PG8_STAGE(PG8_SB(1, 0), cB + kstep, voffB); PG8_STAGE(PG8_SA(1, 0), cA + kstep, voffA); PG8_STAGE(PG8_SB(1, 1), cB + hstepB + kstep, voffB);
    PG8_WAIT_V(6); PG8_BAR;
    PG8_STAMP();
    for (;;) {
        const bool has_next = S.next(ui + 1, nxt);
        const char* nA = has_next ? nxt.a : cA; const char* nB = has_next ? nxt.b : cB;
        const int ntc = cur.nt > 0 ? cur.nt : nt;
        for (int t = 0; t < ntc; t += 2) {
            const bool last = (t == ntc - 2);
            const char* a1 = cA + (size_t)(t + 1) * kstep;
            const char* a2 = last ? nA : cA + (size_t)(t + 2) * kstep; const char* b2 = last ? nB : cB + (size_t)(t + 2) * kstep;
            const char* a3 = a2 + kstep; const char* b3 = b2 + kstep;
            if (last && has_next) S.a_ready(nxt);
            PG8_LDB(B0, 0, 0); PG8_SCHED; PG8_LDA(At, 0, 0); PG8_STAGE(PG8_SA(1, 1), a1 + hstepA, voffA);
            PG8_WAIT_L(8); PG8_BAR; PG8_WAIT_L(0); PG8_MMA(0, 0, At, B0); PG8_BAR; PG8_SCHED;
            PG8_LDB(B1, 0, 1); PG8_STAGE(PG8_SB(0, 0), b2, voffB);
            PG8_BAR; PG8_WAIT_L(0); PG8_MMA(0, 1, At, B1); PG8_BAR;
            PG8_LDA(At, 0, 1); PG8_STAGE(PG8_SA(0, 0), a2, voffA);
            PG8_BAR; PG8_WAIT_L(0); PG8_MMA(1, 0, At, B0); PG8_BAR; PG8_SCHED;
            PG8_STAGE(PG8_SB(0, 1), b2 + hstepB, voffB);
            PG8_WAIT_V(6); PG8_BAR; PG8_MMA(1, 1, At, B1); PG8_BAR;
            PG8_LDB(B0, 1, 0); PG8_SCHED; PG8_LDA(At, 1, 0); PG8_STAGE(PG8_SA(0, 1), a2 + hstepA, voffA);
            PG8_WAIT_L(8); PG8_BAR; PG8_WAIT_L(0); PG8_MMA(0, 0, At, B0); PG8_BAR; PG8_SCHED;
            PG8_LDB(B1, 1, 1); PG8_STAGE(PG8_SB(1, 0), b3, voffB);
            PG8_BAR; PG8_WAIT_L(0); PG8_MMA(0, 1, At, B1); PG8_BAR;
            PG8_LDA(At, 1, 1); PG8_STAGE(PG8_SA(1, 0), a3, voffA);
            PG8_BAR; PG8_WAIT_L(0); PG8_MMA(1, 0, At, B0); PG8_BAR; PG8_SCHED;
            PG8_STAGE(PG8_SB(1, 1), b3 + hstepB, voffB);
            PG8_WAIT_V(6); PG8_BAR; PG8_MMA(1, 1, At, B1); PG8_BAR;
        }
        PG8_STAMP();
        if constexpr (!Epi::AFTER_DRAIN) { E(acc, cur, wr, wc, fr, fq); S.done(cur); }
        PG8_STAMP();
        if (!has_next) break;
#pragma unroll
        for (int a = 0; a < 2; ++a)
#pragma unroll
            for (int b = 0; b < 2; ++b)
#pragma unroll
                for (int m = 0; m < 4; ++m)
#pragma unroll
                    for (int n = 0; n < 2; ++n) acc[a][b][m][n] = (f32x4){0.f, 0.f, 0.f, 0.f};
        cur = nxt; cA = nA; cB = nB; ++ui;
    }
    PG8_WAIT_V(0);
    if (wr == 0) PG8_BAR;
    PG8_BAR;
    if constexpr (Epi::AFTER_DRAIN) { E.fused(acc, cur, wr, wc, fr, fq, lds, wid, lane); S.done(cur); }
    PG8_STAMP();
    if (STAMP && wid == 0) { stamps[lane] = lane < nts ? (((unsigned long long)(unsigned)ts_hi << 32) | (unsigned)ts_lo) : 0ull;
        if (lane == 62) stamps[62] = rt_entry; if (lane == 63) stamps[63] = (unsigned long long)wall_clock64(); }
#undef PG8_STAMP
#undef PG8_SA
#undef PG8_SB
#undef PG8_STAGE
#undef PG8_LDA
#undef PG8_LDB
#undef PG8_MMA
#undef PG8_WAIT_V
#undef PG8_WAIT_L
#undef PG8_BAR
#undef PG8_SCHED
}
}

namespace fk {
using pg8::bf16_t; using pg8::f32x4; using pg8::u32x4; using pg8::Unit; using pg8::Gemm; using pg8::cvt_pk_bf16;
typedef unsigned u32x2 __attribute__((ext_vector_type(2)));
typedef float f32x2 __attribute__((ext_vector_type(2)));
typedef unsigned u32x3 __attribute__((ext_vector_type(3)));
typedef unsigned u32x6 __attribute__((ext_vector_type(6)));
typedef float f32x32 __attribute__((ext_vector_type(32)));
constexpr int T = 65536, DM = 1024, SEQ = 8192, NBATCH = 8, NTHR = 512;
constexpr int LDS_BYTES = 147456;

constexpr size_t al256(size_t x) { return (x + 255) / 256 * 256; }
constexpr size_t OFF_BAR = 0, SZ_BAR = 16384;
constexpr size_t OFF_MOD = OFF_BAR + SZ_BAR, SZ_MOD = 8 * 6144 * 4;
constexpr size_t OFF_CS = OFF_MOD + al256(SZ_MOD), SZ_CS = (size_t)T * 16 * 2 * 4;
constexpr size_t OFF_BT1 = OFF_CS + al256(SZ_CS), SZ_BT1 = 1280 * 1024 * 2;
constexpr size_t OFF_BTQ = OFF_BT1 + al256(SZ_BT1), SZ_BTQ = 768 * 384 * 2;
constexpr size_t OFF_BTK = OFF_BTQ + al256(SZ_BTQ), SZ_BTK = 512 * 256 * 2;
constexpr size_t OFF_ATV = OFF_BTK + al256(SZ_BTK), SZ_ATV = 512 * 256 * 2;
constexpr size_t OFF_BTG = OFF_ATV + al256(SZ_ATV), SZ_BTG = 512 * 512 * 2;
constexpr size_t OFF_BTO1 = OFF_BTG + al256(SZ_BTG), SZ_BTO = 1024 * 512 * 2;
constexpr size_t OFF_BTO2 = OFF_BTO1 + al256(SZ_BTO);
constexpr size_t OFF_WST = OFF_BTO2 + al256(SZ_BTO), SZ_WST = (size_t)2048 * 1024 * 2;
constexpr size_t OFF_WT = OFF_WST + al256(SZ_WST), SZ_WT = (size_t)32 * 1024 * 1152 * 2;
constexpr size_t OFF_WSS = OFF_WT + al256(SZ_WT), SZ_WSS = (size_t)64 * 256 * 512 * 2;
constexpr size_t OFF_A64 = OFF_WSS + al256(SZ_WSS), SZ_A64 = 32 * 64 * 2 * 4;
constexpr size_t OFF_TU8 = OFF_A64 + al256(SZ_A64), SZ_T8 = (size_t)16384 * 1024;
constexpr size_t OFF_TV8 = OFF_TU8 + al256(SZ_T8);
constexpr size_t OFF_SCU = OFF_TV8 + al256(SZ_T8), SZ_SC = 16384 * 4;
constexpr size_t OFF_SCV = OFF_SCU + al256(SZ_SC);
constexpr size_t OFF_TU4 = OFF_TV8 + (size_t)16384 * 512;
constexpr size_t OFF_SCU4 = OFF_SCV + al256(SZ_SC);
constexpr size_t OFF_APOW = OFF_SCU4 + al256(SZ_SC), SZ_APOW = (size_t)32 * 65 * 64 * 8;
constexpr size_t OFF_BBCC = OFF_APOW + al256(SZ_APOW), SZ_BBCC = (size_t)32 * 2048 * 8;
constexpr size_t OFF_KTAB = OFF_BBCC + al256(SZ_BBCC), SZ_KTAB = (size_t)32 * 16384 * 4;
constexpr size_t OFF_R1 = OFF_KTAB + al256(SZ_KTAB), SZ_R1 = (size_t)T * 1024 * 2;
constexpr size_t OFF_R2 = OFF_R1 + SZ_R1, SZ_R2 = (size_t)T * 1280;
constexpr size_t OFF_R3 = OFF_R2 + SZ_R2, SZ_R3 = (size_t)32 * 1024 * 1152 * 2;
constexpr size_t OFF_R4 = OFF_R3 + al256(SZ_R3), SZ_R4 = (size_t)T * 8 * 96 * 2;
constexpr size_t OFF_PQ = OFF_R4 + SZ_R4, SZ_PQ = (size_t)T * 12 * 4;
constexpr size_t OFF_PKV = OFF_PQ + SZ_PQ, SZ_PKV = (size_t)T * 8 * 4;
constexpr size_t OFF_PMLA = OFF_PKV + SZ_PKV, SZ_PMLA = (size_t)T * 8 * 4;
constexpr size_t OFF_PS5 = OFF_PMLA + SZ_PMLA, SZ_PS5 = (size_t)T * 16 * 4;
constexpr size_t OFF_R5 = OFF_PS5 + SZ_PS5, SZ_R5 = (size_t)T * 512 * 2;
constexpr size_t OFF_R6 = OFF_R5 + SZ_R5, SZ_R6 = (size_t)T * 1024 * 2;
constexpr size_t WS_FAST_END = OFF_R6 + SZ_R6;
constexpr size_t OFF_RQ = WS_FAST_END, OFF_RK = OFF_RQ + (size_t)T * 4;
constexpr size_t OFF_H1 = OFF_R1;
constexpr size_t OFF_CQ = OFF_R2, OFF_CKV = OFF_R2 + (size_t)T * 384 * 2;
constexpr size_t OFF_UG = OFF_R3, OFF_KIMG = OFF_R4, OFF_VIMG = OFF_R5;

struct P {
    const float *x, *c; const int* pos; const float *w_ada, *b_ada, *w_in, *lam_re, *lam_im, *log_dt, *b_re, *b_im, *c_re, *c_im, *s5_d, *w_glu, *b_glu, *q_norm, *w_uq, *kv_norm, *w_ukv,
        *gn_s5, *gn_mla, *w_out, *ln1_g, *ln1_b, *w_query, *keys1, *keys2, *pu, *pv, *ln2_g, *ln2_b;
    float* out; char* ws;
};
__device__ __forceinline__ int otid() { int t = wgt_tid(); asm volatile("" : "+v"(t)); return t; }
__device__ __forceinline__ float bf2f(bf16_t v) { return __uint_as_float(((unsigned)v) << 16); }
__device__ __forceinline__ u32x4 pack8(const f32x4 a, const f32x4 b) { u32x4 w; w.x = cvt_pk_bf16(a[0], a[1]); w.y = cvt_pk_bf16(a[2], a[3]); w.z = cvt_pk_bf16(b[0], b[1]); w.w = cvt_pk_bf16(b[2], b[3]); return w; }

template <class PT> struct OrderT {
    int nM, nN, nwg, G, c; PT pt;
    __device__ void init(int nM_, int nN_, int G_, int c_, const PT& pt_) { nM = nM_; nN = nN_; nwg = nM * nN; G = G_; c = c_; pt = pt_; }
    __device__ bool next(int i, Unit& u) const {
        const long L = (long)i * G + c; if (L >= nwg) return false;
        int wgid = (int)L; { const int q = nwg / pg8::NXCD, r = nwg % pg8::NXCD, xcd = wgid % pg8::NXCD, off = wgid / pg8::NXCD; wgid = (xcd < r ? xcd * (q + 1) : r * (q + 1) + (xcd - r) * q) + off; }
        const int nig = pg8::WGM * nN, gid = wgid / nig, fm = gid * pg8::WGM, gsz = (nM - fm) < pg8::WGM ? (nM - fm) : pg8::WGM;
        u.nt = 0; pt.fill(u, fm + ((wgid % nig) % gsz), (wgid % nig) / gsz); return true;
    }
    __device__ __forceinline__ void a_ready(const Unit&) const {}
    __device__ __forceinline__ void done(const Unit&) const {}
};

__device__ __forceinline__ void phase_p0a(const P& p, char* lds) {
    const int tid = otid(); const size_t gtid = (size_t)blockIdx.x * NTHR + tid, gstr = (size_t)gridDim.x * NTHR;
    float* mod = (float*)(p.ws + OFF_MOD);
    {
        float* sl = (float*)lds; float* red = sl + 8192;
        for (int i = tid; i < 8192; i += NTHR) { const float cv = p.c[i]; sl[i] = cv / (1.0f + expf(-cv)); }
        __syncthreads();
        for (int cb = blockIdx.x; cb < 256; cb += gridDim.x) {
            if (tid < 504) { const int ks = tid / 24, col = tid % 24, n = cb * 24 + col;
                float a0 = 0.f, a1 = 0.f, a2 = 0.f, a3 = 0.f, a4 = 0.f, a5 = 0.f, a6 = 0.f, a7 = 0.f;
                for (int k = ks; k < 1024; k += 21) { const float w = p.w_ada[(size_t)k * 6144 + n];
                    a0 += sl[k] * w; a1 += sl[1024 + k] * w; a2 += sl[2048 + k] * w; a3 += sl[3072 + k] * w; a4 += sl[4096 + k] * w; a5 += sl[5120 + k] * w; a6 += sl[6144 + k] * w; a7 += sl[7168 + k] * w; }
                float* r = red + ks * 24 + col; r[0] = a0; r[504] = a1; r[1008] = a2; r[1512] = a3; r[2016] = a4; r[2520] = a5; r[3024] = a6; r[3528] = a7; }
            __syncthreads();
            if (tid < 192) { const int b = tid / 24, col = tid % 24, n = cb * 24 + col; float s = p.b_ada[n];
                for (int ks = 0; ks < 21; ++ks) s += red[b * 504 + ks * 24 + col];
                mod[b * 6144 + n] = s; }
            __syncthreads();
        }
    }
    {
        float* cs = (float*)(p.ws + OFF_CS);
        for (size_t idx = gtid; idx < (size_t)T * 16; idx += gstr) { const int t = (int)(idx >> 4), i = (int)(idx & 15);
            const double ang = (double)p.pos[t] * exp(-9.210340371976184 * (double)i / 16.0);
            cs[idx * 2] = (float)cos(ang); cs[idx * 2 + 1] = (float)sin(ang); }
    }
    {
        bf16_t* bt = (bf16_t*)(p.ws + OFF_BT1);
        for (size_t idx = gtid; idx < (size_t)1280 * 1024 / 2; idx += gstr) { const int n = (int)(idx >> 9), k = (int)(idx & 511) * 2;
            const float v0 = n < 1184 ? p.w_in[(size_t)k * 1184 + n] : 0.f, v1 = n < 1184 ? p.w_in[(size_t)(k + 1) * 1184 + n] : 0.f;
            ((unsigned*)bt)[idx] = cvt_pk_bf16(v0, v1); }
    }
    {
        unsigned* btq = (unsigned*)(p.ws + OFF_BTQ); unsigned* btk = (unsigned*)(p.ws + OFF_BTK); unsigned* atv = (unsigned*)(p.ws + OFF_ATV);
        for (size_t idx = gtid; idx < (size_t)768 * 384 / 2; idx += gstr) { const int n = (int)(idx / 192), k = (int)(idx % 192) * 2;
            btq[idx] = cvt_pk_bf16(p.q_norm[k] * p.w_uq[(size_t)k * 768 + n], p.q_norm[k + 1] * p.w_uq[(size_t)(k + 1) * 768 + n]); }
        for (size_t idx = gtid; idx < (size_t)512 * 256 / 2; idx += gstr) { const int n = (int)(idx >> 7), k = (int)(idx & 127) * 2, col = (n >> 6) * 128 + (n & 63);
            btk[idx] = cvt_pk_bf16(p.kv_norm[k] * p.w_ukv[(size_t)k * 1024 + col], p.kv_norm[k + 1] * p.w_ukv[(size_t)(k + 1) * 1024 + col]);
            atv[idx] = cvt_pk_bf16(p.kv_norm[k] * p.w_ukv[(size_t)k * 1024 + col + 64], p.kv_norm[k + 1] * p.w_ukv[(size_t)(k + 1) * 1024 + col + 64]); }
    }
}

__device__ __forceinline__ void phase_p0c(const P& p, char* lds) {
    const int tid = otid(); const size_t gtid = (size_t)blockIdx.x * NTHR + tid, gstr = (size_t)gridDim.x * NTHR;
    {   unsigned* btg = (unsigned*)(p.ws + OFF_BTG);
        for (size_t idx = gtid; idx < (size_t)512 * 512 / 2; idx += gstr) { const int n = (int)(idx >> 8), k = (int)(idx & 255) * 2;
            btg[idx] = cvt_pk_bf16(p.w_glu[(size_t)k * 512 + n], p.w_glu[(size_t)(k + 1) * 512 + n]); } }
    typedef float f32x2 __attribute__((ext_vector_type(2)));
    f32x2* Apl = (f32x2*)lds;
    f32x2* BB = Apl + 9 * 64;
    f32x2* CC = BB + 64 * 16;
    for (int wi = blockIdx.x; wi < 256; wi += gridDim.x) {
        const int g = wi & 31, slice = wi >> 5;
        __syncthreads();
        const double dt = exp((double)p.log_dt[g]);
        for (int idx = tid; idx < 9 * 64; idx += NTHR) { const int kl = idx >> 6, pp = idx & 63, k = (kl < 8) ? slice * 8 + kl : 64; const double lr = p.lam_re[g * 64 + pp], li = p.lam_im[g * 64 + pp];
            const double mag = exp((double)k * lr * dt), ang = (double)k * li * dt; const f32x2 v = (f32x2){(float)(mag * cos(ang)), (float)(mag * sin(ang))};
            Apl[idx] = v; if (kl < 8 || slice == 7) ((f32x2*)(p.ws + OFF_APOW))[((size_t)g * 65 + k) * 64 + pp] = v; }
        for (int idx = tid; idx < 1024; idx += NTHR) { const int pp = idx >> 4, h = idx & 15; const double lr = p.lam_re[g * 64 + pp], li = p.lam_im[g * 64 + pp];
            const double mag = exp(lr * dt), abr = mag * cos(li * dt), abi = mag * sin(li * dt), den = lr * lr + li * li, nr = abr - 1.0;
            const double cr = (nr * lr + abi * li) / den, ci = (abi * lr - nr * li) / den, br = p.b_re[(g * 64 + pp) * 16 + h], bi = p.b_im[(g * 64 + pp) * 16 + h];
            const f32x2 bv = (f32x2){(float)(cr * br - ci * bi), (float)(cr * bi + ci * br)}; BB[idx] = bv;
            const int hh = idx >> 6, p2 = idx & 63; const f32x2 cv = (f32x2){p.c_re[(g * 16 + hh) * 64 + p2], p.c_im[(g * 16 + hh) * 64 + p2]}; CC[idx] = cv;
            if (slice == 0) { ((f32x2*)(p.ws + OFF_BBCC))[(size_t)g * 2048 + idx] = bv; ((f32x2*)(p.ws + OFF_BBCC))[(size_t)g * 2048 + 1024 + idx] = cv; } }
        __syncthreads();
        for (int e = tid; e < 8 * 256; e += NTHR) { const int kl = e >> 8, h = (e >> 4) & 15, h2 = e & 15, k = slice * 8 + kl; float acc = 0.f;
            for (int pp = 0; pp < 64; ++pp) { const f32x2 c = CC[h * 64 + pp], a = Apl[kl * 64 + pp], b = BB[pp * 16 + h2];
                const float xr = c.x * a.x - c.y * a.y, xi = c.x * a.y + c.y * a.x; acc += xr * b.x - xi * b.y; }
            if (k == 0 && h == h2) acc += p.s5_d[g * 16 + h];
            ((float*)(p.ws + OFF_KTAB))[(size_t)g * 16384 + k * 256 + (e & 255)] = acc; }
    }
}
__device__ __forceinline__ void phase_p0e(const P& p, char* lds) {
    const int tid = otid();
    typedef float f32x2 __attribute__((ext_vector_type(2)));
    f32x2* Apow = (f32x2*)lds;
    f32x2* BB = Apow + 65 * 64;
    f32x2* CC = BB + 64 * 16;
    float* Ktab = (float*)(CC + 16 * 64);
    for (int wi = blockIdx.x; wi < 256; wi += gridDim.x) {
        const int g = wi & 31, slice = wi >> 5;
        __syncthreads();
        for (int idx = tid; idx < 65 * 64; idx += NTHR) Apow[idx] = ((const f32x2*)(p.ws + OFF_APOW))[(size_t)g * 65 * 64 + idx];
        for (int idx = tid; idx < 2048; idx += NTHR) BB[idx] = ((const f32x2*)(p.ws + OFF_BBCC))[(size_t)g * 2048 + idx];
        for (int idx = tid; idx < 16384 / 4; idx += NTHR) ((f32x4*)Ktab)[idx] = ((const f32x4*)(p.ws + OFF_KTAB))[(size_t)g * 4096 + idx];
        __syncthreads();
        unsigned* wt = (unsigned*)(p.ws + OFF_WT) + ((size_t)g * 1024 + slice * 128) * 576;
        for (int e = tid; e < 128 * 576; e += NTHR) { const int nl = e / 576, k = (e - nl * 576) * 2, n = slice * 128 + nl, i = n >> 4, h = n & 15; float v0, v1;
            if (k < 1024) { const int j = k >> 4, h2 = k & 15; v0 = (j <= i) ? Ktab[((i - j) * 16 + h) * 16 + h2] : 0.f; v1 = (j <= i) ? Ktab[((i - j) * 16 + h) * 16 + h2 + 1] : 0.f; }
            else { const int q = k - 1024, pp = q & 63; const f32x2 c0 = CC[h * 64 + pp], a0 = Apow[(i + 1) * 64 + pp], c1 = CC[h * 64 + pp + 1], a1 = Apow[(i + 1) * 64 + pp + 1];
                if (q < 64) { v0 = c0.x * a0.x - c0.y * a0.y; v1 = c1.x * a1.x - c1.y * a1.y; } else { v0 = -(c0.x * a0.y + c0.y * a0.x); v1 = -(c1.x * a1.y + c1.y * a1.x); } }
            wt[e] = cvt_pk_bf16(v0, v1); }
        for (int e = tid; e < 2 * 32 * 256; e += NTHR) { const int kh = e >> 13, rl = (e >> 8) & 31, kk = (e & 255) * 2, row = slice * 32 + rl; float v0 = 0.f, v1 = 0.f;
            if (row < 128) { const int pp = row & 63, j = kh * 32 + (kk >> 4), h2 = kk & 15; const f32x2 a = Apow[(63 - j) * 64 + pp], b0 = BB[pp * 16 + h2], b1 = BB[pp * 16 + h2 + 1];
                if (row < 64) { v0 = a.x * b0.x - a.y * b0.y; v1 = a.x * b1.x - a.y * b1.y; } else { v0 = a.x * b0.y + a.y * b0.x; v1 = a.x * b1.y + a.y * b1.x; } }
            ((unsigned*)(p.ws + OFF_WSS))[(((size_t)(g * 2 + kh) * 256 + row) * 512 + kk) >> 1] = cvt_pk_bf16(v0, v1); }
        if (slice == 0 && tid < 64) ((f32x2*)(p.ws + OFF_A64))[g * 64 + tid] = Apow[64 * 64 + tid];
    }
}
__device__ __forceinline__ void phase_p0d(const P& p, char* lds) {
    const int tid = otid(), lane = tid & 63; const size_t gtid = (size_t)blockIdx.x * NTHR + tid, gstr = (size_t)gridDim.x * NTHR;
    {   unsigned* b1 = (unsigned*)(p.ws + OFF_BTO1); unsigned* b2 = (unsigned*)(p.ws + OFF_BTO2);
        for (size_t idx = gtid; idx < (size_t)1024 * 512 / 2; idx += gstr) { const int n = (int)(idx >> 8), k = (int)(idx & 255) * 2;
            b1[idx] = cvt_pk_bf16(p.gn_s5[k] * p.w_out[(size_t)k * 1024 + n], p.gn_s5[k + 1] * p.w_out[(size_t)(k + 1) * 1024 + n]);
            b2[idx] = cvt_pk_bf16(p.gn_mla[k] * p.w_out[(size_t)(512 + k) * 1024 + n], p.gn_mla[k + 1] * p.w_out[(size_t)(513 + k) * 1024 + n]); } }
    {
        float* Kt = (float*)lds; float* Wq = Kt + 64 * 129;
        for (int tile = blockIdx.x; tile < 32 * 16; tile += gridDim.x) { const int nb = tile >> 4, kb = tile & 15, n0 = nb * 64, k0 = kb * 64, hh = n0 >> 8, half = (n0 >> 7) & 1, key0 = n0 & 127;
            const float* keys = (half ? p.keys2 : p.keys1) + ((size_t)hh * 128 + key0) * 128;
            __syncthreads();
            for (int e = tid; e < 64 * 128; e += NTHR) { const int r = e >> 7, d = e & 127; Kt[r * 129 + d] = keys[(size_t)r * 128 + d]; Wq[e] = p.w_query[(size_t)(k0 + r) * 2048 + hh * 256 + half * 128 + d]; }
            __syncthreads();
            const int tn = tid & 63, tk = (tid >> 6) * 8; float acc[8];
#pragma unroll
            for (int i = 0; i < 8; ++i) acc[i] = 0.f;
            for (int d = 0; d < 128; ++d) { const float kv = Kt[tn * 129 + d];
#pragma unroll
                for (int i = 0; i < 8; ++i) acc[i] += kv * Wq[(tk + i) * 128 + d]; }
            u32x4 w; w.x = cvt_pk_bf16(acc[0], acc[1]); w.y = cvt_pk_bf16(acc[2], acc[3]); w.z = cvt_pk_bf16(acc[4], acc[5]); w.w = cvt_pk_bf16(acc[6], acc[7]);
            *(u32x4*)((bf16_t*)(p.ws + OFF_WST) + (size_t)(n0 + tn) * 1024 + k0 + tk) = w; }
    }
    {
        const int wv = (int)(gtid >> 6), nwv = (int)(gstr >> 6);
        for (int r = wv; r < 2 * 16384; r += nwv) { const int which = r >> 14, e = r & 16383; const float* src = (which ? p.pv : p.pu) + (size_t)e * 1024 + lane * 16;
            f32x4 v[4]; float am = 0.f;
#pragma unroll
            for (int i = 0; i < 4; ++i) { v[i] = *(const f32x4*)(src + 4 * i); am = fmaxf(am, fmaxf(fmaxf(fabsf(v[i][0]), fabsf(v[i][1])), fmaxf(fabsf(v[i][2]), fabsf(v[i][3])))); }
#pragma unroll
            for (int o = 32; o > 0; o >>= 1) am = fmaxf(am, __shfl_xor(am, o));
            if (which == 0) {
            const float sc = am > 0.f ? 7.5f / am : 1.0f; unsigned c[16];
#pragma unroll
            for (int i = 0; i < 16; ++i) { const float x = v[i >> 2][i & 3] * sc, ax = fabsf(x);
                float cf = ax < 1.0f ? rintf(ax * 8.0f) : ax < 2.0f ? 8.0f + rintf((ax - 1.0f) * 8.0f) : ax < 4.0f ? 16.0f + rintf((ax - 2.0f) * 4.0f) : 24.0f + rintf((ax - 4.0f) * 2.0f);
                cf = fminf(cf, 31.0f); c[i] = (unsigned)cf | (x < 0.f ? 32u : 0u); }
            u32x3 w;
            w.x = c[0] | (c[1] << 6) | (c[2] << 12) | (c[3] << 18) | (c[4] << 24) | ((c[5] & 3u) << 30);
            w.y = (c[5] >> 2) | (c[6] << 4) | (c[7] << 10) | (c[8] << 16) | (c[9] << 22) | ((c[10] & 15u) << 28);
            w.z = (c[10] >> 4) | (c[11] << 2) | (c[12] << 8) | (c[13] << 14) | (c[14] << 20) | (c[15] << 26);
            *(u32x3*)(p.ws + OFF_TU8 + (size_t)e * 768 + lane * 12) = w;
            if (lane == 0) ((float*)(p.ws + OFF_SCU))[e] = am > 0.f ? am / 7.5f : 1.0f;
            {
                const float sc4 = am > 0.f ? 6.0f / am : 1.0f; unsigned lo = 0u, hi = 0u;
#pragma unroll
                for (int i = 0; i < 16; ++i) { const float x = v[i >> 2][i & 3] * sc4, ax = fabsf(x);
                    const unsigned c4 = (unsigned)(ax > 0.25f) + (unsigned)(ax > 0.75f) + (unsigned)(ax > 1.25f) + (unsigned)(ax > 1.75f) + (unsigned)(ax > 2.5f) + (unsigned)(ax > 3.5f) + (unsigned)(ax > 5.0f);
                    const unsigned cd = c4 | (x < 0.f ? 8u : 0u);
                    if (i < 8) lo |= cd << (4 * i); else hi |= cd << (4 * (i - 8)); }
                u32x2 w4; w4.x = lo; w4.y = hi;
                *(u32x2*)(p.ws + OFF_TU4 + (size_t)e * 512 + lane * 8) = w4;
                if (lane == 0) ((float*)(p.ws + OFF_SCU4))[e] = am > 0.f ? am / 6.0f : 1.0f; }
            } else {
            const float sc = am > 0.f ? 6.0f / am : 1.0f; unsigned lo = 0u, hi = 0u;
#pragma unroll
            for (int i = 0; i < 16; ++i) { const float x = v[i >> 2][i & 3] * sc, ax = fabsf(x);
                const unsigned c = (unsigned)(ax > 0.25f) + (unsigned)(ax > 0.75f) + (unsigned)(ax > 1.25f) + (unsigned)(ax > 1.75f) + (unsigned)(ax > 2.5f) + (unsigned)(ax > 3.5f) + (unsigned)(ax > 5.0f);
                const unsigned cd = c | (x < 0.f ? 8u : 0u);
                if (i < 8) lo |= cd << (4 * i); else hi |= cd << (4 * (i - 8)); }
            u32x2 w; w.x = lo; w.y = hi;
            *(u32x2*)(p.ws + OFF_TV8 + (size_t)e * 512 + lane * 8) = w;
            if (lane == 0) ((float*)(p.ws + OFF_SCV))[e] = am > 0.f ? am / 6.0f : 1.0f;
            }
            }
    }
}
__device__ __forceinline__ void phase_p0b(const P& p, char* lds) {
    const size_t gtid = (size_t)blockIdx.x * NTHR + otid(), gstr = (size_t)gridDim.x * NTHR;
    const float* mod = (const float*)(p.ws + OFF_MOD); bf16_t* h1 = (bf16_t*)(p.ws + OFF_H1);
    for (size_t i8 = gtid; i8 < (size_t)T * DM / 8; i8 += gstr) { const size_t e = i8 * 8; const int t = (int)(e >> 10), d = (int)(e & 1023), b = t >> 13;
        const f32x4 x0 = *(const f32x4*)(p.x + e), x1 = *(const f32x4*)(p.x + e + 4);
        const float* mb = mod + b * 6144;
        const f32x4 sh0 = *(const f32x4*)(mb + d), sh1 = *(const f32x4*)(mb + d + 4), sc0 = *(const f32x4*)(mb + 1024 + d), sc1 = *(const f32x4*)(mb + 1024 + d + 4);
        *(u32x4*)(h1 + e) = pack8(x0 * (sc0 + 1.0f) + sh0, x1 * (sc1 + 1.0f) + sh1); }
}

__device__ __forceinline__ void phase_g1(const P& p, char* lds) {
    const int tid = otid(); const size_t gtid = (size_t)blockIdx.x * NTHR + tid, gstr = (size_t)gridDim.x * NTHR;
    float* mod = (float*)(p.ws + OFF_MOD);
    {
        float* sl = (float*)lds; float* red = sl + 8192;
        for (int i = tid; i < 8192; i += NTHR) { const float cv = p.c[i]; sl[i] = cv / (1.0f + expf(-cv)); }
        __syncthreads();
        for (int cb = blockIdx.x; cb < 256; cb += gridDim.x) {
            if (tid < 510) { const int ks = tid / 6, c4 = tid - ks * 6; const float* wp = p.w_ada + (size_t)ks * 6144 + cb * 24 + c4 * 4;
                f32x4 w[13];
#pragma unroll
                for (int i = 0; i < 13; ++i) w[i] = (i < 12 || ks < 4) ? *(const f32x4*)(wp + (size_t)i * 85 * 6144) : (f32x4){0.f, 0.f, 0.f, 0.f};
                f32x4 a[8];
#pragma unroll
                for (int b = 0; b < 8; ++b) a[b] = (f32x4){0.f, 0.f, 0.f, 0.f};
#pragma unroll
                for (int i = 0; i < 13; ++i) { const int k = min(ks + 85 * i, 1023);
#pragma unroll
                    for (int b = 0; b < 8; ++b) a[b] += w[i] * sl[b * 1024 + k]; }
#pragma unroll
                for (int b = 0; b < 8; ++b) *(f32x4*)(red + (ks * 8 + b) * 24 + c4 * 4) = a[b]; }
            __syncthreads();
            if (tid < 192) { const int b = tid / 24, col = tid % 24, n = cb * 24 + col; float s = p.b_ada[n];
#pragma unroll 5
                for (int ks = 0; ks < 85; ++ks) s += red[(ks * 8 + b) * 24 + col];
                mod[b * 6144 + n] = s; }
            __syncthreads();
        }
    }
    {
        typedef float f32x2 __attribute__((ext_vector_type(2)));
        f32x2* cs = (f32x2*)(p.ws + OFF_CS);
        const double invf = exp(-9.210340371976184 * (double)(int)(gtid & 15) / 16.0);
        for (size_t idx = gtid; idx < (size_t)T * 16; idx += gstr) { const int t = (int)(idx >> 4);
            const double ang = (double)p.pos[t] * invf; const float r = (float)(ang - 6.283185307179586 * rint(ang * 0.15915494309189535));
            cs[idx] = (f32x2){cosf(r), sinf(r)}; }
    }
    __syncthreads();
    typedef float f32x2 __attribute__((ext_vector_type(2)));
    f32x2* Apl = (f32x2*)lds;
    f32x2* BB = Apl + 9 * 64;
    f32x2* CC = BB + 64 * 16;
    for (int wi = blockIdx.x; wi < 256; wi += gridDim.x) {
        const int g = wi & 31, slice = wi >> 5;
        __syncthreads();
        const double dt = exp((double)p.log_dt[g]);
        for (int idx = tid; idx < 9 * 64; idx += NTHR) { const int kl = idx >> 6, pp = idx & 63, k = (kl < 8) ? slice * 8 + kl : 64; const double lr = p.lam_re[g * 64 + pp], li = p.lam_im[g * 64 + pp];
            const double mag = exp((double)k * lr * dt), ang = (double)k * li * dt; const f32x2 v = (f32x2){(float)(mag * cos(ang)), (float)(mag * sin(ang))};
            Apl[idx] = v; if (kl < 8 || slice == 7) ((f32x2*)(p.ws + OFF_APOW))[((size_t)g * 65 + k) * 64 + pp] = v; }
        for (int idx = tid; idx < 1024; idx += NTHR) { const int pp = idx >> 4, h = idx & 15; const double lr = p.lam_re[g * 64 + pp], li = p.lam_im[g * 64 + pp];
            const double mag = exp(lr * dt), abr = mag * cos(li * dt), abi = mag * sin(li * dt), den = lr * lr + li * li, nr = abr - 1.0;
            const double cr = (nr * lr + abi * li) / den, ci = (abi * lr - nr * li) / den, br = p.b_re[(g * 64 + pp) * 16 + h], bi = p.b_im[(g * 64 + pp) * 16 + h];
            const f32x2 bv = (f32x2){(float)(cr * br - ci * bi), (float)(cr * bi + ci * br)}; BB[idx] = bv;
            const int hh = idx >> 6, p2 = idx & 63; const f32x2 cv = (f32x2){p.c_re[(g * 16 + hh) * 64 + p2], p.c_im[(g * 16 + hh) * 64 + p2]}; CC[idx] = cv;
            if (slice == 0) { ((f32x2*)(p.ws + OFF_BBCC))[(size_t)g * 2048 + idx] = bv; ((f32x2*)(p.ws + OFF_BBCC))[(size_t)g * 2048 + 1024 + idx] = cv; } }
        __syncthreads();
        for (int e = tid; e < 8 * 256; e += NTHR) { const int kl = e >> 8, h = (e >> 4) & 15, h2 = e & 15, k = slice * 8 + kl; float acc = 0.f;
            for (int pp = 0; pp < 64; ++pp) { const f32x2 c = CC[h * 64 + pp], a = Apl[kl * 64 + pp], b = BB[pp * 16 + h2];
                const float xr = c.x * a.x - c.y * a.y, xi = c.x * a.y + c.y * a.x; acc += xr * b.x - xi * b.y; }
            if (k == 0 && h == h2) acc += p.s5_d[g * 16 + h];
            ((float*)(p.ws + OFF_KTAB))[(size_t)g * 16384 + k * 256 + (e & 255)] = acc; }
    }
}
__device__ __forceinline__ void phase_g2(const P& p, char* lds) {
    const int tid = otid(), lane = tid & 63; const size_t gtid = (size_t)blockIdx.x * NTHR + tid, gstr = (size_t)gridDim.x * NTHR;
    const bool rev = (blockIdx.x >> 3) & 1;
#pragma unroll 1
    for (int step = 0; step < 5; ++step) {
        const int task = rev ? 4 - step : step;
        if (task == 0) {


    const float* mod = (const float*)(p.ws + OFF_MOD); bf16_t* h1 = (bf16_t*)(p.ws + OFF_H1);
    if (gstr == (size_t)131072) {
        const size_t e0 = gtid * 8; const int d = (int)(e0 & 1023);
#pragma unroll 1
        for (int b = 0; b < 8; ++b) { const float* mb = mod + b * 6144;
            const f32x4 sh0 = *(const f32x4*)(mb + d), sh1 = *(const f32x4*)(mb + d + 4), sc0 = *(const f32x4*)(mb + 1024 + d) + 1.0f, sc1 = *(const f32x4*)(mb + 1024 + d + 4) + 1.0f;
#pragma unroll
            for (int k = 0; k < 8; ++k) { const size_t e = e0 + ((size_t)(b * 8 + k) << 20);
                const f32x4 x0 = *(const f32x4*)(p.x + e), x1 = *(const f32x4*)(p.x + e + 4);
                *(u32x4*)(h1 + e) = pack8(x0 * sc0 + sh0, x1 * sc1 + sh1); } }
    } else {
#pragma unroll 4
    for (size_t i8 = gtid; i8 < (size_t)T * DM / 8; i8 += gstr) { const size_t e = i8 * 8; const int t = (int)(e >> 10), d = (int)(e & 1023), b = t >> 13;
        const f32x4 x0 = *(const f32x4*)(p.x + e), x1 = *(const f32x4*)(p.x + e + 4);
        const float* mb = mod + b * 6144;
        const f32x4 sh0 = *(const f32x4*)(mb + d), sh1 = *(const f32x4*)(mb + d + 4), sc0 = *(const f32x4*)(mb + 1024 + d), sc1 = *(const f32x4*)(mb + 1024 + d + 4);
        *(u32x4*)(h1 + e) = pack8(x0 * (sc0 + 1.0f) + sh0, x1 * (sc1 + 1.0f) + sh1); }
    }
        } else if (task == 1) {
    {
        const int wv = (int)(gtid >> 6), nwv = (int)(gstr >> 6);
#pragma unroll 2
        for (int r = wv; r < 2 * 16384; r += nwv) { const int which = r >> 14, e = r & 16383; const float* src = (which ? p.pv : p.pu) + (size_t)e * 1024 + lane * 16;
            f32x4 v[4]; float am = 0.f;
#pragma unroll
            for (int i = 0; i < 4; ++i) { v[i] = *(const f32x4*)(src + 4 * i); am = fmaxf(am, fmaxf(fmaxf(fabsf(v[i][0]), fabsf(v[i][1])), fmaxf(fabsf(v[i][2]), fabsf(v[i][3])))); }
#pragma unroll
            for (int o = 32; o > 0; o >>= 1) am = fmaxf(am, __shfl_xor(am, o));
            if (which == 0) {
                const float sc4 = am > 0.f ? 6.0f / am : 1.0f; unsigned lo = 0u, hi = 0u;
#define FK_E4(W, I, B4) W = __builtin_amdgcn_cvt_scalef32_pk_fp4_f32(W, v[(I) >> 2][(I) & 3] * sc4, v[((I) + 1) >> 2][((I) + 1) & 3] * sc4, 1.0f, B4);
                FK_E4(lo, 0, 0) FK_E4(lo, 2, 1) FK_E4(lo, 4, 2) FK_E4(lo, 6, 3) FK_E4(hi, 8, 0) FK_E4(hi, 10, 1) FK_E4(hi, 12, 2) FK_E4(hi, 14, 3)
#undef FK_E4
                u32x2 w4; w4.x = lo; w4.y = hi;
                *(u32x2*)(p.ws + OFF_TU4 + (size_t)e * 512 + lane * 8) = w4;
                if (lane == 0) ((float*)(p.ws + OFF_SCU4))[e] = am > 0.f ? am / 6.0f : 1.0f;
            } else {
            const float sc = am > 0.f ? 6.0f / am : 1.0f; unsigned lo = 0u, hi = 0u;
#define FK_E4(W, I, B4) W = __builtin_amdgcn_cvt_scalef32_pk_fp4_f32(W, v[(I) >> 2][(I) & 3] * sc, v[((I) + 1) >> 2][((I) + 1) & 3] * sc, 1.0f, B4);
            FK_E4(lo, 0, 0) FK_E4(lo, 2, 1) FK_E4(lo, 4, 2) FK_E4(lo, 6, 3) FK_E4(hi, 8, 0) FK_E4(hi, 10, 1) FK_E4(hi, 12, 2) FK_E4(hi, 14, 3)
#undef FK_E4
            u32x2 w; w.x = lo; w.y = hi;
            *(u32x2*)(p.ws + OFF_TV8 + (size_t)e * 512 + lane * 8) = w;
            if (lane == 0) ((float*)(p.ws + OFF_SCV))[e] = am > 0.f ? am / 6.0f : 1.0f;
            }
            }
    }
        } else if (task == 2) {
    {
        float* tl = (float*)lds;
        for (int tile = blockIdx.x; tile < 776; tile += gridDim.x) {
            const float* W; const float* sc; bf16_t* Bt; int ldw, ldb, kT, krow0 = 0, coladd = 0, colmul = 64, nreal = 1 << 30, tt = tile;
            if (tt < 320) { W = p.w_in; sc = nullptr; Bt = (bf16_t*)(p.ws + OFF_BT1); ldw = 1184; ldb = 1024; kT = 16; nreal = 1184; }
            else if ((tt -= 320) < 72) { W = p.w_uq; sc = p.q_norm; Bt = (bf16_t*)(p.ws + OFF_BTQ); ldw = 768; ldb = 384; kT = 6; }
            else if ((tt -= 72) < 32) { W = p.w_ukv; sc = p.kv_norm; Bt = (bf16_t*)(p.ws + OFF_BTK); ldw = 1024; ldb = 256; kT = 4; colmul = 128; }
            else if ((tt -= 32) < 32) { W = p.w_ukv; sc = p.kv_norm; Bt = (bf16_t*)(p.ws + OFF_ATV); ldw = 1024; ldb = 256; kT = 4; colmul = 128; coladd = 64; }
            else if ((tt -= 32) < 64) { W = p.w_glu; sc = nullptr; Bt = (bf16_t*)(p.ws + OFF_BTG); ldw = 512; ldb = 512; kT = 8; }
            else if ((tt -= 64) < 128) { W = p.w_out; sc = p.gn_s5; Bt = (bf16_t*)(p.ws + OFF_BTO1); ldw = 1024; ldb = 512; kT = 8; }
            else { tt -= 128; W = p.w_out; sc = p.gn_mla; Bt = (bf16_t*)(p.ws + OFF_BTO2); ldw = 1024; ldb = 512; kT = 8; krow0 = 512; }
            const int nt_ = tt / kT, k0 = (tt - nt_ * kT) * 64, n0 = nt_ * 64, col0 = nt_ * colmul + coladd, nval = nreal - n0;
            __syncthreads();
            {   const int r = tid >> 3, c8 = (tid & 7) * 8; const float g = sc ? sc[k0 + r] : 1.0f; const float* src = W + (size_t)(krow0 + k0 + r) * ldw + col0 + c8;
                const f32x4 z4 = {0.f, 0.f, 0.f, 0.f}; const f32x4 v0 = (c8 < nval) ? *(const f32x4*)src : z4, v1 = (c8 + 4 < nval) ? *(const f32x4*)(src + 4) : z4;
#pragma unroll
                for (int i = 0; i < 4; ++i) { tl[r * 65 + c8 + i] = v0[i] * g; tl[r * 65 + c8 + 4 + i] = v1[i] * g; } }
            __syncthreads();
            {   const int n = tid >> 3, kq = (tid & 7) * 8; f32x4 o0, o1;
#pragma unroll
                for (int i = 0; i < 4; ++i) { o0[i] = tl[(kq + i) * 65 + n]; o1[i] = tl[(kq + 4 + i) * 65 + n]; }
                *(u32x4*)(Bt + (size_t)(n0 + n) * ldb + k0 + kq) = pack8(o0, o1); }
        }
    }
        } else if (task == 3) {
    {
        float* Kt = (float*)lds; float* Wq = Kt + 64 * 129;
        for (int tile = blockIdx.x; tile < 32 * 16; tile += gridDim.x) { const int nb = tile >> 4, kb = tile & 15, n0 = nb * 64, k0 = kb * 64, hh = n0 >> 8, half = (n0 >> 7) & 1, key0 = n0 & 127;
            const float* keys = (half ? p.keys2 : p.keys1) + ((size_t)hh * 128 + key0) * 128;
            __syncthreads();
            for (int e = tid; e < 64 * 128; e += NTHR) { const int r = e >> 7, d = e & 127; Kt[r * 129 + d] = keys[(size_t)r * 128 + d]; Wq[e] = p.w_query[(size_t)(k0 + r) * 2048 + hh * 256 + half * 128 + d]; }
            __syncthreads();
            const int tn = tid & 63, tk = (tid >> 6) * 8; float acc[8];
#pragma unroll
            for (int i = 0; i < 8; ++i) acc[i] = 0.f;
            for (int d = 0; d < 128; d += 4) { const float k0 = Kt[tn * 129 + d], k1 = Kt[tn * 129 + d + 1], k2 = Kt[tn * 129 + d + 2], k3 = Kt[tn * 129 + d + 3];
#pragma unroll
                for (int i = 0; i < 8; ++i) { const f32x4 wq = *(const f32x4*)(Wq + (tk + i) * 128 + d); acc[i] += (k0 * wq[0] + k1 * wq[1]) + (k2 * wq[2] + k3 * wq[3]); } }
            u32x4 w; w.x = cvt_pk_bf16(acc[0], acc[1]); w.y = cvt_pk_bf16(acc[2], acc[3]); w.z = cvt_pk_bf16(acc[4], acc[5]); w.w = cvt_pk_bf16(acc[6], acc[7]);
            *(u32x4*)((bf16_t*)(p.ws + OFF_WST) + (size_t)(n0 + tn) * 1024 + k0 + tk) = w; }
    }
        } else {


    typedef float f32x2 __attribute__((ext_vector_type(2)));
    f32x2* Apow = (f32x2*)lds;
    f32x2* BB = Apow + 65 * 64;
    f32x2* CC = BB + 64 * 16;
    float* Ktab = (float*)(CC + 16 * 64);
    for (int wi = blockIdx.x; wi < 256; wi += gridDim.x) {
        const int g = wi & 31, slice = wi >> 5;
        __syncthreads();
        for (int idx = tid; idx < 65 * 64; idx += NTHR) Apow[idx] = ((const f32x2*)(p.ws + OFF_APOW))[(size_t)g * 65 * 64 + idx];
        for (int idx = tid; idx < 2048; idx += NTHR) BB[idx] = ((const f32x2*)(p.ws + OFF_BBCC))[(size_t)g * 2048 + idx];
        for (int idx = tid; idx < 16384 / 4; idx += NTHR) ((f32x4*)Ktab)[idx] = ((const f32x4*)(p.ws + OFF_KTAB))[(size_t)g * 4096 + idx];
        __syncthreads();
        unsigned* wt = (unsigned*)(p.ws + OFF_WT) + ((size_t)g * 1024 + slice * 128) * 576;
        for (int e = tid; e < 128 * 576; e += NTHR) { const int nl = e / 576, k = (e - nl * 576) * 2, n = slice * 128 + nl, i = n >> 4, h = n & 15; float v0, v1;
            if (k >= 128 + 256 * ((i >> 4) + 1)) continue;
            if (k >= 128) { const int kk = k - 128, j = kk >> 4, h2 = kk & 15; v0 = (j <= i) ? Ktab[((i - j) * 16 + h) * 16 + h2] : 0.f; v1 = (j <= i) ? Ktab[((i - j) * 16 + h) * 16 + h2 + 1] : 0.f; }
            else { const int q = k, pp = q & 63; const f32x2 c0 = CC[h * 64 + pp], a0 = Apow[(i + 1) * 64 + pp], c1 = CC[h * 64 + pp + 1], a1 = Apow[(i + 1) * 64 + pp + 1];
                if (q < 64) { v0 = c0.x * a0.x - c0.y * a0.y; v1 = c1.x * a1.x - c1.y * a1.y; } else { v0 = -(c0.x * a0.y + c0.y * a0.x); v1 = -(c1.x * a1.y + c1.y * a1.x); } }
            wt[e] = cvt_pk_bf16(v0, v1); }
        for (int e = tid; e < 2 * 32 * 256; e += NTHR) { const int kh = e >> 13, rl = (e >> 8) & 31, kk = (e & 255) * 2, row = slice * 32 + rl; float v0 = 0.f, v1 = 0.f;
            if (row < 128) { const int pp = row & 63, j = kh * 32 + (kk >> 4), h2 = kk & 15; const f32x2 a = Apow[(63 - j) * 64 + pp], b0 = BB[pp * 16 + h2], b1 = BB[pp * 16 + h2 + 1];
                if (row < 64) { v0 = a.x * b0.x - a.y * b0.y; v1 = a.x * b1.x - a.y * b1.y; } else { v0 = a.x * b0.y + a.y * b0.x; v1 = a.x * b1.y + a.y * b1.x; } }
            ((unsigned*)(p.ws + OFF_WSS))[(((size_t)(g * 2 + kh) * 256 + row) * 512 + kk) >> 1] = cvt_pk_bf16(v0, v1); }
        if (slice == 0 && tid < 64) ((f32x2*)(p.ws + OFF_A64))[g * 64 + tid] = Apow[64 * 64 + tid];
    }
        }
        __syncthreads();
    }
}
struct PtrP1 { const char* A; const char* B; __device__ void fill(Unit& u, int PM, int pn) const { u.pm = PM; u.pn = pn; u.pz = 0; u.a = A + (size_t)PM * 256 * 1024 * 2; u.b = B + (size_t)pn * 256 * 1024 * 2; } };
struct EpiP1 {
    static constexpr bool PERM = true, AFTER_DRAIN = false;
    bf16_t* UG; bf16_t* cq; bf16_t* ckv; float* partq; float* partkv; bf16_t* Kimg; const float* cs;
    __device__ __forceinline__ void operator()(const f32x4 (&acc)[2][2][4][2], const Unit& u, int wr, int wc, int fr_, int fq_) const {
        int fr = fr_, fq = fq_; asm volatile("" : "+v"(fr), "+v"(fq));
#pragma unroll
        for (int bj = 0; bj < 2; ++bj) {
            const int c32 = u.pn * 256 + bj * 128 + wc * 32, c8 = c32 + 8 * fq;
#pragma unroll
            for (int ai = 0; ai < 2; ++ai)
#pragma unroll
                for (int m = 0; m < 4; ++m) {
                    const int t = u.pm * 256 + ai * 128 + wr * 64 + m * 16 + fr;
                    const f32x4 v0 = acc[ai][bj][m][0], v1 = acc[ai][bj][m][1];
                    if (c32 < 512) {
                        *(u32x4*)(UG + ((size_t)(c8 >> 4) * 1024 + (t >> 6)) * 1152 + 128 + (t & 63) * 16 + (c8 & 15)) = pack8(v0, v1);
                    } else if (c32 < 1152) {
                        float s = (v0[0] * v0[0] + v0[1] * v0[1]) + (v0[2] * v0[2] + v0[3] * v0[3]) + (v1[0] * v1[0] + v1[1] * v1[1]) + (v1[2] * v1[2] + v1[3] * v1[3]);
                        s += __shfl_xor(s, 16); s += __shfl_xor(s, 32);
                        if (c32 < 896) { *(u32x4*)(cq + (size_t)t * 384 + (c8 - 512)) = pack8(v0, v1); if (fq == 0) partq[(size_t)t * 12 + ((c32 - 512) >> 5)] = s; }
                        else { *(u32x4*)(ckv + (size_t)t * 256 + (c8 - 896)) = pack8(v0, v1); if (fq == 0) partkv[(size_t)t * 8 + ((c32 - 896) >> 5)] = s; }
                    } else if (c32 < 1184) {
                        const float* csr = cs + ((size_t)t * 16 + (fq & 1) * 8) * 2;
                        f32x4 o0, o1;
#pragma unroll
                        for (int e = 0; e < 4; ++e) {
                            const float a0 = v0[e], a1 = v1[e], b0 = __shfl_xor(a0, 32), b1 = __shfl_xor(a1, 32);
                            const float c0 = csr[e * 2], s0 = csr[e * 2 + 1], c1 = csr[(4 + e) * 2], s1 = csr[(4 + e) * 2 + 1];
                            o0[e] = (fq < 2) ? a0 * c0 - b0 * s0 : a0 * c0 + b0 * s0;
                            o1[e] = (fq < 2) ? a1 * c1 - b1 * s1 : a1 * c1 + b1 * s1; }
                        const u32x4 w = pack8(o0, o1);
                        const int b = t >> 13, tile = (t & 8191) >> 6, key = t & 63;
#pragma unroll
                        for (int h = 0; h < 8; ++h) *(u32x4*)(Kimg + ((((size_t)(b * 8 + h) * 128 + tile) * 12 + 8 + fq) * 64 + key) * 8) = w;
                    }
                }
        }
    }
};
__device__ __forceinline__ void phase_p1(const P& p, char* lds) {
    OrderT<PtrP1> S; PtrP1 pt; pt.A = p.ws + OFF_H1; pt.B = p.ws + OFF_BT1; S.init(T / 256, 5, (int)gridDim.x, (int)blockIdx.x, pt);
    EpiP1 E; E.UG = (bf16_t*)(p.ws + OFF_UG); E.cq = (bf16_t*)(p.ws + OFF_CQ); E.ckv = (bf16_t*)(p.ws + OFF_CKV); E.partq = (float*)(p.ws + OFF_PQ); E.partkv = (float*)(p.ws + OFF_PKV);
    E.Kimg = (bf16_t*)(p.ws + OFF_KIMG); E.cs = (const float*)(p.ws + OFF_CS);
    Gemm g; g.K = 1024; g.lda = 1024; g.ldb = 1024;
    pg8::gemm_phase<EpiP1, OrderT<PtrP1>, false>((PG8_LAS unsigned char*)lds, g, S, E, nullptr);
}


constexpr size_t OFF_QB = OFF_R1;
constexpr size_t OFF_E = OFF_R1 + (size_t)T * 8 * 96 * 2;
constexpr size_t OFF_YMLA = OFF_R2;
constexpr float QSCALE = 0.10206207261596577f * 1.4426950408889634f;
struct PtrAB { const char* A; const char* B; size_t sa, sb; __device__ void fill(Unit& u, int PM, int pn) const { u.pm = PM; u.pn = pn; u.pz = 0; u.a = A + (size_t)PM * sa; u.b = B + (size_t)pn * sb; } };
struct EpiQ {
    static constexpr bool PERM = true, AFTER_DRAIN = false;
    bf16_t* Qb; const float* rqa; const float* cs;
    __device__ __forceinline__ void operator()(const f32x4 (&acc)[2][2][4][2], const Unit& u, int wr, int wc, int fr_, int fq_) const {
        int fr = fr_, fq = fq_; asm volatile("" : "+v"(fr), "+v"(fq));
        float rq[8];
#pragma unroll
        for (int r8 = 0; r8 < 8; ++r8) rq[r8] = rqa[u.pm * 256 + (r8 >> 2) * 128 + wr * 64 + (r8 & 3) * 16 + fr];
        const int g0 = (u.pn * 256 + wc * 32) >> 5, j0 = g0 % 3, j1 = (g0 + 4) % 3;
        const bool rope = (j0 == 2) || (j1 == 2);
#pragma unroll
        for (int rp = 0; rp < 4; ++rp) { const int ai = rp >> 1, mb = (rp & 1) * 2;
            f32x4 csv[2][4];
            if (rope) {
#pragma unroll
                for (int mm = 0; mm < 2; ++mm) { const int t = u.pm * 256 + ai * 128 + wr * 64 + (mb + mm) * 16 + fr; const f32x4* csr = (const f32x4*)(cs + ((size_t)t * 16 + (fq & 1) * 8) * 2);
#pragma unroll
                    for (int q = 0; q < 4; ++q) csv[mm][q] = csr[q]; } }
#pragma unroll
            for (int mm = 0; mm < 2; ++mm) { const int m = mb + mm; const int t = u.pm * 256 + ai * 128 + wr * 64 + m * 16 + fr; const float rqv = rq[ai * 4 + m];
#pragma unroll
                for (int bj = 0; bj < 2; ++bj) {
                    const int c32 = u.pn * 256 + bj * 128 + wc * 32, g32 = c32 >> 5, h = g32 / 3, j = g32 - 3 * h;
                    f32x4 v0 = acc[ai][bj][m][0] * rqv, v1 = acc[ai][bj][m][1] * rqv;
                    if (j == 2) {
                        f32x4 o0, o1;
#pragma unroll
                        for (int e = 0; e < 4; ++e) {
                            const float a0 = v0[e], a1 = v1[e], b0 = __shfl_xor(a0, 32), b1 = __shfl_xor(a1, 32);
                            const float c0 = csv[mm][e >> 1][(e & 1) * 2], s0 = csv[mm][e >> 1][(e & 1) * 2 + 1], c1 = csv[mm][2 + (e >> 1)][(e & 1) * 2], s1 = csv[mm][2 + (e >> 1)][(e & 1) * 2 + 1];
                            o0[e] = (fq < 2) ? a0 * c0 - b0 * s0 : a0 * c0 + b0 * s0;
                            o1[e] = (fq < 2) ? a1 * c1 - b1 * s1 : a1 * c1 + b1 * s1; }
                        v0 = o0; v1 = o1;
                    }
                    *(u32x4*)(Qb + ((size_t)((t >> 13) * 8 + h) * SEQ + (t & 8191)) * 96 + j * 32 + 8 * fq) = pack8(v0, v1);
                }
            }
            asm volatile("" ::: "memory");
        }
    }
};
struct EpiK {
    static constexpr bool PERM = true, AFTER_DRAIN = false;
    bf16_t* Kimg; const float* partkv;
    __device__ __forceinline__ void operator()(const f32x4 (&acc)[2][2][4][2], const Unit& u, int wr, int wc, int fr_, int fq_) const {
        int fr = fr_, fq = fq_; asm volatile("" : "+v"(fr), "+v"(fq));
#pragma unroll
        for (int ai = 0; ai < 2; ++ai)
#pragma unroll
            for (int m = 0; m < 4; ++m) { const int t = u.pm * 256 + ai * 128 + wr * 64 + m * 16 + fr;
                const float rk = partkv[t];
                const int bb = t >> 13, tile = (t & 8191) >> 6, key = t & 63;
#pragma unroll
                for (int bj = 0; bj < 2; ++bj) { const int c8 = u.pn * 256 + bj * 128 + wc * 32 + 8 * fq, h = c8 >> 6, chunk = (c8 & 63) >> 3;
                    *(u32x4*)(Kimg + ((((size_t)(bb * 8 + h) * 128 + tile) * 12 + chunk) * 64 + key) * 8) = pack8(acc[ai][bj][m][0] * rk, acc[ai][bj][m][1] * rk); }
                }
    }
};
struct EpiV {
    static constexpr bool PERM = false, AFTER_DRAIN = false;
    bf16_t* Vimg; const float* partkv;
    __device__ __forceinline__ void operator()(const f32x4 (&acc)[2][2][4][2], const Unit& u, int wr, int wc, int fr_, int fq_) const {
        int fr = fr_, fq = fq_; asm volatile("" : "+v"(fr), "+v"(fq));
#pragma unroll
        for (int bj = 0; bj < 2; ++bj)
#pragma unroll
            for (int n = 0; n < 2; ++n) {
                const int tk = u.pn * 256 + bj * 128 + wc * 32 + 16 * n + 4 * fq;
                const f32x4 rk = *(const f32x4*)(partkv + tk);
                const int bb = tk >> 13, tile = (tk & 8191) >> 6, key = tk & 63, pos = ((fq & 1) << 3) | ((fq >> 1) << 2), g = (key >> 4) * 2 + (pos >> 3);
#pragma unroll
                for (int ai = 0; ai < 2; ++ai)
#pragma unroll
                    for (int m = 0; m < 4; ++m) { const int r = u.pm * 256 + ai * 128 + wr * 64 + m * 16 + fr, h = r >> 6, d = r & 63;
                        const f32x4 v = acc[ai][bj][m][n] * rk; u32x2 w; w.x = cvt_pk_bf16(v[0], v[1]); w.y = cvt_pk_bf16(v[2], v[3]);
                        *(u32x2*)(Vimg + ((size_t)(bb * 8 + h) * 128 + tile) * 4096 + d * 64 + ((g ^ ((d >> 1) & 7)) * 8) + (pos & 7)) = w; }
                asm volatile("" ::: "memory");
            }
    }
};

struct PtrState { const char* UG; const char* W; __device__ void fill(Unit& u, int PM, int pn) const { u.pm = PM; u.pn = pn; u.pz = 0; const int g = PM >> 2, rt = PM & 3;
    u.a = UG + ((size_t)(g * 1024 + rt * 256) * 1152 + 128 + pn * 512) * 2; u.b = W + (size_t)(g * 2 + pn) * 256 * 512 * 2; } };
struct EpiE {
    static constexpr bool PERM = false, AFTER_DRAIN = false;
    float* E;
    __device__ __forceinline__ void operator()(const f32x4 (&acc)[2][2][4][2], const Unit& u, int wr, int wc, int fr_, int fq_) const {
        int fr = fr_, fq = fq_; asm volatile("" : "+v"(fr), "+v"(fq));
        const int g = u.pm >> 2, rt = u.pm & 3;
#pragma unroll
        for (int ai = 0; ai < 2; ++ai)
#pragma unroll
            for (int m = 0; m < 4; ++m) { const int c = rt * 256 + ai * 128 + wr * 64 + m * 16 + fr;
#pragma unroll
                for (int n = 0; n < 2; ++n) *(f32x4*)(E + ((size_t)(g * 2 + u.pn) * 1024 + c) * 128 + wc * 32 + 16 * n + 4 * fq) = acc[ai][0][m][n]; }
    }
};
__device__ __forceinline__ void phase_p2(const P& p, char* lds) {
    {
        const int tid = otid(); float* rqa = (float*)(p.ws + OFF_RQ); float* rka = (float*)(p.ws + OFF_RK); const float* partq = (const float*)(p.ws + OFF_PQ); const float* partkv = (const float*)(p.ws + OFF_PKV);
        PtrAB pt0; pt0.A = nullptr; pt0.B = nullptr; pt0.sa = 0; pt0.sb = 0; Unit u;
        {   OrderT<PtrAB> S; S.init(T / 256, 3, (int)gridDim.x, (int)blockIdx.x, pt0);
            for (int i = 0; S.next(i, u); ++i) if (tid < 256) { const int t = u.pm * 256 + tid; const f32x4* pp = (const f32x4*)(partq + (size_t)t * 12);
                const f32x4 a = pp[0], b = pp[1], c = pp[2]; const float s = ((a[0] + a[1]) + (a[2] + a[3])) + ((b[0] + b[1]) + (b[2] + b[3])) + ((c[0] + c[1]) + (c[2] + c[3]));
                rqa[t] = QSCALE / sqrtf(s * (1.0f / 384.0f) + 1e-6f); } }
#define FK_RKROW(T_) { const int t = (T_); const f32x4* pp = (const f32x4*)(partkv + (size_t)t * 8); const f32x4 a = pp[0], b = pp[1]; \
            rka[t] = 1.0f / sqrtf((((a[0] + a[1]) + (a[2] + a[3])) + ((b[0] + b[1]) + (b[2] + b[3]))) * (1.0f / 256.0f) + 1e-6f); }
        {   OrderT<PtrAB> S; S.init(T / 256, 2, (int)gridDim.x, (int)blockIdx.x, pt0);
            for (int i = 0; S.next(i, u); ++i) if (tid < 256) FK_RKROW(u.pm * 256 + tid) }
        {   OrderT<PtrAB> S; S.init(2, T / 256, (int)gridDim.x, (int)blockIdx.x, pt0);
            for (int i = 0; S.next(i, u); ++i) if (tid < 256) FK_RKROW(u.pn * 256 + tid) }
#undef FK_RKROW
        asm volatile("s_waitcnt vmcnt(0)" ::: "memory"); __syncthreads();
    }
    {   OrderT<PtrAB> S; PtrAB pt; pt.A = p.ws + OFF_CQ; pt.B = p.ws + OFF_BTQ; pt.sa = (size_t)256 * 384 * 2; pt.sb = (size_t)256 * 384 * 2; S.init(T / 256, 3, (int)gridDim.x, (int)blockIdx.x, pt);
        EpiQ E; E.Qb = (bf16_t*)(p.ws + OFF_QB); E.rqa = (const float*)(p.ws + OFF_RQ); E.cs = (const float*)(p.ws + OFF_CS);
        Gemm g; g.K = 384; g.lda = 384; g.ldb = 384;
        pg8::gemm_phase<EpiQ, OrderT<PtrAB>, false>((PG8_LAS unsigned char*)lds, g, S, E, nullptr); }
    __syncthreads();
    {   OrderT<PtrAB> S; PtrAB pt; pt.A = p.ws + OFF_CKV; pt.B = p.ws + OFF_BTK; pt.sa = (size_t)256 * 256 * 2; pt.sb = (size_t)256 * 256 * 2; S.init(T / 256, 2, (int)gridDim.x, (int)blockIdx.x, pt);
        EpiK E; E.Kimg = (bf16_t*)(p.ws + OFF_KIMG); E.partkv = (const float*)(p.ws + OFF_RK);
        Gemm g; g.K = 256; g.lda = 256; g.ldb = 256;
        pg8::gemm_phase<EpiK, OrderT<PtrAB>, false>((PG8_LAS unsigned char*)lds, g, S, E, nullptr); }
    __syncthreads();
    {   OrderT<PtrAB> S; PtrAB pt; pt.A = p.ws + OFF_ATV; pt.B = p.ws + OFF_CKV; pt.sa = (size_t)256 * 256 * 2; pt.sb = (size_t)256 * 256 * 2; S.init(2, T / 256, (int)gridDim.x, (int)blockIdx.x, pt);
        EpiV E; E.Vimg = (bf16_t*)(p.ws + OFF_VIMG); E.partkv = (const float*)(p.ws + OFF_RK);
        Gemm g; g.K = 256; g.lda = 256; g.ldb = 256;
        pg8::gemm_phase<EpiV, OrderT<PtrAB>, false>((PG8_LAS unsigned char*)lds, g, S, E, nullptr); }
    __syncthreads();
    {   OrderT<PtrState> S; PtrState pt; pt.UG = p.ws + OFF_UG; pt.W = p.ws + OFF_WSS; S.init(128, 2, (int)gridDim.x, (int)blockIdx.x, pt);
        EpiE E; E.E = (float*)(p.ws + OFF_E);
        Gemm g; g.K = 512; g.lda = 1152; g.ldb = 512;
        pg8::gemm_phase<EpiE, OrderT<PtrState>, false>((PG8_LAS unsigned char*)lds, g, S, E, nullptr); }
}
typedef short bf16x8 __attribute__((ext_vector_type(8)));
typedef float f32x16 __attribute__((ext_vector_type(16)));
#define FK_MFMA32(a, b, c) __builtin_amdgcn_mfma_f32_32x32x16_bf16(a, b, c, 0, 0, 0)
constexpr int ATT_TILE_BYTES = 20480;
__device__ __forceinline__ void attn_stage(const bf16_t* kt, const bf16_t* vt, PG8_LAS unsigned char* buf, int w, int lane) {
    const bf16_t* s0 = kt + w * 512 + lane * 8;
    const bf16_t* s1 = (w < 4) ? kt + (w + 8) * 512 + lane * 8 : vt + (w - 4) * 512 + lane * 8;
    __builtin_amdgcn_global_load_lds((const unsigned*)s0, (PG8_LAS unsigned*)(buf + w * 1024), 16, 0, 0);
    __builtin_amdgcn_global_load_lds((const unsigned*)s1, (PG8_LAS unsigned*)(buf + (w + 8) * 1024), 16, 0, 0);
    if (w < 4) __builtin_amdgcn_global_load_lds((const unsigned*)(vt + (w + 4) * 512 + lane * 8), (PG8_LAS unsigned*)(buf + (w + 16) * 1024), 16, 0, 0);
}
__device__ __forceinline__ void attn_unit(const P& p, PG8_LAS unsigned char* lds, int b, int h, int qb) {
    const int tid = otid(), lane = tid & 63, r32 = lane & 31, hi = lane >> 5; const int w = __builtin_amdgcn_readfirstlane(tid >> 6);
    const bf16_t* kimg = (const bf16_t*)(p.ws + OFF_KIMG) + (size_t)(b * 8 + h) * 128 * 6144;
    const bf16_t* vimg = (const bf16_t*)(p.ws + OFF_VIMG) + (size_t)(b * 8 + h) * 128 * 4096;
    const int q0 = qb * 256 + w * 32, NT = 4 * qb + 4, my_nt = 4 * qb + (w >> 1) + 1;
    const bf16_t* qrow = (const bf16_t*)(p.ws + OFF_QB) + ((size_t)(b * 8 + h) * SEQ + q0 + r32) * 96;
    bf16x8 qf[6];
#pragma unroll
    for (int d0 = 0; d0 < 6; ++d0) qf[d0] = *(const bf16x8*)(qrow + d0 * 16 + hi * 8);
    f32x16 o0, o1;
#pragma unroll
    for (int r = 0; r < 16; ++r) { o0[r] = 0.f; o1[r] = 0.f; }
    float m_ref = 0.f, l_run = 0.f; f32x16 negm, s0, s1;
#pragma unroll
    for (int r = 0; r < 16; ++r) negm[r] = 0.f;
#define FK_QK(dst0, dst1, kb_) { _Pragma("unroll") for (int d0 = 0; d0 < 6; ++d0) { \
        const bf16x8 k0_ = *(const PG8_LAS bf16x8*)((kb_) + ((2 * d0 + hi) * 64 + r32) * 16), k1_ = *(const PG8_LAS bf16x8*)((kb_) + ((2 * d0 + hi) * 64 + 32 + r32) * 16); \
        dst0 = FK_MFMA32(k0_, qf[d0], d0 == 0 ? negm : dst0); dst1 = FK_MFMA32(k1_, qf[d0], d0 == 0 ? negm : dst1); } }
#define FK_WAIT_OLDER() { if (w < 4) asm volatile("s_waitcnt vmcnt(3)" ::: "memory"); else asm volatile("s_waitcnt vmcnt(2)" ::: "memory"); }
    asm volatile("s_waitcnt vmcnt(0)" ::: "memory");
    attn_stage(kimg, vimg, lds, w, lane);
    attn_stage(kimg + 6144, vimg + 4096, lds + ATT_TILE_BYTES, w, lane);
    attn_stage(kimg + 2 * 6144, vimg + 2 * 4096, lds + 2 * ATT_TILE_BYTES, w, lane);
    FK_WAIT_OLDER()
    __syncthreads();
#define FK_EXPS() { float ls0 = 0.f, ls1 = 0.f; \
            _Pragma("unroll") for (int r = 0; r < 8; ++r) { const float a0 = __builtin_amdgcn_exp2f(s0[2 * r]), a1 = __builtin_amdgcn_exp2f(s0[2 * r + 1]), b0 = __builtin_amdgcn_exp2f(s1[2 * r]), b1 = __builtin_amdgcn_exp2f(s1[2 * r + 1]); \
                ls0 += a0 + a1; ls1 += b0 + b1; pw[r] = cvt_pk_bf16(a0, a1); pw[8 + r] = cvt_pk_bf16(b0, b1); } \
            lsum = ls0 + ls1; }
      \

#define FK_SOFTMAX(first_) { \
            float lsum = 0.f; bool move_ = (first_); \
            for (;;) { \
                if (move_) { \
                    float mx = fmaxf(fmaxf(s0[0], s0[1]), s1[0]); \
                    _Pragma("unroll") for (int r = 2; r < 16; r += 2) mx = fmaxf(fmaxf(mx, s0[r]), s0[r + 1]); \
                    _Pragma("unroll") for (int r = 1; r < 15; r += 2) mx = fmaxf(fmaxf(mx, s1[r]), s1[r + 1]); \
                    mx = fmaxf(mx, s1[15]); \
                    mx = fmaxf(mx, __shfl_xor(mx, 32)); \
                    const float delta = (first_) ? mx : fmaxf(mx, 0.f), sc = __builtin_amdgcn_exp2f(-delta); \
                    m_ref += delta; l_run *= sc; \
                    _Pragma("unroll") for (int r = 0; r < 16; ++r) { s0[r] -= delta; s1[r] -= delta; o0[r] *= sc; o1[r] *= sc; negm[r] = -m_ref; } } \
                FK_EXPS() \
                if (move_ || __builtin_amdgcn_ballot_w64(!(lsum <= 256.0f)) == 0ull) break; \
                move_ = true; } \
            l_run += lsum; }
#define FK_RDV(vb_) { _Pragma("unroll") for (int ks = 0; ks < 4; ++ks) { const int g = 2 * ks + hi; \
                vf0[ks] = *(const PG8_LAS bf16x8*)((vb_) + r32 * 128 + ((g ^ ((r32 >> 1) & 7)) * 16)); \
                vf1[ks] = *(const PG8_LAS bf16x8*)((vb_) + (32 + r32) * 128 + ((g ^ (((32 + r32) >> 1) & 7)) * 16)); } }
#define FK_RDK(kb_) { _Pragma("unroll") for (int d0 = 0; d0 < 6; ++d0) { kf0[d0] = *(const PG8_LAS bf16x8*)((kb_) + ((2 * d0 + hi) * 64 + r32) * 16); kf1[d0] = *(const PG8_LAS bf16x8*)((kb_) + ((2 * d0 + hi) * 64 + 32 + r32) * 16); } }
#define FK_PV() { _Pragma("unroll") for (int ks = 0; ks < 4; ++ks) { union { bf16x8 v; unsigned u[4]; } pf; \
                _Pragma("unroll") for (int jj = 0; jj < 4; ++jj) pf.u[jj] = pw[ks * 4 + jj]; \
                o0 = FK_MFMA32(vf0[ks], pf.v, o0); o1 = FK_MFMA32(vf1[ks], pf.v, o1); } }
#define FK_QKF() { s0 = FK_MFMA32(kf0[0], qf[0], negm); s1 = FK_MFMA32(kf1[0], qf[0], negm); \
                _Pragma("unroll") for (int d0 = 1; d0 < 6; ++d0) { s0 = FK_MFMA32(kf0[d0], qf[d0], s0); s1 = FK_MFMA32(kf1[d0], qf[d0], s1); } }
    if (w < 4) {
    FK_QK(s0, s1, lds)
    int slot = 0;
    for (int t = 0; t < NT; ++t) {
        if (t > 0) { if (t + 2 < NT) { FK_WAIT_OLDER() } else asm volatile("s_waitcnt vmcnt(0)" ::: "memory"); __syncthreads(); }
        const int slot1 = slot == 4 ? 0 : slot + 1, slot3 = slot >= 2 ? slot - 2 : slot + 3;
        if (t + 3 < NT) attn_stage(kimg + (size_t)(t + 3) * 6144, vimg + (size_t)(t + 3) * 4096, lds + slot3 * ATT_TILE_BYTES, w, lane);
        if (t < my_nt) {
            const bool more = (t + 1 < my_nt);
            const PG8_LAS unsigned char* kb1 = lds + slot1 * ATT_TILE_BYTES; const PG8_LAS unsigned char* vb = lds + slot * ATT_TILE_BYTES + 12288;
            bf16x8 kf0[6], kf1[6], vf0[4], vf1[4]; unsigned pw[16];
            FK_RDV(vb)
            __builtin_amdgcn_sched_barrier(0);
            FK_SOFTMAX(t == 0)
            __builtin_amdgcn_sched_barrier(0);
            if (more) FK_RDK(kb1)
            FK_PV()
            if (more) FK_QKF()
        }
        slot = slot1;
    }
    } else {
    unsigned pw[16];
#pragma unroll
    for (int r = 0; r < 16; ++r) { pw[r] = 0u; s0[r] = 0.f; s1[r] = 0.f; }
    int slot = 0;
    for (int t = 0; t < NT; ++t) {
        if (t > 0) { if (t + 2 < NT) { FK_WAIT_OLDER() } else asm volatile("s_waitcnt vmcnt(0)" ::: "memory"); __syncthreads(); }
        const int slot1 = slot == 4 ? 0 : slot + 1, slot3 = slot >= 2 ? slot - 2 : slot + 3, slotm = slot == 0 ? 4 : slot - 1;
        if (t + 3 < NT) attn_stage(kimg + (size_t)(t + 3) * 6144, vimg + (size_t)(t + 3) * 4096, lds + slot3 * ATT_TILE_BYTES, w, lane);
        const bool dopv = t >= 1 && t <= my_nt, doqk = t < my_nt;
        bf16x8 kf0[6], kf1[6], vf0[4], vf1[4];
        if (dopv) FK_RDV(lds + slotm * ATT_TILE_BYTES + 12288)
        if (doqk) FK_RDK(lds + slot * ATT_TILE_BYTES)
        if (dopv) FK_PV()
        if (doqk) { FK_QKF()
            __builtin_amdgcn_sched_barrier(0);
            __builtin_amdgcn_s_setprio(0);
            FK_SOFTMAX(t == 0)
            __builtin_amdgcn_s_setprio(2); }
        slot = slot1;
    }
    if (my_nt == NT) { bf16x8 vf0[4], vf1[4]; const int slotm = slot == 0 ? 4 : slot - 1;
        FK_RDV(lds + slotm * ATT_TILE_BYTES + 12288)
        FK_PV() }
    }
#undef FK_SOFTMAX
#undef FK_EXPS
#undef FK_RDV
#undef FK_RDK
#undef FK_PV
#undef FK_QKF
    __syncthreads();
#undef FK_QK
#undef FK_WAIT_OLDER
    const float lt = l_run + __shfl_xor(l_run, 32), inv = 1.0f / lt;
    bf16_t* yrow = (bf16_t*)(p.ws + OFF_YMLA) + ((size_t)b * SEQ + q0 + r32) * 512 + h * 64;
    float ss = 0.f;
#pragma unroll
    for (int rg = 0; rg < 4; ++rg) {
        const float a0 = o0[4 * rg] * inv, a1 = o0[4 * rg + 1] * inv, a2 = o0[4 * rg + 2] * inv, a3 = o0[4 * rg + 3] * inv;
        const float b0 = o1[4 * rg] * inv, b1 = o1[4 * rg + 1] * inv, b2 = o1[4 * rg + 2] * inv, b3 = o1[4 * rg + 3] * inv;
        ss += (a0 * a0 + a1 * a1) + (a2 * a2 + a3 * a3) + (b0 * b0 + b1 * b1) + (b2 * b2 + b3 * b3);
        u32x2 wa, wb; wa.x = cvt_pk_bf16(a0, a1); wa.y = cvt_pk_bf16(a2, a3); wb.x = cvt_pk_bf16(b0, b1); wb.y = cvt_pk_bf16(b2, b3);
        *(u32x2*)(yrow + 8 * rg + 4 * hi) = wa; *(u32x2*)(yrow + 32 + 8 * rg + 4 * hi) = wb; }
    ss += __shfl_xor(ss, 32);
    if (hi == 0) ((float*)(p.ws + OFF_PMLA))[((size_t)b * SEQ + q0 + r32) * 8 + h] = ss;
}
__device__ __forceinline__ void s5_carry_scan(const P& p, char* lds) {
    typedef float f32x2 __attribute__((ext_vector_type(2)));
    const int tid_ = otid();
    float* el = (float*)lds;
    for (int cb = blockIdx.x; cb < 256; cb += gridDim.x) { const int g = cb & 31, b = cb >> 5;
        const float* e0 = (const float*)(p.ws + OFF_E) + ((size_t)(g * 2) * 1024 + b * 128) * 128; const float* e1 = e0 + (size_t)1024 * 128;
        __syncthreads();
#pragma unroll
        for (int i = 0; i < 8; ++i) { const int i4 = (i * NTHR + tid_) * 4; const f32x4 x0 = *(const f32x4*)(e0 + i4), x1 = *(const f32x4*)(e1 + i4); *(f32x4*)(el + i4) = x0 + x1; }
        __syncthreads();
        if (tid_ < 64) { const int pp = tid_; const f32x2 a = ((const f32x2*)(p.ws + OFF_A64))[g * 64 + pp];
            bf16_t* sp = (bf16_t*)(p.ws + OFF_UG) + ((size_t)g * 1024 + b * 128) * 1152 + pp;
            float sr = 0.f, si = 0.f;
#pragma unroll 8
            for (int cl = 0; cl < 128; ++cl) {
                sp[(size_t)cl * 1152] = (bf16_t)(cvt_pk_bf16(sr, 0.f) & 0xffffu); sp[(size_t)cl * 1152 + 64] = (bf16_t)(cvt_pk_bf16(si, 0.f) & 0xffffu);
                const float er = el[cl * 128 + pp], ei = el[cl * 128 + 64 + pp];
                const float nr = a.x * sr - a.y * si + er, ni = a.x * si + a.y * sr + ei; sr = nr; si = ni; } }
    }
    __syncthreads();
}
__device__ __forceinline__ void phase_p3(const P& p, char* lds) {
    s5_carry_scan(p, lds);
    const int xcd = blockIdx.x & 7, slot = blockIdx.x >> 3, nslot = gridDim.x >> 3;
    if (__builtin_amdgcn_readfirstlane(otid() >> 6) < 4) __builtin_amdgcn_s_setprio(1); else __builtin_amdgcn_s_setprio(2);
    for (int li = slot; li < 128; li += nslot) { const int bh = xcd + 8 * (li >> 4), pr = li & 15;
#pragma unroll 1
        for (int half = 0; half < 2; ++half) attn_unit(p, (PG8_LAS unsigned char*)lds, bh >> 3, bh & 7, half ? 31 - pr : pr); }
    __builtin_amdgcn_s_setprio(0);
}

constexpr size_t OFF_YG = OFF_R1, OFF_YS5 = OFF_R1 + (size_t)T * 512 * 2;
__device__ __forceinline__ float gelu_fast(float x) {
    const float z = x * (0.7978845608028654f + 0.035677408136300125f * x * x);
    return x * __builtin_amdgcn_rcpf(1.0f + __builtin_amdgcn_exp2f(-2.885390081777927f * z)); }
struct PtrToep { const char* UG; const char* W; __device__ void fill(Unit& u, int PM, int pn) const { u.pm = PM; u.pn = pn; u.pz = 0; const int g = PM >> 2, rt = PM & 3;
    u.a = UG + (size_t)(g * 1024 + rt * 256) * 1152 * 2; u.b = W + (size_t)(g * 1024 + pn * 256) * 1152 * 2; u.nt = 2 + 4 * (pn + 1); } };
struct OrderToep { int G, c; PtrToep pt;
    __device__ bool next(int i, Unit& u) const { const long L = (long)i * G + c; if (L >= 512) return false;
        const int half = (int)(L >> 8), idx = (int)(L & 255), x = idx & 7, slot = idx >> 3, g = x * 4 + (slot >> 3), rt = (slot >> 1) & 3, pnlow = slot & 1;
        pt.fill(u, g * 4 + rt, half ? 3 - pnlow : pnlow); return true; }
    __device__ __forceinline__ void a_ready(const Unit&) const {}
    __device__ __forceinline__ void done(const Unit&) const {}
};
struct EpiY {
    static constexpr bool PERM = true, AFTER_DRAIN = false;
    bf16_t* yg;
    __device__ __forceinline__ void operator()(const f32x4 (&acc)[2][2][4][2], const Unit& u, int wr, int wc, int fr_, int fq_) const {
        int fr = fr_, fq = fq_; asm volatile("" : "+v"(fr), "+v"(fq));
        const int g = u.pm >> 2, rt = u.pm & 3;
#pragma unroll
        for (int ai = 0; ai < 2; ++ai)
#pragma unroll
            for (int m = 0; m < 4; ++m) { const int c = rt * 256 + ai * 128 + wr * 64 + m * 16 + fr;
#pragma unroll
                for (int bj = 0; bj < 2; ++bj) { const int n8 = u.pn * 256 + bj * 128 + wc * 32 + 8 * fq, i = n8 >> 4, h0 = n8 & 15;
                    f32x4 v0 = acc[ai][bj][m][0], v1 = acc[ai][bj][m][1];
#pragma unroll
                    for (int e = 0; e < 4; ++e) { v0[e] = gelu_fast(v0[e]); v1[e] = gelu_fast(v1[e]); }
                    *(u32x4*)(yg + ((size_t)c * 64 + i) * 512 + g * 16 + h0) = pack8(v0, v1); } }
    }
};
__device__ __forceinline__ void phase_p4(const P& p, char* lds) {
    OrderToep S; S.pt.UG = p.ws + OFF_UG; S.pt.W = p.ws + OFF_WT; S.G = (int)gridDim.x; S.c = (int)blockIdx.x;
    EpiY E; E.yg = (bf16_t*)(p.ws + OFF_YG);
    Gemm g; g.K = 1152; g.lda = 1152; g.ldb = 1152;
    pg8::gemm_phase<EpiY, OrderToep, false>((PG8_LAS unsigned char*)lds, g, S, E, nullptr);
}
struct EpiG {
    static constexpr bool PERM = true, AFTER_DRAIN = false;
    const bf16_t* yg; bf16_t* ys5; float* parts5; const float* b_glu;
    __device__ __forceinline__ void operator()(const f32x4 (&acc)[2][2][4][2], const Unit& u, int wr, int wc, int fr_, int fq_) const {
        int fr = fr_, fq = fq_; asm volatile("" : "+v"(fr), "+v"(fq));
#pragma unroll
        for (int bj = 0; bj < 2; ++bj) { const int c32 = u.pn * 256 + bj * 128 + wc * 32, c8 = c32 + 8 * fq;
            const f32x4 bg0 = *(const f32x4*)(b_glu + c8), bg1 = *(const f32x4*)(b_glu + c8 + 4);
#pragma unroll
            for (int ai = 0; ai < 2; ++ai)
#pragma unroll
                for (int m = 0; m < 4; ++m) { const int t = u.pm * 256 + ai * 128 + wr * 64 + m * 16 + fr;
                    const u32x4 yw = *(const u32x4*)(yg + (size_t)t * 512 + c8);
                    const f32x4 z0 = acc[ai][bj][m][0] + bg0, z1 = acc[ai][bj][m][1] + bg1; f32x4 o0, o1;
#pragma unroll
                    for (int e = 0; e < 4; ++e) { const unsigned w0 = yw[e >> 1], w1 = yw[2 + (e >> 1)];
                        const float y0 = (e & 1) ? __uint_as_float(w0 & 0xffff0000u) : __uint_as_float(w0 << 16), y1 = (e & 1) ? __uint_as_float(w1 & 0xffff0000u) : __uint_as_float(w1 << 16);
                        o0[e] = y0 * __builtin_amdgcn_rcpf(1.0f + __builtin_amdgcn_exp2f(-1.4426950408889634f * z0[e])); o1[e] = y1 * __builtin_amdgcn_rcpf(1.0f + __builtin_amdgcn_exp2f(-1.4426950408889634f * z1[e])); }
                    float sq = (o0[0] * o0[0] + o0[1] * o0[1]) + (o0[2] * o0[2] + o0[3] * o0[3]) + (o1[0] * o1[0] + o1[1] * o1[1]) + (o1[2] * o1[2] + o1[3] * o1[3]);
                    sq += __shfl_xor(sq, 16); sq += __shfl_xor(sq, 32);
                    *(u32x4*)(ys5 + (size_t)t * 512 + c8) = pack8(o0, o1);
                    if (fq == 0) parts5[(size_t)t * 16 + (c32 >> 5)] = sq; }
            asm volatile("" ::: "memory"); }
    }
};
__device__ __forceinline__ void phase_p5(const P& p, char* lds) {
    OrderT<PtrAB> S; PtrAB pt; pt.A = p.ws + OFF_YG; pt.B = p.ws + OFF_BTG; pt.sa = (size_t)256 * 512 * 2; pt.sb = (size_t)256 * 512 * 2; S.init(T / 256, 2, (int)gridDim.x, (int)blockIdx.x, pt);
    EpiG E; E.yg = (const bf16_t*)(p.ws + OFF_YG); E.ys5 = (bf16_t*)(p.ws + OFF_YS5); E.parts5 = (float*)(p.ws + OFF_PS5); E.b_glu = p.b_glu;
    Gemm g; g.K = 512; g.lda = 512; g.ldb = 512;
    pg8::gemm_phase<EpiG, OrderT<PtrAB>, false>((PG8_LAS unsigned char*)lds, g, S, E, nullptr);
}

struct EpiPlain {
    static constexpr bool PERM = true, AFTER_DRAIN = false;
    bf16_t* O; int ldc, coff;
    __device__ __forceinline__ void operator()(const f32x4 (&acc)[2][2][4][2], const Unit& u, int wr, int wc, int fr_, int fq_) const {
        int fr = fr_, fq = fq_; asm volatile("" : "+v"(fr), "+v"(fq));
#pragma unroll
        for (int ai = 0; ai < 2; ++ai)
#pragma unroll
            for (int m = 0; m < 4; ++m) { bf16_t* rowp = O + (size_t)(u.pm * 256 + ai * 128 + wr * 64 + m * 16 + fr) * ldc + coff + u.pn * 256 + wc * 32 + 8 * fq;
#pragma unroll
                for (int bj = 0; bj < 2; ++bj) *(u32x4*)(rowp + bj * 128) = pack8(acc[ai][bj][m][0], acc[ai][bj][m][1]); }
    }
};
struct PtrP6 { const char* A1; const char* A2; const char* B1; const char* B2;
    __device__ void fill(Unit& u, int PM, int pn) const { u.pm = PM; u.pn = pn; u.pz = 0; const size_t st = (size_t)256 * 512 * 2;
        u.a = (pn < 4 ? A1 : A2) + (size_t)PM * st; u.b = pn < 4 ? B1 + (size_t)pn * st : B2 + (size_t)(pn - 4) * st; } };
__device__ __forceinline__ void phase_p6(const P& p, char* lds) {
    bf16_t* Y12 = (bf16_t*)p.out;
    OrderT<PtrP6> S; PtrP6 pt; pt.A1 = p.ws + OFF_YS5; pt.A2 = p.ws + OFF_YMLA; pt.B1 = p.ws + OFF_BTO1; pt.B2 = p.ws + OFF_BTO2; S.init(T / 256, 8, (int)gridDim.x, (int)blockIdx.x, pt);
    EpiPlain E; E.O = Y12; E.ldc = 2048; E.coff = 0; Gemm g; g.K = 512; g.lda = 512; g.ldb = 512;
    pg8::gemm_phase<EpiPlain, OrderT<PtrP6>, false>((PG8_LAS unsigned char*)lds, g, S, E, nullptr);
}
constexpr size_t OFF_X1 = OFF_R1, OFF_H2 = OFF_R6;
constexpr float DN_ALPHA = 1.189207115002721f;
__device__ __forceinline__ void unpack8(const u32x4 w, float (&o)[8]) {
#pragma unroll
    for (int i = 0; i < 4; ++i) { o[2 * i] = __uint_as_float(w[i] << 16); o[2 * i + 1] = __uint_as_float(w[i] & 0xffff0000u); } }
__device__ __forceinline__ void phase_p7(const P& p, char* lds) {
    const int tid = otid(), lane = tid & 63, w = tid >> 6, c0 = lane * 16;
    const bf16_t* Y12 = (const bf16_t*)p.out; const float* mod = (const float*)(p.ws + OFF_MOD);
    for (int tb = blockIdx.x; tb < T / 256; tb += gridDim.x) {
        const int b = (tb * 256) >> 13; const float* mb = mod + b * 6144;
        float g1[16], sc2[16], sh2[16], lg[16], lb[16];
#pragma unroll
        for (int i = 0; i < 16; ++i) { g1[i] = 1.0f + mb[2048 + c0 + i]; sc2[i] = 1.0f + mb[4096 + c0 + i]; sh2[i] = mb[3072 + c0 + i]; lg[i] = p.ln1_g[c0 + i]; lb[i] = p.ln1_b[c0 + i]; }
        for (int it = 0; it < 32; ++it) { const int t = tb * 256 + it * 8 + w;
            const float* ps = (const float*)(p.ws + OFF_PS5) + (size_t)t * 16; const float* pm = (const float*)(p.ws + OFF_PMLA) + (size_t)t * 8;
            float s5 = 0.f, sm = 0.f;
#pragma unroll
            for (int i = 0; i < 16; ++i) s5 += ps[i];
#pragma unroll
            for (int i = 0; i < 8; ++i) sm += pm[i];
            const float r5 = 1.0f / sqrtf(s5 * (1.0f / 512.0f) + 1e-6f), rm = 1.0f / sqrtf(sm * (1.0f / 512.0f) + 1e-6f);
            float y1[16], y2[16], v[16];
            unpack8(*(const u32x4*)(Y12 + (size_t)t * 2048 + c0), *(float(*)[8])&y1[0]); unpack8(*(const u32x4*)(Y12 + (size_t)t * 2048 + c0 + 8), *(float(*)[8])&y1[8]);
            unpack8(*(const u32x4*)(Y12 + (size_t)t * 2048 + 1024 + c0), *(float(*)[8])&y2[0]); unpack8(*(const u32x4*)(Y12 + (size_t)t * 2048 + 1024 + c0 + 8), *(float(*)[8])&y2[8]);
            float sum = 0.f;
#pragma unroll
            for (int i = 0; i < 4; ++i) { const f32x4 xv = *(const f32x4*)(p.x + (size_t)t * 1024 + c0 + 4 * i);
#pragma unroll
                for (int e = 0; e < 4; ++e) { const int k = 4 * i + e; v[k] = DN_ALPHA * xv[e] + g1[k] * (r5 * y1[k] + rm * y2[k]); sum += v[k]; } }
#pragma unroll
            for (int o = 32; o > 0; o >>= 1) sum += __shfl_xor(sum, o);
            const float mu = sum * (1.0f / 1024.0f); float q = 0.f;
#pragma unroll
            for (int k = 0; k < 16; ++k) { const float d = v[k] - mu; q += d * d; }
#pragma unroll
            for (int o = 32; o > 0; o >>= 1) q += __shfl_xor(q, o);
            const float rstd = 1.0f / sqrtf(q * (1.0f / 1024.0f) + 1e-6f);
            f32x4 a[4], hh[4];
#pragma unroll
            for (int k = 0; k < 16; ++k) { const float x1 = (v[k] - mu) * rstd * lg[k] + lb[k]; a[k >> 2][k & 3] = x1; hh[k >> 2][k & 3] = x1 * sc2[k] + sh2[k]; }
            *(u32x4*)((bf16_t*)(p.ws + OFF_X1) + (size_t)t * 1024 + c0) = pack8(a[0], a[1]); *(u32x4*)((bf16_t*)(p.ws + OFF_X1) + (size_t)t * 1024 + c0 + 8) = pack8(a[2], a[3]);
            *(u32x4*)((bf16_t*)(p.ws + OFF_H2) + (size_t)t * 1024 + c0) = pack8(hh[0], hh[1]); *(u32x4*)((bf16_t*)(p.ws + OFF_H2) + (size_t)t * 1024 + c0 + 8) = pack8(hh[2], hh[3]);
        }
    }
}
struct EpiS {
    static constexpr bool PERM = true, AFTER_DRAIN = false;
    bf16_t* S;
    __device__ __forceinline__ void operator()(const f32x4 (&acc)[2][2][4][2], const Unit& u, int wr, int wc, int fr_, int fq_) const {
        int fr = fr_, fq = fq_; asm volatile("" : "+v"(fr), "+v"(fq));
#pragma unroll
        for (int ai = 0; ai < 2; ++ai)
#pragma unroll
            for (int m = 0; m < 4; ++m) { const int t = u.pm * 256 + ai * 128 + wr * 64 + m * 16 + fr;
#pragma unroll
                for (int bj = 0; bj < 2; ++bj) { const int c8 = bj * 128 + wc * 32 + 8 * fq;
                    *(u32x4*)(S + ((((size_t)(t >> 6) * 8 + u.pn) * 32 + (c8 >> 3)) * 64 + (t & 63)) * 8) = pack8(acc[ai][bj][m][0], acc[ai][bj][m][1]); } }
    }
};
__device__ __forceinline__ void phase_p8(const P& p, char* lds) {
    OrderT<PtrAB> S; PtrAB pt; pt.A = p.ws + OFF_H2; pt.B = p.ws + OFF_WST; pt.sa = (size_t)256 * 1024 * 2; pt.sb = (size_t)256 * 1024 * 2; S.init(T / 256, 8, (int)gridDim.x, (int)blockIdx.x, pt);
    EpiS E; E.S = (bf16_t*)p.out; Gemm g; g.K = 1024; g.lda = 1024; g.ldb = 1024;
    pg8::gemm_phase<EpiS, OrderT<PtrAB>, false>((PG8_LAS unsigned char*)lds, g, S, E, nullptr);
}
constexpr size_t OFF_PK = OFF_R2;
#define FK_MED3(a, b, c) __builtin_amdgcn_fmed3f(a, b, c)
#define FK_INS16(L, x) { _Pragma("unroll") for (int j_ = 15; j_ >= 1; --j_) L[j_] = FK_MED3(L[j_ - 1], L[j_], (x)); L[0] = fmaxf(L[0], (x)); }
__device__ __forceinline__ void topk128(const bf16_t* sp, float (&L)[16]) {
#pragma unroll
    for (int j = 0; j < 16; ++j) L[j] = -INFINITY;
#pragma unroll 8
    for (int cg = 0; cg < 16; ++cg) { const u32x4 w = *(const u32x4*)(sp + (size_t)cg * 512);
#pragma unroll
        for (int i = 0; i < 4; ++i) { const float x0 = __uint_as_float((w[i] << 16) | (unsigned)(cg * 8 + 2 * i)), x1 = __uint_as_float((w[i] & 0xffff0000u) | (unsigned)(cg * 8 + 2 * i + 1));
            FK_INS16(L, x0) FK_INS16(L, x1) } }
}
__device__ __forceinline__ void phase_p9(const P& p, char* lds) {
    const int tid = otid(), lane = tid & 63, h = tid >> 6;
    const float* scu = (const float*)(p.ws + OFF_SCU); const float* scv = (const float*)(p.ws + OFF_SCV);
    for (int tb = blockIdx.x; tb < T / 64; tb += gridDim.x) {
        const bf16_t* sp = (const bf16_t*)p.out + (((size_t)tb * 8 + h) * 32 * 64 + lane) * 8;
        float A[16], B[16], TL[16];
        topk128(sp, A); topk128(sp + (size_t)16 * 512, B);
#pragma unroll
        for (int j = 0; j < 16; ++j) TL[j] = -INFINITY;
#pragma unroll
        for (int i = 0; i < 16; ++i)
#pragma unroll
            for (int j = 0; j < 16; ++j) if ((i + 1) * (j + 1) <= 16) {
                const unsigned ua = __float_as_uint(A[i]), ub = __float_as_uint(B[j]);
                const float sum = __uint_as_float(ua & 0xffffff80u) + __uint_as_float(ub & 0xffffff80u);
                const float key = __uint_as_float((__float_as_uint(sum) & 0xffffc000u) | ((ua & 127u) << 7) | (ub & 127u));
                FK_INS16(TL, key) }
        float e[16], den = 0.f; const float m0 = __uint_as_float(__float_as_uint(TL[0]) & 0xffffc000u);
#pragma unroll
        for (int j = 0; j < 16; ++j) { e[j] = __builtin_amdgcn_exp2f((__uint_as_float(__float_as_uint(TL[j]) & 0xffffc000u) - m0) * 1.4426950408889634f); den += e[j]; }
        const float rden = 1.0f / den;
        unsigned long long* pk = (unsigned long long*)(p.ws + OFF_PK) + ((size_t)(tb * 64 + lane) * 8 + h) * 16;
#pragma unroll
        for (int j = 0; j < 16; j += 2) { const unsigned id0 = __float_as_uint(TL[j]) & 0x3fffu, id1 = __float_as_uint(TL[j + 1]) & 0x3fffu;
            const float su0 = scu[id0], su1 = scu[id1], gv0 = e[j] * rden * scv[id0], gv1 = e[j + 1] * rden * scv[id1];
            u32x4 w; w.x = id0 | (cvt_pk_bf16(su0, 0.f) << 16); w.y = __float_as_uint(gv0); w.z = id1 | (cvt_pk_bf16(su1, 0.f) << 16); w.w = __float_as_uint(gv1);
            *(u32x4*)(pk + j) = w; }
    }
}
__device__ __forceinline__ f32x32 cvt32(const u32x3 a, const u32x3 b) { u32x6 w; w[0] = a.x; w[1] = a.y; w[2] = a.z; w[3] = b.x; w[4] = b.y; w[5] = b.z; return __builtin_amdgcn_cvt_scalef32_pk32_f32_fp6(w, 1.0f); }
__device__ __forceinline__ void phase_p10(const P& p, char* lds) {
    const int tid = otid(), lane = tid & 63; const int w = __builtin_amdgcn_readfirstlane(tid >> 6);
    const float* mod = (const float*)(p.ws + OFF_MOD); const unsigned l12 = (unsigned)lane * 12u;
    const __amdgpu_buffer_rsrc_t ru = __builtin_amdgcn_make_buffer_rsrc((void*)(p.ws + OFF_TU8), 0, 16384 * 768, 0x00020000), rv = __builtin_amdgcn_make_buffer_rsrc((void*)(p.ws + OFF_TV8), 0, 16384 * 768, 0x00020000);
    const int jl = ((lane >> 5) & 1) * 8 + ((lane >> 4) & 1) * 4 + ((lane >> 3) & 1) * 2 + ((lane >> 2) & 1);
    for (int t = blockIdx.x * 8 + w; t < T; t += gridDim.x * 8) {
        int c0 = lane * 16; asm volatile("" : "+v"(c0));
        float hv[16], acc[16];
        unpack8(*(const u32x4*)((const bf16_t*)(p.ws + OFF_H2) + (size_t)t * 1024 + c0), *(float(*)[8])&hv[0]); unpack8(*(const u32x4*)((const bf16_t*)(p.ws + OFF_H2) + (size_t)t * 1024 + c0 + 8), *(float(*)[8])&hv[8]);
#pragma unroll
        for (int i = 0; i < 16; ++i) acc[i] = 0.f;
        const unsigned long long* pk = (const unsigned long long*)(p.ws + OFF_PK) + (size_t)t * 128;
#pragma unroll 1
        for (int h = 0; h < 8; ++h) {
            unsigned ids[16];
#pragma unroll
            for (int j = 0; j < 16; ++j) ids[j] = (unsigned)__builtin_amdgcn_readfirstlane((int)(unsigned)pk[h * 16 + j]) & 0x3fffu;
            u32x3 ur[16], vr[16];
#pragma unroll
            for (int j = 0; j < 16; ++j) ur[j] = __builtin_amdgcn_raw_buffer_load_b96(ru, l12, ids[j] * 768u, 0);
#pragma unroll
            for (int j = 0; j < 8; ++j) vr[j] = __builtin_amdgcn_raw_buffer_load_b96(rv, l12, ids[j] * 768u, 0);
            const unsigned long long mine = pk[h * 16 + jl];
            float d[16];
#pragma unroll
            for (int j = 0; j < 16; j += 2) { const f32x32 uf = cvt32(ur[j], ur[j + 1]); f32x2 a0 = {0.f, 0.f}, a1 = {0.f, 0.f};
#pragma unroll
                for (int i = 0; i < 16; i += 2) { const f32x2 h2 = {hv[i], hv[i + 1]}; a0 += (f32x2){uf[i], uf[i + 1]} * h2; a1 += (f32x2){uf[16 + i], uf[17 + i]} * h2; }
                d[j] = a0[0] + a0[1]; d[j + 1] = a1[0] + a1[1]; }
            __builtin_amdgcn_sched_barrier(0);
#pragma unroll
            for (int j = 8; j < 16; ++j) vr[j] = __builtin_amdgcn_raw_buffer_load_b96(rv, l12, ids[j] * 768u, 0);
            { const bool b5 = lane & 32;
#pragma unroll
              for (int j = 0; j < 8; ++j) { const float keep = b5 ? d[j + 8] : d[j], give = b5 ? d[j] : d[j + 8]; d[j] = keep + __shfl_xor(give, 32); }
              const bool b4 = lane & 16;
#pragma unroll
              for (int j = 0; j < 4; ++j) { const float keep = b4 ? d[j + 4] : d[j], give = b4 ? d[j] : d[j + 4]; d[j] = keep + __shfl_xor(give, 16); }
              const bool b3 = lane & 8;
#pragma unroll
              for (int j = 0; j < 2; ++j) { const float keep = b3 ? d[j + 2] : d[j], give = b3 ? d[j] : d[j + 2]; d[j] = keep + __shfl_xor(give, 8); }
              const bool b2 = lane & 4;
              { const float keep = b2 ? d[1] : d[0], give = b2 ? d[0] : d[1]; d[0] = keep + __shfl_xor(give, 4); }
              d[0] += __shfl_xor(d[0], 2); d[0] += __shfl_xor(d[0], 1); }
            const float su = __uint_as_float(((unsigned)mine) & 0xffff0000u), gsv = __uint_as_float((unsigned)(mine >> 32));
            const float pre = d[0] * su; const float wgt = gsv * gelu_fast(pre);
#pragma unroll
            for (int j = 0; j < 16; j += 2) { const int src0 = ((j >> 3) & 1) * 32 + ((j >> 2) & 1) * 16 + ((j >> 1) & 1) * 8 + (j & 1) * 4, src1 = src0 + 4;
                const float w0 = __uint_as_float((unsigned)__builtin_amdgcn_readlane((int)__float_as_uint(wgt), src0)), w1 = __uint_as_float((unsigned)__builtin_amdgcn_readlane((int)__float_as_uint(wgt), src1));
                const f32x32 vf = cvt32(vr[j], vr[j + 1]);
#pragma unroll
                for (int i = 0; i < 16; ++i) acc[i] += w0 * vf[i] + w1 * vf[16 + i]; }
        }
        const float* mb = mod + (t >> 13) * 6144; float x1[16], v[16], sum = 0.f;
        unpack8(*(const u32x4*)((const bf16_t*)(p.ws + OFF_X1) + (size_t)t * 1024 + c0), *(float(*)[8])&x1[0]); unpack8(*(const u32x4*)((const bf16_t*)(p.ws + OFF_X1) + (size_t)t * 1024 + c0 + 8), *(float(*)[8])&x1[8]);
#pragma unroll
        for (int i = 0; i < 4; ++i) { const f32x4 g2 = *(const f32x4*)(mb + 5120 + c0 + 4 * i);
#pragma unroll
            for (int e = 0; e < 4; ++e) { const int k = 4 * i + e; v[k] = DN_ALPHA * x1[k] + (1.0f + g2[e]) * acc[k]; sum += v[k]; } }
#pragma unroll
        for (int o = 32; o > 0; o >>= 1) sum += __shfl_xor(sum, o);
        const float mu = sum * (1.0f / 1024.0f); float q = 0.f;
#pragma unroll
        for (int k = 0; k < 16; ++k) { const float dd = v[k] - mu; q += dd * dd; }
#pragma unroll
        for (int o = 32; o > 0; o >>= 1) q += __shfl_xor(q, o);
        const float rstd = 1.0f / sqrtf(q * (1.0f / 1024.0f) + 1e-6f);
#pragma unroll
        for (int i = 0; i < 4; ++i) { const f32x4 lg = *(const f32x4*)(p.ln2_g + c0 + 4 * i), lb = *(const f32x4*)(p.ln2_b + c0 + 4 * i); f32x4 o;
#pragma unroll
            for (int e = 0; e < 4; ++e) o[e] = (v[4 * i + e] - mu) * rstd * lg[e] + lb[e];
            *(f32x4*)(p.out + (size_t)t * 1024 + c0 + 4 * i) = o; }
    }
}

__device__ __forceinline__ void phase_p9p10(const P& p, char* lds) {
    const int tid = otid();
    const float* scu = (const float*)(p.ws + OFF_SCU); const float* scu4 = (const float*)(p.ws + OFF_SCU4); const float* scv = (const float*)(p.ws + OFF_SCV);

    const int w = __builtin_amdgcn_readfirstlane(tid >> 6);
    const float* mod = (const float*)(p.ws + OFF_MOD);
    const __amdgpu_buffer_rsrc_t ru = __builtin_amdgcn_make_buffer_rsrc((void*)(p.ws + OFF_TU8), 0, 16384 * 768, 0x00020000), rv = __builtin_amdgcn_make_buffer_rsrc((void*)(p.ws + OFF_TV8), 0, 16384 * 512, 0x00020000), ru4 = __builtin_amdgcn_make_buffer_rsrc((void*)(p.ws + OFF_TU4), 0, 16384 * 512, 0x00020000), ruv = __builtin_amdgcn_make_buffer_rsrc((void*)(p.ws + OFF_TV8), 0, 16384 * 1024, 0x00020000);
    const int nb = (T / 64 - (int)blockIdx.x + (int)gridDim.x - 1) / (int)gridDim.x;
    volatile PG8_LAS unsigned* qcnt = (volatile PG8_LAS unsigned*)(lds + 131072 + 64);
    if (tid == 0) { qcnt[0] = 0u; qcnt[1] = 0u; }
#pragma unroll 1
    for (int st = 0; st <= nb; ++st) {
      if (st == 0 || w == 7) {
        if (st >= 1 && (int)__builtin_amdgcn_mbcnt_hi(~0u, __builtin_amdgcn_mbcnt_lo(~0u, 0u)) == 0) qcnt[(st + 1) & 1] = 0u;
        if (st < nb) {
        const int tb = (int)blockIdx.x + st * (int)gridDim.x; char* ldb = lds + (st & 1) * 65536;
        const int h0 = st == 0 ? w : 0, h1 = st == 0 ? w + 1 : 8;
#pragma unroll 1
        for (int hh = h0; hh < h1; ++hh) {
        int lane_o = (int)__builtin_amdgcn_mbcnt_hi(~0u, __builtin_amdgcn_mbcnt_lo(~0u, 0u)); asm volatile("" : "+v"(lane_o));
        const bf16_t* sp = (const bf16_t*)p.out + (((size_t)tb * 8 + hh) * 32 * 64 + lane_o) * 8;
        float A[16], B[16], TL[16];
        topk128(sp, A); topk128(sp + (size_t)16 * 512, B);
#pragma unroll
        for (int j = 0; j < 16; ++j) TL[j] = -INFINITY;
#pragma unroll
        for (int i = 0; i < 16; ++i)
#pragma unroll
            for (int j = 0; j < 16; ++j) if ((i + 1) * (j + 1) <= 16) {
                const unsigned ua = __float_as_uint(A[i]), ub = __float_as_uint(B[j]);
                const float sum = __uint_as_float(ua & 0xffffff80u) + __uint_as_float(ub & 0xffffff80u);
                const float key = __uint_as_float((__float_as_uint(sum) & 0xffffc000u) | ((ua & 127u) << 7) | (ub & 127u));
                FK_INS16(TL, key) }
        float e[16], den = 0.f; const float m0 = __uint_as_float(__float_as_uint(TL[0]) & 0xffffc000u);
#pragma unroll
        for (int j = 0; j < 16; ++j) { e[j] = __builtin_amdgcn_exp2f((__uint_as_float(__float_as_uint(TL[j]) & 0xffffc000u) - m0) * 1.4426950408889634f); den += e[j]; }
        const float rden = 1.0f / den;
        PG8_LAS unsigned long long* pk = (PG8_LAS unsigned long long*)ldb + (lane_o * 8 + hh) * 16;
#pragma unroll
        for (int j = 0; j < 16; j += 2) { const unsigned id0 = __float_as_uint(TL[j]) & 0x3fffu, id1 = __float_as_uint(TL[j + 1]) & 0x3fffu;
            const float su0 = scu4[id0], su1 = scu4[id1], gv0 = e[j] * rden * scv[id0], gv1 = e[j + 1] * rden * scv[id1];
            u32x4 w; w.x = id0 | (cvt_pk_bf16(su0, 0.f) << 16); w.y = __float_as_uint(gv0); w.z = id1 | (cvt_pk_bf16(su1, 0.f) << 16); w.w = __float_as_uint(gv1);
            *(PG8_LAS u32x4*)(pk + j) = w; }
        }
            asm volatile("s_waitcnt lgkmcnt(0)" ::: "memory");
        }
      } else {
        const int tb = (int)blockIdx.x + (st - 1) * (int)gridDim.x; const char* ldb = lds + ((st - 1) & 1) * 65536;
        if (w & 1) __builtin_amdgcn_s_setprio(2); else __builtin_amdgcn_s_setprio(1);
        for (;;) { int c0 = (int)__builtin_amdgcn_mbcnt_hi(~0u, __builtin_amdgcn_mbcnt_lo(~0u, 0u)) * 16; asm volatile("" : "+v"(c0)); unsigned tk = 0u; if (c0 == 0) tk = __hip_atomic_fetch_add((PG8_LAS unsigned*)(lds + 131072 + 64) + (st & 1), 1u, __ATOMIC_RELAXED, __HIP_MEMORY_SCOPE_WORKGROUP);
            const int tl = __builtin_amdgcn_readfirstlane((int)tk); if (tl >= 64) break; const int t = tb * 64 + tl;
        const int jl = ((c0 >> 9) & 1) * 8 + ((c0 >> 8) & 1) * 4 + ((c0 >> 7) & 1) * 2 + ((c0 >> 6) & 1);
        typedef int i32x8 __attribute__((ext_vector_type(8)));
        const int ln = c0 >> 4, nn = ln & 15, cch = ln >> 4, jpar = nn & 1, e8 = nn >> 1;
        float acc[16]; float hinv; i32x8 Bq[4];
        {
            const bf16_t* hp = (const bf16_t*)(p.ws + OFF_H2) + (size_t)t * 1024 + 128 * jpar + 16 * cch;
            u32x4 hr[16];
#pragma unroll
            for (int q = 0; q < 4; ++q) { hr[4 * q] = *(const u32x4*)(hp + 256 * q); hr[4 * q + 1] = *(const u32x4*)(hp + 256 * q + 8); hr[4 * q + 2] = *(const u32x4*)(hp + 256 * q + 64); hr[4 * q + 3] = *(const u32x4*)(hp + 256 * q + 72); }
            unsigned mx = 0u;
#pragma unroll
            for (int i = 0; i < 16; ++i)
#pragma unroll
                for (int d = 0; d < 4; ++d) { const unsigned wv = hr[i][d]; mx = max(mx, (wv << 16) & 0x7fff0000u); mx = max(mx, wv & 0x7fff0000u); }
            float am = __uint_as_float(mx);
            am = fmaxf(am, __uint_as_float((unsigned)__builtin_amdgcn_ds_swizzle((int)__float_as_uint(am), (1 << 10) | 0x1f))); am = fmaxf(am, __uint_as_float((unsigned)__builtin_amdgcn_ds_swizzle((int)__float_as_uint(am), (16 << 10) | 0x1f)));
            { const auto r2 = __builtin_amdgcn_permlane32_swap(__float_as_uint(am), __float_as_uint(am), false, false); am = fmaxf(__uint_as_float(r2[0]), __uint_as_float(r2[1])); }
            const unsigned E = (__float_as_uint(am) >> 23) & 0xffu; const bool okE = E >= 8u && E <= 250u;
            const float hsc = okE ? __uint_as_float((261u - E) << 23) : 1.0f; hinv = okE ? __uint_as_float((E - 7u) << 23) : 1.0f;
#pragma unroll
            for (int q = 0; q < 4; ++q) { float hf[32];
                unpack8(hr[4 * q], *(float(*)[8])&hf[0]); unpack8(hr[4 * q + 1], *(float(*)[8])&hf[8]); unpack8(hr[4 * q + 2], *(float(*)[8])&hf[16]); unpack8(hr[4 * q + 3], *(float(*)[8])&hf[24]);
#pragma unroll
                for (int d4 = 0; d4 < 8; ++d4) { int p_ = __builtin_amdgcn_cvt_pk_fp8_f32(hf[4 * d4] * hsc, hf[4 * d4 + 1] * hsc, 0, false); p_ = __builtin_amdgcn_cvt_pk_fp8_f32(hf[4 * d4 + 2] * hsc, hf[4 * d4 + 3] * hsc, p_, true); Bq[q][d4] = p_; } } }
#pragma unroll
        for (int i = 0; i < 16; ++i) acc[i] = 0.f;
        const PG8_LAS unsigned long long* pk = (const PG8_LAS unsigned long long*)ldb + tl * 128;
#pragma unroll 1
        for (int h = 0; h < 8; ++h) {
            const unsigned idu0 = (unsigned)pk[h * 16 + e8] & 0x3fffu, idu1 = (unsigned)pk[h * 16 + 8 + e8] & 0x3fffu;
            const unsigned lo = (unsigned)((4 * jpar + cch) * 16);
            u32x4 ua[2][4];
#pragma unroll
            for (int q = 0; q < 4; ++q) { ua[0][q] = __builtin_amdgcn_raw_buffer_load_b128(ru4, idu0 * 512u + lo, (unsigned)q * 128u, 0); ua[1][q] = __builtin_amdgcn_raw_buffer_load_b128(ru4, idu1 * 512u + lo, (unsigned)q * 128u, 0); }
            unsigned ids[16];
#pragma unroll
            for (int j = 0; j < 16; ++j) ids[j] = (unsigned)__builtin_amdgcn_readfirstlane((int)(unsigned)pk[h * 16 + j]) & 0x3fffu;
            u32x2 vr[16];
#pragma unroll
            for (int j = 0; j < 16; ++j) vr[j] = __builtin_amdgcn_raw_buffer_load_b64(rv, (unsigned)c0 >> 1, ids[j] * 512u, 0);
            const u32x4 en0 = *(const PG8_LAS u32x4*)(pk + h * 16 + 2 * cch), en1 = *(const PG8_LAS u32x4*)(pk + h * 16 + 8 + 2 * cch);
            float wg[2][2];
#pragma unroll
            for (int G = 0; G < 2; ++G) { f32x4 cm = {0.f, 0.f, 0.f, 0.f};
#pragma unroll
                for (int q = 0; q < 4; ++q) { i32x8 A; A[0] = (int)ua[G][q].x; A[1] = (int)ua[G][q].y; A[2] = (int)ua[G][q].z; A[3] = (int)ua[G][q].w; A[4] = 0; A[5] = 0; A[6] = 0; A[7] = 0;
                    cm = __builtin_amdgcn_mfma_scale_f32_16x16x128_f8f6f4(A, Bq[q], cm, 4, 0, 0, 0x7f7f7f7f, 0, 0x7f7f7f7f); }
                const float x0 = jpar ? cm[1] : cm[0], x1 = jpar ? cm[3] : cm[2];
                const float t0 = x0 + __uint_as_float((unsigned)__builtin_amdgcn_ds_swizzle((int)__float_as_uint(x0), (1 << 10) | 0x1f)), t1 = x1 + __uint_as_float((unsigned)__builtin_amdgcn_ds_swizzle((int)__float_as_uint(x1), (1 << 10) | 0x1f));
                const u32x4 en = G ? en1 : en0;
                wg[G][0] = __uint_as_float(en.y) * gelu_fast(t0 * (__uint_as_float(en.x & 0xffff0000u) * hinv)); wg[G][1] = __uint_as_float(en.w) * gelu_fast(t1 * (__uint_as_float(en.z & 0xffff0000u) * hinv)); }
#pragma unroll
            for (int j = 0; j < 16; ++j) {
                const float wj = __uint_as_float((unsigned)__builtin_amdgcn_readlane((int)__float_as_uint(wg[j >> 3][j & 1]), ((j & 7) >> 1) * 16));
#define FK_AX4(B4) { const auto lo2 = __builtin_amdgcn_cvt_scalef32_pk_f32_fp4(vr[j].x, 1.0f, B4), hi2 = __builtin_amdgcn_cvt_scalef32_pk_f32_fp4(vr[j].y, 1.0f, B4); \
                    acc[2 * B4] += wj * lo2[0]; acc[2 * B4 + 1] += wj * lo2[1]; acc[8 + 2 * B4] += wj * hi2[0]; acc[8 + 2 * B4 + 1] += wj * hi2[1]; }
                FK_AX4(0) FK_AX4(1) FK_AX4(2) FK_AX4(3)
#undef FK_AX4
            }
        }
        const float* mb = mod + (t >> 13) * 6144; float x1[16], v[16], sum = 0.f;
        unpack8(*(const u32x4*)((const bf16_t*)(p.ws + OFF_X1) + (size_t)t * 1024 + c0), *(float(*)[8])&x1[0]); unpack8(*(const u32x4*)((const bf16_t*)(p.ws + OFF_X1) + (size_t)t * 1024 + c0 + 8), *(float(*)[8])&x1[8]);
#pragma unroll
        for (int i = 0; i < 4; ++i) { const f32x4 g2 = *(const f32x4*)(mb + 5120 + c0 + 4 * i);
#pragma unroll
            for (int e = 0; e < 4; ++e) { const int k = 4 * i + e; v[k] = DN_ALPHA * x1[k] + (1.0f + g2[e]) * acc[k]; sum += v[k]; } }
#pragma unroll
        for (int o = 32; o > 0; o >>= 1) sum += __shfl_xor(sum, o);
        const float mu = sum * (1.0f / 1024.0f); float q = 0.f;
#pragma unroll
        for (int k = 0; k < 16; ++k) { const float dd = v[k] - mu; q += dd * dd; }
#pragma unroll
        for (int o = 32; o > 0; o >>= 1) q += __shfl_xor(q, o);
        const float rstd = 1.0f / sqrtf(q * (1.0f / 1024.0f) + 1e-6f);
#pragma unroll
        for (int i = 0; i < 4; ++i) { const f32x4 lg = *(const f32x4*)(p.ln2_g + c0 + 4 * i), lb = *(const f32x4*)(p.ln2_b + c0 + 4 * i); f32x4 o;
#pragma unroll
            for (int e = 0; e < 4; ++e) o[e] = (v[4 * i + e] - mu) * rstd * lg[e] + lb[e];
            *(f32x4*)(p.out + (size_t)t * 1024 + c0 + 4 * i) = o; }
    }
        __builtin_amdgcn_s_setprio(0);
      }
      __syncthreads();
    }
}

template <int PH> __global__ __launch_bounds__(512, 2) void k_phase(P p) {
    extern __shared__ __attribute__((aligned(16))) char lds[];
    if constexpr (PH == 0) phase_p0a(p, lds);
    if constexpr (PH == 1) phase_p0b(p, lds);
    if constexpr (PH == 2) phase_p1(p, lds);
    if constexpr (PH == 3) phase_p2(p, lds);
    if constexpr (PH == 4) phase_p3(p, lds);
    if constexpr (PH == 5) phase_p0c(p, lds);
    if constexpr (PH == 6) phase_p4(p, lds);
    if constexpr (PH == 7) phase_p5(p, lds);
    if constexpr (PH == 8) phase_p0d(p, lds);
    if constexpr (PH == 9) phase_p6(p, lds);
    if constexpr (PH == 10) phase_p7(p, lds);
    if constexpr (PH == 11) phase_p8(p, lds);
    if constexpr (PH == 12) phase_p9(p, lds);
    if constexpr (PH == 13) phase_p10(p, lds);
}
template <int PH> static void launch_phase(const P& p, hipStream_t st) {
    static bool init = false;
    if (!init) { (void)hipFuncSetAttribute((const void*)k_phase<PH>, hipFuncAttributeMaxDynamicSharedMemorySize, LDS_BYTES); init = true; }
    hipLaunchKernelGGL(k_phase<PH>, dim3(256), dim3(NTHR), LDS_BYTES, st, p);
}
__global__ void k_adapt_proj(const char* ws, int b, float* proj) {
    const size_t idx = (size_t)blockIdx.x * 256 + threadIdx.x; if (idx >= (size_t)SEQ * 1184) return;
    const int tl = (int)(idx / 1184), c = (int)(idx % 1184), t = b * SEQ + tl;
    bf16_t v;
    if (c < 512) v = ((const bf16_t*)(ws + OFF_UG))[((size_t)(c >> 4) * 1024 + (t >> 6)) * 1152 + (t & 63) * 16 + (c & 15)];
    else if (c < 896) v = ((const bf16_t*)(ws + OFF_CQ))[(size_t)t * 384 + c - 512];
    else if (c < 1152) v = ((const bf16_t*)(ws + OFF_CKV))[(size_t)t * 256 + c - 896];
    else { const int i = c - 1152; v = ((const bf16_t*)(ws + OFF_KIMG))[((((size_t)(b * 8 + 0) * 128 + (tl >> 6)) * 12 + 8 + (i >> 3)) * 64 + (tl & 63)) * 8 + (i & 7)]; }
    proj[idx] = bf2f(v);
}
__global__ void k_adapt_ymla(const char* ws, int b, float* ymla) {
    const size_t idx = (size_t)blockIdx.x * 256 + threadIdx.x; if (idx >= (size_t)SEQ * 512) return;
    ymla[idx] = bf2f(((const bf16_t*)(ws + OFF_YMLA))[(size_t)b * SEQ * 512 + idx]);
}
__global__ void k_adapt_ys5(const char* ws, int b, float* ys5) {
    const size_t idx = (size_t)blockIdx.x * 256 + threadIdx.x; if (idx >= (size_t)SEQ * 512) return;
    ys5[idx] = bf2f(((const bf16_t*)(ws + OFF_YS5))[(size_t)b * SEQ * 512 + idx]);
}
__global__ void k_adapt_x1(const char* ws, int b, float* x1) {
    const size_t idx = (size_t)blockIdx.x * 256 + threadIdx.x; if (idx >= (size_t)SEQ * 1024) return;
    x1[idx] = bf2f(((const bf16_t*)(ws + OFF_X1))[(size_t)b * SEQ * 1024 + idx]);
}
}

namespace fk {
__global__ void __launch_bounds__(512, 2) mk_fwd(P p, unsigned* barw) {
    extern __shared__ __attribute__((aligned(16))) char lds[];
    if (threadIdx.x == 0) *(uint4*)(lds + 131072) = make_uint4(0u, 0u, 0u, 0u);
    if ((threadIdx.x & 63) == 0) wgt_file((int)(threadIdx.x >> 6));
    __syncthreads();
    XcdBarrier bar = xcd_barrier_post(barw, (volatile LAS unsigned*)(lds + 131072));
#define MK_PHASE(fn) { fn(p, lds); }
    MK_PHASE(phase_g1)
    xcd_barrier(bar);
    MK_PHASE(phase_g2)
    xcd_barrier(bar);
    MK_PHASE(phase_p1)
    xcd_barrier(bar);
    MK_PHASE(phase_p2)
    xcd_barrier(bar);
    MK_PHASE(phase_p3)
    xcd_barrier(bar);
    MK_PHASE(phase_p4)
    xcd_barrier(bar);
    MK_PHASE(phase_p5)
    xcd_barrier(bar);
    MK_PHASE(phase_p6)
    xcd_barrier(bar);
    MK_PHASE(phase_p7)
    xcd_barrier(bar);
    MK_PHASE(phase_p8)
    xcd_barrier(bar);
    MK_PHASE(phase_p9p10)
#undef MK_PHASE
}
}

extern "C" void kernel_launch(void* const* d_in, const int* in_sizes, int n_in, void* d_out, int out_size, void* d_ws, size_t ws_size, hipStream_t stream) {
    fk::P p{};
    p.x = (const float*)d_in[0]; p.c = (const float*)d_in[1]; p.pos = (const int*)d_in[2]; p.w_ada = (const float*)d_in[3]; p.b_ada = (const float*)d_in[4]; p.w_in = (const float*)d_in[5];
    p.lam_re = (const float*)d_in[6]; p.lam_im = (const float*)d_in[7]; p.log_dt = (const float*)d_in[8]; p.b_re = (const float*)d_in[9]; p.b_im = (const float*)d_in[10];
    p.c_re = (const float*)d_in[11]; p.c_im = (const float*)d_in[12]; p.s5_d = (const float*)d_in[13]; p.w_glu = (const float*)d_in[14]; p.b_glu = (const float*)d_in[15];
    p.q_norm = (const float*)d_in[16]; p.w_uq = (const float*)d_in[17]; p.kv_norm = (const float*)d_in[18]; p.w_ukv = (const float*)d_in[19]; p.gn_s5 = (const float*)d_in[20];
    p.gn_mla = (const float*)d_in[21]; p.w_out = (const float*)d_in[22]; p.ln1_g = (const float*)d_in[23]; p.ln1_b = (const float*)d_in[24]; p.w_query = (const float*)d_in[25];
    p.keys1 = (const float*)d_in[26]; p.keys2 = (const float*)d_in[27]; p.pu = (const float*)d_in[28]; p.pv = (const float*)d_in[29]; p.ln2_g = (const float*)d_in[30]; p.ln2_b = (const float*)d_in[31];
    p.out = (float*)d_out; p.ws = (char*)d_ws;
    static int grid = 0;
    if (!grid) {
        int dev = 0, cus = 0, per_cu = 0;
        (void)hipGetDevice(&dev);
        (void)hipDeviceGetAttribute(&cus, hipDeviceAttributeMultiprocessorCount, dev);
        (void)hipFuncSetAttribute((const void*)fk::mk_fwd, hipFuncAttributeMaxDynamicSharedMemorySize, fk::LDS_BYTES);
        (void)hipOccupancyMaxActiveBlocksPerMultiprocessor(&per_cu, fk::mk_fwd, fk::NTHR, fk::LDS_BYTES);
        grid = cus > 0 ? cus : 256;
        if (per_cu < 1) fprintf(stderr, "kernel_launch: occupancy query reports %d workgroups per CU\n", per_cu);
    }
    (void)hipMemsetAsync(d_ws, 0, fk::SZ_BAR, stream);
    hipLaunchKernelGGL(fk::mk_fwd, dim3(grid), dim3(fk::NTHR), fk::LDS_BYTES, stream, p, (unsigned*)d_ws);
}
```
